# Optimizing an MI355X kernel written in HIP

```python
import jax
import jax.numpy as jnp
from jax import lax
import numpy as np


D_MODEL = 1024
BATCH = 8
SEQ = 4096
DEPTH = 4

GRID_W = 64
CTX_LEN = 256
EPS = 1e-6
NEG = -1e30
RET_HEADS = 4
RET_QK_DIM = 64
RET_V_DIM = 128
RET_CHUNK = 128
RET_QK = RET_HEADS * RET_QK_DIM
RET_V = RET_HEADS * RET_V_DIM
SG_GROUPS = 4
SG_CHUNK = 128
SG_W = D_MODEL // 2
SG_DIM = SG_W // SG_GROUPS
EVEN_SPLITS = (RET_QK, 2 * RET_QK, 2 * RET_QK + RET_V, 2 * RET_QK + 2 * RET_V, 2 * RET_QK + 2 * RET_V + SG_W)
EVEN_IN = 2 * RET_QK + 2 * RET_V + 2 * SG_W
EVEN_OUT = RET_V + SG_W
ATT_HEADS = 8
ATT_KV_HEADS = 2
HEAD_DIM = 128
ATT_GROUP = ATT_HEADS // ATT_KV_HEADS
ATT_BLOCK = 128
WINDOW = 128
ROPE_BASE = 10000.0
Q_COLS = ATT_HEADS * HEAD_DIM
KV_COLS = ATT_KV_HEADS * HEAD_DIM
ODD_IN = Q_COLS + 2 * KV_COLS
N_EXPERTS = 16
N_GROUPS = 4
EXPERTS_PER_GROUP = N_EXPERTS // N_GROUPS
GROUP_SCORE_K = 2
TOP_K = 2
D_EXPERT = 1024
N_EVEN = (DEPTH + 1) // 2
N_ODD = DEPTH // 2

kernel_name = 'hybrid_retention_sgmlp_swa_moe_dit'


def rms_norm(x, g):
    xf = x.astype(jnp.float32)
    y = xf * lax.rsqrt(jnp.mean(xf * xf, axis=-1, keepdims=True) + EPS)
    return (y * g.astype(jnp.float32)).astype(x.dtype)


def layer_norm(x, g, b):
    xf = x.astype(jnp.float32)
    mu = jnp.mean(xf, axis=-1, keepdims=True)
    var = jnp.mean(jnp.square(xf - mu), axis=-1, keepdims=True)
    y = (xf - mu) * lax.rsqrt(var + EPS)
    return (y * g.astype(jnp.float32) + b.astype(jnp.float32)).astype(x.dtype)


def head_norm(o, g):
    mu = jnp.mean(o, axis=-1, keepdims=True)
    var = jnp.mean(jnp.square(o - mu), axis=-1, keepdims=True)
    y = (o - mu) * lax.rsqrt(var + EPS)
    return y.reshape(o.shape[0], o.shape[1], -1) * g.astype(jnp.float32)


def maybe_flip(a, rev):
    return jnp.flip(a, axis=1) if rev else a


def retention_chunkwise(q, k, v, log_g, s0):
    f32 = jnp.float32
    b, L, H, dk = q.shape
    dv = v.shape[-1]
    C = RET_CHUNK
    n = L // C
    qc = q.astype(f32).reshape(b, n, C, H, dk)
    kc = k.astype(f32).reshape(b, n, C, H, dk)
    vc = v.astype(f32).reshape(b, n, C, H, dv)
    pos = jnp.arange(C, dtype=f32)
    diff = pos[:, None] - pos[None, :]
    inner_decay = jnp.where(diff[None] >= 0, jnp.exp(log_g[:, None, None] * jnp.maximum(diff, 0.0)[None]), 0.0)
    xi = jnp.exp(log_g[None, :] * (pos[:, None] + 1.0))
    zeta = jnp.exp(log_g[None, :] * (C - 1.0 - pos[:, None]))
    chunk_decay = jnp.exp(log_g * C)
    scores = jnp.einsum('bnihd,bnjhd->bnhij', qc, kc) * inner_decay
    inner = jnp.einsum('bnhij,bnjhe->bnihe', scores, vc)
    kv = jnp.einsum('bnjhd,jh,bnjhe->nbhde', kc, zeta, vc)

    def step(s, kv_n):
        return s * chunk_decay[None, :, None, None] + kv_n, s

    _, s_prev = lax.scan(step, s0.astype(f32), kv)
    cross = jnp.einsum('bnihd,nbhde->bnihe', qc, s_prev) * xi[None, None, :, :, None]
    return (inner + cross).reshape(b, L, H, dv)


def retention_final_state(k, v, log_g):
    f32 = jnp.float32
    Lc = k.shape[1]
    w = jnp.exp(log_g[None, :] * (Lc - 1.0 - jnp.arange(Lc, dtype=f32))[:, None])
    return jnp.einsum('bjhd,jh,bjhe->bhde', k.astype(f32), w, v.astype(f32))


def spatial_gating(u, s, ln_g, ln_b, w_s, b_s):
    b, L, _ = s.shape
    n = L // SG_CHUNK
    sn = layer_norm(s, ln_g, ln_b).reshape(b, n, SG_CHUNK, SG_GROUPS, SG_DIM)
    mixed = jnp.einsum('gpq,bnqgc->bnpgc', w_s, sn) + b_s.T[None, None, :, :, None]
    return u * mixed.reshape(b, L, SG_W)


def split_even(p):
    b, L, _ = p.shape
    q, k, v, g, u, s = jnp.split(p, EVEN_SPLITS, axis=-1)
    q = q.reshape(b, L, RET_HEADS, RET_QK_DIM)
    k = k.reshape(b, L, RET_HEADS, RET_QK_DIM) * (RET_QK_DIM ** -0.5)
    v = v.reshape(b, L, RET_HEADS, RET_V_DIM)
    return q, k, v, g, jax.nn.gelu(u), jax.nn.gelu(s)


def even_mixer(h_l, h_c, w_in, w_out, log_decay, gn_g, ln_g, ln_b, w_s, b_s, need_ctx):
    f32 = jnp.float32
    b, Lc, _ = h_c.shape
    ql, kl, vl, gl, ul, sl = split_even(h_l @ w_in)
    if need_ctx:
        qc, kc, vc, gc, uc, sc = split_even(h_c @ w_in)
    else:
        pkv = h_c @ w_in[:, RET_QK:2 * RET_QK + RET_V]
        kc = pkv[..., :RET_QK].reshape(b, Lc, RET_HEADS, RET_QK_DIM) * (RET_QK_DIM ** -0.5)
        vc = pkv[..., RET_QK:].reshape(b, Lc, RET_HEADS, RET_V_DIM)
    o_l = jnp.zeros(vl.shape, f32)
    o_c = jnp.zeros(vc.shape, f32)
    for d in range(2):
        rev = d == 1
        lg = -jnp.exp(log_decay[d].astype(f32))
        s_ctx = retention_final_state(maybe_flip(kc, rev), maybe_flip(vc, rev), lg)
        o_l = o_l + maybe_flip(retention_chunkwise(maybe_flip(ql, rev), maybe_flip(kl, rev), maybe_flip(vl, rev), lg, s_ctx), rev)
        if need_ctx:
            o_c = o_c + maybe_flip(retention_chunkwise(maybe_flip(qc, rev), maybe_flip(kc, rev), maybe_flip(vc, rev), lg, jnp.zeros_like(s_ctx)), rev)

    def merge(o, g, u, s):
        ret = (head_norm(o, gn_g) * jax.nn.silu(g.astype(f32))).astype(u.dtype)
        sg = spatial_gating(u, s, ln_g, ln_b, w_s, b_s)
        return jnp.concatenate([ret, sg], axis=-1) @ w_out

    y_l = merge(o_l, gl, ul, sl)
    y_c = merge(o_c, gc, uc, sc) if need_ctx else None
    return y_l, y_c


def axial_rope(x):
    f32 = jnp.float32
    L = x.shape[1]
    rows = L // GRID_W
    row = jnp.repeat(jnp.arange(rows, dtype=f32), GRID_W)
    col = jnp.tile(jnp.arange(GRID_W, dtype=f32), rows)
    half = HEAD_DIM // 2
    quarter = half // 2
    inv_freq = ROPE_BASE ** (-jnp.arange(quarter, dtype=f32) / quarter)

    def rot(xa, pos):
        ang = pos[:, None] * inv_freq[None, :]
        cos = jnp.cos(ang)[None, :, None, :]
        sin = jnp.sin(ang)[None, :, None, :]
        x1 = xa[..., :quarter].astype(f32)
        x2 = xa[..., quarter:].astype(f32)
        return jnp.concatenate([x1 * cos - x2 * sin, x2 * cos + x1 * sin], axis=-1)

    return jnp.concatenate([rot(x[..., :half], row), rot(x[..., half:], col)], axis=-1).astype(x.dtype)


def window_attention(q, k, v, kc, vc, sink):
    f32 = jnp.float32
    b, L, _, _ = q.shape
    nb = L // ATT_BLOCK
    scale = HEAD_DIM ** -0.5
    qb = q.reshape(b, nb, ATT_BLOCK, ATT_KV_HEADS, ATT_GROUP, HEAD_DIM)
    pad = ((0, 0), (ATT_BLOCK, ATT_BLOCK), (0, 0), (0, 0))

    def band(t):
        tp = jnp.pad(t, pad).reshape(b, nb + 2, ATT_BLOCK, ATT_KV_HEADS, HEAD_DIM)
        return jnp.concatenate([tp[:, 0:nb], tp[:, 1:nb + 1], tp[:, 2:nb + 2]], axis=2)

    kw, vw = band(k), band(v)
    qpos = jnp.arange(L).reshape(nb, ATT_BLOCK)
    kpos = jnp.arange(nb)[:, None] * ATT_BLOCK + jnp.arange(-ATT_BLOCK, 2 * ATT_BLOCK)[None, :]
    valid = (kpos[:, None, :] >= 0) & (kpos[:, None, :] < L) & (jnp.abs(qpos[:, :, None] - kpos[:, None, :]) <= WINDOW)
    s_loc = jnp.einsum('bnikgd,bnjkd->bnkgij', qb, kw).astype(f32) * scale
    s_loc = jnp.where(valid[None, :, None, None], s_loc, NEG)
    s_ctx = jnp.einsum('bnikgd,bjkd->bnkgij', qb, kc).astype(f32) * scale
    sink_b = jnp.broadcast_to(sink.astype(f32).reshape(ATT_KV_HEADS, ATT_GROUP)[None, None, :, :, None, None], s_loc.shape[:-1] + (1,))
    p = jax.nn.softmax(jnp.concatenate([sink_b, s_loc, s_ctx], axis=-1), axis=-1)
    nloc = 3 * ATT_BLOCK
    p_loc = p[..., 1:1 + nloc].astype(v.dtype)
    p_ctx = p[..., 1 + nloc:].astype(v.dtype)
    o = jnp.einsum('bnkgij,bnjkd->bnikgd', p_loc, vw) + jnp.einsum('bnkgij,bjkd->bnikgd', p_ctx, vc)
    return o.reshape(b, L, ATT_HEADS * HEAD_DIM)


def context_attention(qc, kc, vc, sink):
    f32 = jnp.float32
    b, Lc, _, _ = qc.shape
    qg = qc.reshape(b, Lc, ATT_KV_HEADS, ATT_GROUP, HEAD_DIM)
    s = jnp.einsum('bikgd,bjkd->bkgij', qg, kc).astype(f32) * (HEAD_DIM ** -0.5)
    sink_b = jnp.broadcast_to(sink.astype(f32).reshape(ATT_KV_HEADS, ATT_GROUP)[None, :, :, None, None], s.shape[:-1] + (1,))
    p = jax.nn.softmax(jnp.concatenate([sink_b, s], axis=-1), axis=-1)[..., 1:].astype(vc.dtype)
    o = jnp.einsum('bkgij,bjkd->bikgd', p, vc)
    return o.reshape(b, Lc, ATT_HEADS * HEAD_DIM)


def odd_mixer(h_l, h_c, w_qkv, w_o, sink, need_ctx):
    b, L, _ = h_l.shape
    Lc = h_c.shape[1]
    p = h_l @ w_qkv
    ql = axial_rope(p[..., :Q_COLS].reshape(b, L, ATT_HEADS, HEAD_DIM))
    kl = axial_rope(p[..., Q_COLS:Q_COLS + KV_COLS].reshape(b, L, ATT_KV_HEADS, HEAD_DIM))
    vl = p[..., Q_COLS + KV_COLS:].reshape(b, L, ATT_KV_HEADS, HEAD_DIM)
    pkv = h_c @ w_qkv[:, Q_COLS:]
    kc = pkv[..., :KV_COLS].reshape(b, Lc, ATT_KV_HEADS, HEAD_DIM)
    vc = pkv[..., KV_COLS:].reshape(b, Lc, ATT_KV_HEADS, HEAD_DIM)
    y_l = window_attention(ql, kl, vl, kc, vc, sink) @ w_o
    y_c = None
    if need_ctx:
        qc = (h_c @ w_qkv[:, :Q_COLS]).reshape(b, Lc, ATT_HEADS, HEAD_DIM)
        y_c = context_attention(qc, kc, vc, sink) @ w_o
    return y_l, y_c


def grouped_moe(h, w_router, b_router, w_gate, w_up, w_down):
    f32 = jnp.float32
    n = h.shape[0]
    probs = jax.nn.softmax((h @ w_router + b_router).astype(f32), axis=-1)
    grp = probs.reshape(n, N_GROUPS, EXPERTS_PER_GROUP)
    group_score = jnp.sum(lax.top_k(grp, GROUP_SCORE_K)[0], axis=-1)
    g_sel = jnp.argmax(group_score, axis=-1)
    in_group = (jnp.arange(N_EXPERTS) // EXPERTS_PER_GROUP)[None, :] == g_sel[:, None]
    top_w, top_i = lax.top_k(jnp.where(in_group, probs, -1.0), TOP_K)
    top_w = top_w / jnp.sum(top_w, axis=-1, keepdims=True)
    combine = jnp.sum(jax.nn.one_hot(top_i, N_EXPERTS, dtype=f32) * top_w[..., None], axis=1).astype(h.dtype)
    out = jnp.zeros_like(h)
    for e in range(N_EXPERTS):
        a = jax.nn.silu(h @ w_gate[e]) * (h @ w_up[e])
        out = out + combine[:, e:e + 1] * (a @ w_down[e])
    return out


def setup_inputs(seed: int = 0) -> dict:
    key = jax.random.key(seed)
    ks = iter(jax.random.split(key, 32))

    def nrm(shape, std):
        return jax.random.normal(next(ks), shape, jnp.float32) * std

    D = D_MODEL
    base_decay = jnp.asarray(np.log(-np.log(1.0 - 2.0 ** (-5.0 - np.arange(RET_HEADS)))), jnp.float32)
    return {
        'x': nrm((BATCH, SEQ, D), 1.0),
        'c': nrm((BATCH, D), 1.0),
        'ctx': nrm((BATCH, CTX_LEN, D), 1.0),
        'c_ctx': nrm((D,), 1.0),
        'w_mod': nrm((DEPTH, D, 6 * D), 0.5 * D ** -0.5),
        'b_mod': nrm((DEPTH, 6 * D), 0.02),
        'norm_g': 1.0 + nrm((DEPTH, 2, D), 0.02),
        'w_in_even': nrm((N_EVEN, D, EVEN_IN), D ** -0.5),
        'w_out_even': nrm((N_EVEN, EVEN_OUT, D), EVEN_OUT ** -0.5),
        'ret_log_decay': base_decay + nrm((N_EVEN, 2, RET_HEADS), 0.1),
        'ret_gn_g': 1.0 + nrm((N_EVEN, RET_V), 0.02),
        'sg_ln_g': 1.0 + nrm((N_EVEN, SG_W), 0.02),
        'sg_ln_b': nrm((N_EVEN, SG_W), 0.02),
        'sg_w': nrm((N_EVEN, SG_GROUPS, SG_CHUNK, SG_CHUNK), SG_CHUNK ** -0.5),
        'sg_b': 1.0 + nrm((N_EVEN, SG_GROUPS, SG_CHUNK), 0.1),
        'w_qkv_odd': nrm((N_ODD, D, ODD_IN), D ** -0.5),
        'w_o_odd': nrm((N_ODD, Q_COLS, D), Q_COLS ** -0.5),
        'attn_sink': nrm((N_ODD, ATT_HEADS), 0.5),
        'w_router': nrm((D, N_EXPERTS), D ** -0.5),
        'b_router': nrm((N_EXPERTS,), 0.01),
        'w_e_gate': nrm((DEPTH, N_EXPERTS, D, D_EXPERT), D ** -0.5),
        'w_e_up': nrm((DEPTH, N_EXPERTS, D, D_EXPERT), D ** -0.5),
        'w_e_down': nrm((DEPTH, N_EXPERTS, D_EXPERT, D), D_EXPERT ** -0.5),
        'final_g': 1.0 + nrm((D,), 0.02),
    }


def reference(x, c, ctx, c_ctx, w_mod, b_mod, norm_g, w_in_even, w_out_even, ret_log_decay, ret_gn_g, sg_ln_g, sg_ln_b, sg_w, sg_b, w_qkv_odd, w_o_odd, attn_sink, w_router, b_router, w_e_gate, w_e_up, w_e_down, final_g):
    b, L, D = x.shape
    for l in range(DEPTH):
        need_ctx = l < DEPTH - 1
        m_l = (jax.nn.silu(c) @ w_mod[l] + b_mod[l])[:, None, :]
        m_c = (jax.nn.silu(c_ctx) @ w_mod[l] + b_mod[l])[None, None, :]
        sh1, sc1, g1, sh2, sc2, g2 = jnp.split(m_l, 6, axis=-1)
        csh1, csc1, cg1, csh2, csc2, cg2 = jnp.split(m_c, 6, axis=-1)
        h_l = rms_norm(x, norm_g[l, 0]) * (1.0 + sc1) + sh1
        h_c = rms_norm(ctx, norm_g[l, 0]) * (1.0 + csc1) + csh1
        i = l // 2
        if l % 2 == 0:
            y_l, y_c = even_mixer(h_l, h_c, w_in_even[i], w_out_even[i], ret_log_decay[i], ret_gn_g[i], sg_ln_g[i], sg_ln_b[i], sg_w[i], sg_b[i], need_ctx)
        else:
            y_l, y_c = odd_mixer(h_l, h_c, w_qkv_odd[i], w_o_odd[i], attn_sink[i], need_ctx)
        x = x + g1 * y_l
        h2_l = rms_norm(x, norm_g[l, 1]) * (1.0 + sc2) + sh2
        if need_ctx:
            ctx = ctx + cg1 * y_c
            h2_c = rms_norm(ctx, norm_g[l, 1]) * (1.0 + csc2) + csh2
            rows = jnp.concatenate([h2_l.reshape(-1, D), h2_c.reshape(-1, D)], axis=0)
            out = grouped_moe(rows, w_router, b_router, w_e_gate[l], w_e_up[l], w_e_down[l])
            x = x + g2 * out[:b * L].reshape(x.shape)
            ctx = ctx + cg2 * out[b * L:].reshape(ctx.shape)
        else:
            x = x + g2 * grouped_moe(h2_l.reshape(-1, D), w_router, b_router, w_e_gate[l], w_e_up[l], w_e_down[l]).reshape(x.shape)
    return rms_norm(x, final_g)
```

```cpp
#include <hip/hip_runtime.h>
#include <cstdio>
#include <cstdint>
#include <type_traits>

#define GAS __attribute__((address_space(1)))
#define LAS __attribute__((address_space(3)))
typedef unsigned short bf16;
typedef unsigned v4u __attribute__((ext_vector_type(4)));
typedef unsigned u32x2 __attribute__((ext_vector_type(2)));
typedef float f32x2 __attribute__((ext_vector_type(2)));
typedef float f32x4 __attribute__((ext_vector_type(4)));
typedef float f32x16 __attribute__((ext_vector_type(16)));
typedef short bf16x8 __attribute__((ext_vector_type(8)));
typedef short s16x4 __attribute__((ext_vector_type(4)));
typedef GAS unsigned gu32;
#define RLX_AGENT __ATOMIC_RELAXED, __HIP_MEMORY_SCOPE_AGENT
#define LDS_WAIT() asm volatile("s_waitcnt lgkmcnt(0)" ::: "memory")
#define VM_WAIT() asm volatile("s_waitcnt vmcnt(0)" ::: "memory")

constexpr int D = 1024, NB = 8, SEQ = 4096, LC = 256, DEPTH = 4;
constexpr int RL = NB * SEQ;
constexpr int RC = NB * LC;
constexpr int RT = RL + RC;
constexpr int NCH = 34;
constexpr int EVEN_IN = 2560, ODD_IN = 1536;
constexpr int NE = 16;
constexpr float EPS = 1e-6f;
constexpr int MAXSLOT = 73728;

__device__ __forceinline__ unsigned cvt_pk_bf16(float lo, float hi) { unsigned r; asm volatile("v_cvt_pk_bf16_f32 %0, %1, %2" : "=v"(r) : "v"(lo), "v"(hi)); return r; }
__device__ __forceinline__ float bf_lo(unsigned w) { return __uint_as_float(w << 16); }
__device__ __forceinline__ float bf_hi(unsigned w) { return __uint_as_float(w & 0xffff0000u); }
__device__ __forceinline__ float bf2f(unsigned short h) { return __uint_as_float(((unsigned)h) << 16); }
__device__ __forceinline__ unsigned short f2bf(float f) { return (unsigned short)(cvt_pk_bf16(f, 0.f) & 0xffffu); }
__device__ __forceinline__ float gelu_tanh(float x) { const float u = x + 0.044715f * x * x * x; return x * __builtin_amdgcn_rcpf(1.0f + __builtin_amdgcn_exp2f(-2.302208198f * u)); }
__device__ __forceinline__ float silu_f(float x) { return x * __builtin_amdgcn_rcpf(1.0f + __builtin_amdgcn_exp2f(-1.4426950409f * x)); }
__device__ __forceinline__ float fexp2(float x) { return __builtin_amdgcn_exp2f(x); }
__device__ __forceinline__ float fexp(float x) { return __builtin_amdgcn_exp2f(x * 1.4426950409f); }
__device__ __forceinline__ float frsq(float x) { return __builtin_amdgcn_rsqf(x); }
__device__ __forceinline__ float dpp_f(float v, const int ctrl_b1, const int sel) {
    const int x = __float_as_int(v);
    const int y = sel == 0 ? __builtin_amdgcn_mov_dpp(x, 0xB1, 0xf, 0xf, true) : sel == 1 ? __builtin_amdgcn_mov_dpp(x, 0x4E, 0xf, 0xf, true) : sel == 2 ? __builtin_amdgcn_mov_dpp(x, 0x141, 0xf, 0xf, true) : __builtin_amdgcn_mov_dpp(x, 0x140, 0xf, 0xf, true);
    return __int_as_float(y);
}
__device__ __forceinline__ float row_sum16(float v) { v += dpp_f(v, 0, 0); v += dpp_f(v, 0, 1); v += dpp_f(v, 0, 2); v += dpp_f(v, 0, 3); return v; }
__device__ __forceinline__ float wave_sum(float v, int) {
    v = row_sum16(v);
    const int x = __float_as_int(v);
    return (__int_as_float(__builtin_amdgcn_readlane(x, 0)) + __int_as_float(__builtin_amdgcn_readlane(x, 16))) + (__int_as_float(__builtin_amdgcn_readlane(x, 32)) + __int_as_float(__builtin_amdgcn_readlane(x, 48)));
}
__device__ __forceinline__ float col_sum4(float v) {
    { auto r = __builtin_amdgcn_permlane16_swap(__float_as_uint(v), __float_as_uint(v), false, false); v = __uint_as_float(r[0]) + __uint_as_float(r[1]); }
    { auto r = __builtin_amdgcn_permlane32_swap(__float_as_uint(v), __float_as_uint(v), false, false); v = __uint_as_float(r[0]) + __uint_as_float(r[1]); }
    return v;
}

namespace pg8 {
typedef unsigned short bf16_t;
constexpr int BM = 256, BK = 64, HALF = 128, HTB = HALF * BK * 2, STAGE_BYTES = 8 * HTB, NXCD = 8, WGM = 8, KD = 1024;

__host__ __device__ __forceinline__ int lds_byte(int r, int c) { const int st = (r >> 4) * 2 + (c >> 5), rr = r & 15, cc = c & 31, ob = rr * 64 + cc * 2; return st * 1024 + (ob ^ (((ob >> 9) & 1) << 5)); }
__host__ __device__ __forceinline__ void stage_rc(int b, int& R, int& C) { const int st = b / 1024, sb = b % 1024, swz = sb ^ (((sb >> 9) & 1) << 5); R = (st >> 1) * 16 + swz / 64; C = (st & 1) * 32 + (swz % 64) / 2; }
__host__ __device__ __forceinline__ int perm32(int rho) { const int n = rho >> 4, i = rho & 15; return 8 * (i >> 2) + 4 * n + (i & 3); }

struct Unit { int pm, pn, e, nvalid; const int* gidx; };
typedef int i32x8 __attribute__((ext_vector_type(8)));
typedef int i32x4 __attribute__((ext_vector_type(4)));
typedef i32x8 Frag;
__device__ __forceinline__ bf16x8 frag_half(const Frag& f, int k) { const i32x4 q = k ? __builtin_shufflevector(f, f, 4, 5, 6, 7) : __builtin_shufflevector(f, f, 0, 1, 2, 3); return __builtin_bit_cast(bf16x8, q); }
struct Gemm { const bf16_t* A; const bf16_t* Bt; size_t bstride; };

struct StaticOrder {
    int nM, nN, nwg, G, c;
    __device__ void init(int M, int N, int G_, int c_) { nM = M / BM; nN = N / BM; nwg = nM * nN; G = G_; c = c_; }
    __device__ bool next(int i, Unit& u) const {
        const long L = (long)i * G + c; if (L >= nwg) return false;
        int wgid = (int)L; { const int q = nwg / NXCD, r = nwg % NXCD, xcd = wgid % NXCD, off = wgid / NXCD; wgid = (xcd < r ? xcd * (q + 1) : r * (q + 1) + (xcd - r) * q) + off; }
        const int nig = WGM * nN, gid = wgid / nig, fm = gid * WGM, gsz = (nM - fm) < WGM ? (nM - fm) : WGM;
        u.pm = fm + ((wgid % nig) % gsz); u.pn = (wgid % nig) / gsz; u.e = 0; u.nvalid = 256; u.gidx = nullptr; return true;
    }
};
struct MoeOrder {
    const LAS int* tab; const int* lists; int npn, G, c, nwg;
    __device__ void init(const LAS int* tab_, const int* lists_, int npn_, int G_, int c_) { tab = tab_; lists = lists_; npn = npn_; G = G_; c = c_; nwg = tab_[16] * npn_; }
    __device__ bool next(int i, Unit& u) const {
        const long L = (long)i * G + c; if (L >= nwg) return false;
        int wgid = (int)L; { const int q = nwg / NXCD, r = nwg % NXCD, xcd = wgid % NXCD, off = wgid / NXCD; wgid = (xcd < r ? xcd * (q + 1) : r * (q + 1) + (xcd - r) * q) + off; }
        int e = 0;
#pragma unroll 1
        for (int k = 1; k < 16; ++k) if (wgid >= tab[k] * npn) e = k;
        const int t0 = tab[e], loc = wgid - t0 * npn, mt = loc / npn;
        u.pm = t0 + mt; u.pn = loc - mt * npn; u.e = e; u.nvalid = tab[32 + e] - mt * 256; u.gidx = lists + (size_t)e * RT + mt * 256; return true;
    }
};

template <class Epi, class Sched, bool ALIGN_EPI, bool GATHER, bool FP8>
__device__ __forceinline__ void gemm_phase(LAS unsigned char* lds, const Gemm g, const Sched& S, const Epi& E, const int tid) {
    const int wid = __builtin_amdgcn_readfirstlane(tid >> 6), lane = tid & 63, wr = wid >> 2, wc = wid & 3, fr = lane & 15, fq = lane >> 4;
    constexpr int ROWB = FP8 ? 1024 : 2048, nt = ROWB / 128;
    unsigned voffA[2], voffB[2]; int RA[2]; unsigned CA2[2];
#pragma unroll
    for (int i = 0; i < 2; ++i) { int R, C; stage_rc(tid * 16 + i * 8192, R, C); const int Rb = Epi::PERM ? ((R & ~31) + perm32(R & 31)) : R;
        voffA[i] = (unsigned)(R * ROWB + C * 2); voffB[i] = (unsigned)(Rb * ROWB + C * 2); RA[i] = R; CA2[i] = (unsigned)C * 2u; }
    const size_t kstep = (size_t)(BK * 2);
    const size_t hstep = (size_t)HALF * ROWB;
    const size_t tstep = 2 * hstep;
    const unsigned ldsw = (unsigned)wid * 1024u;
    const int aoff = lds_byte(wr * 64 + fr, fq * 8), boff = lds_byte(wc * 32 + fr, fq * 8);
#define PG8_SA(b, h) (((b) * 2 + (h)) * HTB)
#define PG8_SB(b, h) ((4 + (b) * 2 + (h)) * HTB)
#define PG8_STAGE(bufoff, gbase, voff) do { _Pragma("unroll") for (int _i = 0; _i < 2; ++_i) \
        __builtin_amdgcn_global_load_lds((const unsigned*)((const char*)(gbase) + (voff)[_i]), (LAS unsigned*)(lds + (bufoff) + ldsw + _i * 8192), 16, 0, 0); } while (0)
#define PG8_STA(bufoff, kptr, H, VG) do { if constexpr (GATHER) { PG8_STAGE(bufoff, kptr, VG[H]); } else { PG8_STAGE(bufoff, (kptr) + (H) * hstep, voffA); } } while (0)
#define PG8_LDA(dst, b, h) do { _Pragma("unroll") for (int m = 0; m < 4; ++m) dst[m] = __builtin_shufflevector(*(const LAS i32x4*)(lds + PG8_SA(b, h) + aoff + m * 2048), *(const LAS i32x4*)(lds + PG8_SA(b, h) + aoff + m * 2048 + 1024), 0, 1, 2, 3, 4, 5, 6, 7); } while (0)
#define PG8_LDB(dst, b, h) do { _Pragma("unroll") for (int n = 0; n < 2; ++n) dst[n] = __builtin_shufflevector(*(const LAS i32x4*)(lds + PG8_SB(b, h) + boff + n * 2048), *(const LAS i32x4*)(lds + PG8_SB(b, h) + boff + n * 2048 + 1024), 0, 1, 2, 3, 4, 5, 6, 7); } while (0)
#define PG8_MMA(ai, bj, At, Bt) do { __builtin_amdgcn_s_setprio(1); _Pragma("unroll") for (int m = 0; m < 4; ++m) _Pragma("unroll") for (int n = 0; n < 2; ++n) { \
        if constexpr (FP8) asm volatile("v_mfma_scale_f32_16x16x128_f8f6f4 %0, %1, %2, %0, %3, %3 op_sel_hi:[0,0,0]" : "+v"(acc[ai][bj][m][n]) : "v"(Bt[n]), "v"(At[m]), "v"(sc1)); \
        else { _Pragma("unroll") for (int k = 0; k < 2; ++k) acc[ai][bj][m][n] = __builtin_amdgcn_mfma_f32_16x16x32_bf16(frag_half(Bt[n], k), frag_half(At[m], k), acc[ai][bj][m][n], 0, 0, 0); } } \
        __builtin_amdgcn_s_setprio(0); } while (0)
#define PG8_WAIT_V(n) asm volatile("s_waitcnt vmcnt(" #n ")" ::: "memory")
#define PG8_WAIT_L(n) asm volatile("s_waitcnt lgkmcnt(" #n ")" ::: "memory")
#define PG8_BAR __builtin_amdgcn_s_barrier()
#define PG8_SCHED __builtin_amdgcn_sched_barrier(0)
#define PG8_GLOAD(U, TK) do { _Pragma("unroll") for (int _h = 0; _h < 2; ++_h) _Pragma("unroll") for (int _i = 0; _i < 2; ++_i) { const int _r = _h * HALF + RA[_i]; \
        const int _rc = _r < (U).nvalid ? _r : (U).nvalid - 1; TK[_h][_i] = (U).gidx[_rc]; } } while (0)
#define PG8_GADDR(TK, VG) do { _Pragma("unroll") for (int _h = 0; _h < 2; ++_h) _Pragma("unroll") for (int _i = 0; _i < 2; ++_i) VG[_h][_i] = (unsigned)TK[_h][_i] * (unsigned)ROWB + CA2[_i]; } while (0)
    Unit cur, nxt; int ui = 0;
    if (!S.next(0, cur)) return;
    f32x4 acc[2][2][4][2];
#pragma unroll
    for (int a = 0; a < 2; ++a)
#pragma unroll
        for (int b = 0; b < 2; ++b)
#pragma unroll
            for (int m = 0; m < 4; ++m)
#pragma unroll
                for (int n = 0; n < 2; ++n) acc[a][b][m][n] = (f32x4){0.f, 0.f, 0.f, 0.f};
    Frag At[4], B0[2], B1[2];
    const int sc1 = 0x7f7f7f7f;
    unsigned vgc[2][2] = {{0u, 0u}, {0u, 0u}}, vgn[2][2] = {{0u, 0u}, {0u, 0u}};
    int tkn[2][2] = {{0, 0}, {0, 0}};
    if constexpr (GATHER) { PG8_GLOAD(cur, tkn); PG8_GADDR(tkn, vgc); }
    const char* cA = GATHER ? (const char*)g.A : (const char*)g.A + (size_t)cur.pm * tstep;
    const char* cB = (const char*)g.Bt + (size_t)cur.e * g.bstride + (size_t)cur.pn * tstep;
    PG8_STAGE(PG8_SB(0, 0), cB, voffB); PG8_STAGE(PG8_SB(0, 1), cB + hstep, voffB); PG8_STA(PG8_SA(0, 0), cA, 0, vgc); PG8_STA(PG8_SA(0, 1), cA, 1, vgc);
    if (wr == 1) PG8_BAR;
    PG8_WAIT_V(2); PG8_BAR;
    PG8_STAGE(PG8_SB(1, 0), cB + kstep, voffB); PG8_STA(PG8_SA(1, 0), cA + kstep, 0, vgc); PG8_STAGE(PG8_SB(1, 1), cB + hstep + kstep, voffB);
    PG8_WAIT_V(6); PG8_BAR;
    for (;;) {
        const bool has_next = S.next(ui + 1, nxt);
        if constexpr (GATHER) { if (has_next) { PG8_GLOAD(nxt, tkn); } }
        const char* nA = GATHER ? (const char*)g.A : (has_next ? (const char*)g.A + (size_t)nxt.pm * tstep : cA);
        const char* nB = has_next ? (const char*)g.Bt + (size_t)nxt.e * g.bstride + (size_t)nxt.pn * tstep : cB;
#pragma unroll 1
        for (int t = 0; t < nt; t += 2) {
            const bool last = (t == nt - 2);
            const char* a1 = cA + (size_t)(t + 1) * kstep;
            const char* a2 = last ? nA : cA + (size_t)(t + 2) * kstep; const char* b2 = last ? nB : cB + (size_t)(t + 2) * kstep;
            const char* a3 = a2 + kstep; const char* b3 = b2 + kstep;
            unsigned va2[2][2] = {{vgc[0][0], vgc[0][1]}, {vgc[1][0], vgc[1][1]}};
            if constexpr (GATHER) { if (last && has_next) { asm volatile("" : "+v"(tkn[0][0]), "+v"(tkn[0][1]), "+v"(tkn[1][0]), "+v"(tkn[1][1])); PG8_GADDR(tkn, vgn);
                va2[0][0] = vgn[0][0]; va2[0][1] = vgn[0][1]; va2[1][0] = vgn[1][0]; va2[1][1] = vgn[1][1]; } }
            PG8_LDB(B0, 0, 0); PG8_LDB(B1, 0, 1); PG8_SCHED; PG8_LDA(At, 0, 0); PG8_STA(PG8_SA(1, 1), a1, 1, vgc);
            PG8_WAIT_V(8); PG8_WAIT_L(0); PG8_BAR; PG8_MMA(0, 0, At, B0); PG8_MMA(0, 1, At, B1); PG8_BAR; PG8_SCHED;
            PG8_LDA(At, 0, 1); PG8_STAGE(PG8_SB(0, 0), b2, voffB); PG8_STAGE(PG8_SB(0, 1), b2 + hstep, voffB); PG8_STA(PG8_SA(0, 0), a2, 0, va2);
            PG8_WAIT_V(8); PG8_WAIT_L(0); PG8_BAR; PG8_MMA(1, 0, At, B0); PG8_MMA(1, 1, At, B1); PG8_BAR; PG8_SCHED;
            PG8_LDB(B0, 1, 0); PG8_LDB(B1, 1, 1); PG8_SCHED; PG8_LDA(At, 1, 0); PG8_STA(PG8_SA(0, 1), a2, 1, va2);
            PG8_WAIT_V(8); PG8_WAIT_L(0); PG8_BAR; PG8_MMA(0, 0, At, B0); PG8_MMA(0, 1, At, B1); PG8_BAR; PG8_SCHED;
            PG8_LDA(At, 1, 1); PG8_STAGE(PG8_SB(1, 0), b3, voffB); PG8_STAGE(PG8_SB(1, 1), b3 + hstep, voffB); PG8_STA(PG8_SA(1, 0), a3, 0, va2);
            PG8_WAIT_V(8); PG8_WAIT_L(0); PG8_BAR; PG8_MMA(1, 0, At, B0); PG8_MMA(1, 1, At, B1); PG8_BAR; PG8_SCHED;
        }
        if constexpr (ALIGN_EPI) { if (wr == 0) PG8_BAR; }
        if constexpr (FP8) asm volatile("s_nop 15\n\ts_nop 15" ::: "memory");
        E(acc, cur, wr, wc, fr, fq);
        if (!has_next) break;
#pragma unroll
        for (int a = 0; a < 2; ++a)
#pragma unroll
            for (int b = 0; b < 2; ++b)
#pragma unroll
                for (int m = 0; m < 4; ++m)
#pragma unroll
                    for (int n = 0; n < 2; ++n) acc[a][b][m][n] = (f32x4){0.f, 0.f, 0.f, 0.f};
        cur = nxt; cA = nA; cB = nB; ++ui;
        if constexpr (GATHER) {
#pragma unroll
            for (int h = 0; h < 2; ++h)
#pragma unroll
                for (int i = 0; i < 2; ++i) vgc[h][i] = vgn[h][i]; }
        if constexpr (ALIGN_EPI) { if (wr == 1) PG8_BAR; }
    }
    PG8_WAIT_V(0);
    if constexpr (!ALIGN_EPI) { if (wr == 0) PG8_BAR; }
    PG8_BAR;
#undef PG8_SA
#undef PG8_SB
#undef PG8_STAGE
#undef PG8_STA
#undef PG8_LDA
#undef PG8_LDB
#undef PG8_MMA
#undef PG8_WAIT_V
#undef PG8_WAIT_L
#undef PG8_BAR
#undef PG8_SCHED
#undef PG8_GLOAD
#undef PG8_GADDR
}
}
#define XB_TMO      128
#define XB_XCNT(j)  (256  + 64 * (j))
#define XB_XSUB(j)  (1280 + 64 * (j))
#define XB_XGEN(j)  (2304 + 64 * (j))
#define XB_TOP      3328
#define XB_TOPGEN   3392
#define XCD_BAR_WORDS 3456
#define XB_SPIN_CAP (1u << 22)

__device__ __forceinline__ unsigned xb_ld(unsigned* p)              { return __hip_atomic_load(p, __ATOMIC_RELAXED, __HIP_MEMORY_SCOPE_AGENT); }
__device__ __forceinline__ unsigned xb_add(unsigned* p, unsigned v) { return __hip_atomic_fetch_add(p, v, __ATOMIC_RELAXED, __HIP_MEMORY_SCOPE_AGENT); }
__device__ __forceinline__ unsigned xb_xcc_id() { return (unsigned)__builtin_amdgcn_s_getreg((3 << 11) | 20) & 0xFu; }
#define XB_SPIN(cond, bar) do { unsigned _sp = 0; while (cond) { __builtin_amdgcn_s_sleep(1); \
    if ((++_sp & 255u) == 0u) { if (xb_ld(&(bar)[XB_TMO])) break; if (_sp > XB_SPIN_CAP) { atomicAdd(&(bar)[XB_TMO], 1u); break; } } } } while (0)

struct XcdBarrier {
    unsigned* bar; unsigned x;
    volatile LAS unsigned* st;
};

__device__ __forceinline__ XcdBarrier xcd_barrier_post(unsigned* bar, volatile LAS unsigned* st) {
    XcdBarrier b; b.bar = bar; b.x = xb_xcc_id(); b.st = st;
    if (threadIdx.x == 0) (void)xb_add(&bar[XB_XCNT(b.x)], 1u);
    return b;
}
__device__ __forceinline__ void xcd_barrier_complete(unsigned* bar, unsigned x, unsigned& nloc, unsigned& nx) {
    const unsigned G = gridDim.x * gridDim.y * gridDim.z;
    unsigned sum, cnt, mine, sp = 0u;
    for (;;) {
        sum = 0u; cnt = 0u; mine = 0u;
#pragma unroll
        for (unsigned j = 0; j < 16; ++j) { const unsigned c = xb_ld(&bar[XB_XCNT(j)]); sum += c; cnt += (c > 0u) ? 1u : 0u; mine = (j == x) ? c : mine; }
        if (sum == G) break;
        __builtin_amdgcn_s_sleep(1);
        if ((++sp & 255u) == 0u) { if (xb_ld(&bar[XB_TMO])) break; if (sp > XB_SPIN_CAP) { atomicAdd(&bar[XB_TMO], 1u); break; } }
    }
    nloc = mine > 0u ? mine : 1u; nx = cnt > 0u ? cnt : 1u;
}

__device__ __forceinline__ void xcd_barrier(const XcdBarrier& b) {
    asm volatile("s_waitcnt vmcnt(0)" ::: "memory");
    __syncthreads();
    if (threadIdx.x == 0) {
        unsigned* bar = b.bar; unsigned bxx = b.x; asm volatile("" : "+s"(bxx), "+s"(bar));
        __builtin_amdgcn_s_waitcnt(0);
        unsigned nloc = b.st[0], nx = b.st[1];
        if (nloc == 0u) { xcd_barrier_complete(bar, bxx, nloc, nx); b.st[0] = nloc; b.st[1] = nx; }
        const unsigned old = xb_add(&bar[XB_XSUB(bxx)], 1u);
        const unsigned gen = old / nloc;
        if (old + 1u == (gen + 1u) * nloc) {
            __builtin_amdgcn_fence(__ATOMIC_RELEASE, "agent");
            asm volatile("s_waitcnt vmcnt(0)" ::: "memory");
            const unsigned og = xb_add(&bar[XB_TOP], 1u);
            const unsigned tg = og / nx;
            if (og + 1u == (tg + 1u) * nx) xb_add(&bar[XB_TOPGEN], 1u);
            else XB_SPIN(xb_ld(&bar[XB_TOPGEN]) == tg, bar);
            __builtin_amdgcn_fence(__ATOMIC_ACQUIRE, "agent");
            xb_add(&bar[XB_XGEN(bxx)], 1u);
            asm volatile("s_waitcnt vmcnt(0)" ::: "memory");
        } else {
            XB_SPIN(xb_ld(&bar[XB_XGEN(bxx)]) == gen, bar);
            __builtin_amdgcn_fence(__ATOMIC_ACQUIRE, "agent");
            asm volatile("s_waitcnt vmcnt(0)" ::: "memory");
        }
    }
    __syncthreads();
}

constexpr size_t MiB = 1u << 20;
constexpr size_t WS_CTL = 0, CTL_ZERO_BYTES = 1 * MiB;
constexpr size_t WS_MOD = 1 * MiB;
constexpr size_t WS_ROPE = 2 * MiB;
constexpr size_t WS_SGW = 2 * MiB + 65536;
constexpr size_t WS_TOK = 3 * MiB;
constexpr size_t WS_LIST = 4 * MiB;
constexpr size_t WS_W1T = 8 * MiB;
constexpr size_t WS_W2T = 264 * MiB;
constexpr size_t WS_WIN = 392 * MiB;
constexpr size_t WS_WOUT = 402 * MiB;
constexpr size_t WS_WQKV = 406 * MiB;
constexpr size_t WS_WO = 412 * MiB;
constexpr size_t WS_X = 416 * MiB;
constexpr size_t WS_H = 552 * MiB;
constexpr size_t WS_BIG = 620 * MiB;
constexpr size_t WS_MIX = 790 * MiB;
constexpr size_t WS_C = 858 * MiB;
constexpr size_t WS_END = 1002 * MiB;
constexpr size_t BIG_K = 68 * MiB, BIG_V = 85 * MiB, C_ST = 68 * MiB;
constexpr int CW_TMO = 0, CW_BAR = 4096, CW_CNT = 8192;

constexpr int RING_BYTES = 131072, MISC_OFF = RING_BYTES, LDS_BYTES = 147456;
constexpr int NWAVES = 8;

struct Frame {
    LAS unsigned char* lds; char* ldsg;
    volatile LAS unsigned* MISC;
    unsigned* ctl;
    int tid, lane, wave, vcu, G, bx;
    const float *x_in, *c_in, *ctx_in, *cctx_in, *w_mod, *b_mod, *norm_g, *w_in_even, *w_out_even, *ret_ld, *ret_gn, *sg_ln_g, *sg_ln_b, *sg_w, *sg_b,
                *w_qkv, *w_o, *sink, *w_router, *b_router, *w_eg, *w_eu, *w_ed, *final_g;
    float* out;
    float *MOD, *ROPE, *KV;
    bf16 *X, *SGW, *W1T, *W2T, *WIN, *WOUT, *WQKV, *WO, *H, *BIG, *MIX, *CS, *ST;
    v4u* TOK; int* LIST;
};

using pg8::Unit;
__device__ __forceinline__ unsigned cvt4_fp8(float a, float b, float c, float d) { int w = 0; w = __builtin_amdgcn_cvt_pk_fp8_f32(a, b, w, false); w = __builtin_amdgcn_cvt_pk_fp8_f32(c, d, w, true); return (unsigned)w; }
__device__ __forceinline__ float clamp448(float x) { return __builtin_amdgcn_fmed3f(x, -448.f, 448.f); }
constexpr bool IN8 = false, QKV8 = true;
constexpr float W8_SCALE = 32.f, W8_INV = 1.f / 32.f;
constexpr float ACT8_SCALE = 4.f, ACT8_INV = 0.25f;
struct EpiIn {
    static constexpr bool PERM = true;
    bf16* O;
    __device__ __forceinline__ void operator()(const f32x4 (&acc)[2][2][4][2], const Unit& u, int wr, int wc, int fr, int fq) const {
        const int row0 = u.pm * 256 + wr * 64 + fr, col0 = u.pn * 256 + wc * 32 + 8 * fq;
        const int mode = (u.pn == 1) ? 1 : (u.pn >= 6 ? 2 : 0);
#pragma unroll
        for (int ai = 0; ai < 2; ++ai)
#pragma unroll
            for (int m = 0; m < 4; ++m) { bf16* rowp = O + (size_t)(row0 + ai * 128 + m * 16) * EVEN_IN + col0;
#pragma unroll
                for (int bj = 0; bj < 2; ++bj) { f32x4 v0 = acc[ai][bj][m][0] * (IN8 ? W8_INV : 1.f), v1 = acc[ai][bj][m][1] * (IN8 ? W8_INV : 1.f);
                    if (mode == 1) { v0 = v0 * 0.125f; v1 = v1 * 0.125f; }
                    if (mode == 2) {
#pragma unroll
                        for (int j = 0; j < 4; ++j) { v0[j] = gelu_tanh(v0[j]); v1[j] = gelu_tanh(v1[j]); } }
                    v4u w; w.x = cvt_pk_bf16(v0[0], v0[1]); w.y = cvt_pk_bf16(v0[2], v0[3]); w.z = cvt_pk_bf16(v1[0], v1[1]); w.w = cvt_pk_bf16(v1[2], v1[3]);
                    *(v4u*)(rowp + bj * 128) = w; } }
    }
};
struct EpiRes {
    static constexpr bool PERM = true;
    const float* xlat; const float* xctx; bf16* X; const float* modl;
    __device__ __forceinline__ void operator()(const f32x4 (&acc)[2][2][4][2], const Unit& u, int wr, int wc, int fr, int fq) const {
        const int row0 = u.pm * 256 + wr * 64 + fr, col0 = u.pn * 256 + wc * 32 + 8 * fq;
        const bool lat = u.pm < (RL / 256); const int bb = lat ? (u.pm >> 4) : 8;
        const float* gp = modl + bb * 6144 + 2 * 1024 + col0;
        f32x4 gv[2][2];
#pragma unroll
        for (int bj = 0; bj < 2; ++bj)
#pragma unroll
            for (int n = 0; n < 2; ++n) gv[bj][n] = *(const f32x4*)(gp + bj * 128 + n * 4);
#pragma unroll
        for (int ai = 0; ai < 2; ++ai) {
            f32x4 x0[4][2], x1[4][2];
#pragma unroll
            for (int m = 0; m < 4; ++m) { const int r = row0 + ai * 128 + m * 16; const bf16* xo = X + (size_t)r * D + col0;
#pragma unroll
                for (int bj = 0; bj < 2; ++bj) {
                    if (xlat) { const float* xi = (lat ? xlat + (size_t)r * D : xctx + (size_t)(r - RL) * D) + col0 + bj * 128; x0[m][bj] = *(const f32x4*)xi; x1[m][bj] = *(const f32x4*)(xi + 4); }
                    else { const v4u xw = *(const v4u*)(xo + bj * 128); x0[m][bj] = (f32x4){bf_lo(xw.x), bf_hi(xw.x), bf_lo(xw.y), bf_hi(xw.y)}; x1[m][bj] = (f32x4){bf_lo(xw.z), bf_hi(xw.z), bf_lo(xw.w), bf_hi(xw.w)}; } } }
#pragma unroll
            for (int m = 0; m < 4; ++m) { const int r = row0 + ai * 128 + m * 16; bf16* xo = X + (size_t)r * D + col0;
#pragma unroll
                for (int bj = 0; bj < 2; ++bj) {
                    const f32x4 v0 = x0[m][bj] + gv[bj][0] * acc[ai][bj][m][0], v1 = x1[m][bj] + gv[bj][1] * acc[ai][bj][m][1];
                    v4u w; w.x = cvt_pk_bf16(v0[0], v0[1]); w.y = cvt_pk_bf16(v0[2], v0[3]); w.z = cvt_pk_bf16(v1[0], v1[1]); w.w = cvt_pk_bf16(v1[2], v1[3]);
                    *(v4u*)(xo + bj * 128) = w; } }
        }
    }
};
struct EpiQKV {
    static constexpr bool PERM = true;
    bf16 *Q, *K, *V; const float* rope;
    __device__ __forceinline__ void operator()(const f32x4 (&acc)[2][2][4][2], const Unit& u, int wr, int wc, int fr, int fq) const {
        const int row0 = u.pm * 256 + wr * 64 + fr; const int cin = wc * 32 + 8 * fq;
        const bool lat = u.pm < (RL / 256); const bool dorope = lat && (u.pn < 5);
        bf16* base; int ld;
        if (u.pn < 4) { base = Q + u.pn * 256; ld = 1024; } else if (u.pn == 4) { base = K; ld = 256; } else { base = V; ld = 256; }
        const int half = (cin >> 6) & 1, i0 = (cin & 63) >> 1;
#pragma unroll
        for (int ai = 0; ai < 2; ++ai)
#pragma unroll
            for (int m = 0; m < 4; ++m) { const int r = row0 + ai * 128 + m * 16; bf16* rowp = base + (size_t)r * ld + cin;
                f32x4 cs0 = {1.f, 0.f, 1.f, 0.f}, cs1 = {1.f, 0.f, 1.f, 0.f};
                if (dorope) { const int t = r & (SEQ - 1); const int pos = half ? (t & 63) : (t >> 6); const float* tp = rope + (size_t)(pos * 32 + i0) * 2; cs0 = *(const f32x4*)tp; cs1 = *(const f32x4*)(tp + 4); }
#pragma unroll
                for (int bj = 0; bj < 2; ++bj) { const f32x4 v0 = acc[ai][bj][m][0] * (QKV8 ? W8_INV : 1.f), v1 = acc[ai][bj][m][1] * (QKV8 ? W8_INV : 1.f);
                    const float a0 = v0[0] * cs0[0] - v0[1] * cs0[1], a1 = v0[1] * cs0[0] + v0[0] * cs0[1];
                    const float a2 = v0[2] * cs0[2] - v0[3] * cs0[3], a3 = v0[3] * cs0[2] + v0[2] * cs0[3];
                    const float a4 = v1[0] * cs1[0] - v1[1] * cs1[1], a5 = v1[1] * cs1[0] + v1[0] * cs1[1];
                    const float a6 = v1[2] * cs1[2] - v1[3] * cs1[3], a7 = v1[3] * cs1[2] + v1[2] * cs1[3];
                    v4u w; w.x = cvt_pk_bf16(a0, a1); w.y = cvt_pk_bf16(a2, a3); w.z = cvt_pk_bf16(a4, a5); w.w = cvt_pk_bf16(a6, a7);
                    *(v4u*)(rowp + bj * 128) = w; } }
    }
};
struct EpiMoe1 {
    static constexpr bool PERM = true;
    unsigned char* O;
    __device__ __forceinline__ void operator()(const f32x4 (&acc)[2][2][4][2], const Unit& u, int wr, int wc, int fr, int fq) const {
        const int row0 = u.pm * 256 + wr * 64 + fr, col0 = u.pn * 128 + wc * 32 + 8 * fq;
#pragma unroll
        for (int ai = 0; ai < 2; ++ai)
#pragma unroll
            for (int m = 0; m < 4; ++m) { unsigned char* rowp = O + (size_t)(row0 + ai * 128 + m * 16) * 1024 + col0;
                const f32x4 g0 = acc[ai][0][m][0] * W8_INV, g1 = acc[ai][0][m][1] * W8_INV, u0 = acc[ai][1][m][0] * (W8_INV * ACT8_SCALE), u1 = acc[ai][1][m][1] * (W8_INV * ACT8_SCALE);
                f32x4 v0, v1;
#pragma unroll
                for (int j = 0; j < 4; ++j) { v0[j] = clamp448(silu_f(g0[j]) * u0[j]); v1[j] = clamp448(silu_f(g1[j]) * u1[j]); }
                u32x2 w; w.x = cvt4_fp8(v0[0], v0[1], v0[2], v0[3]); w.y = cvt4_fp8(v1[0], v1[1], v1[2], v1[3]);
                *(u32x2*)rowp = w; }
    }
};
struct EpiBf8 {
    static constexpr bool PERM = true;
    bf16* O;
    __device__ __forceinline__ void operator()(const f32x4 (&acc)[2][2][4][2], const Unit& u, int wr, int wc, int fr, int fq) const {
        const int row0 = u.pm * 256 + wr * 64 + fr, col0 = u.pn * 256 + wc * 32 + 8 * fq;
#pragma unroll
        for (int ai = 0; ai < 2; ++ai)
#pragma unroll
            for (int m = 0; m < 4; ++m) { bf16* rowp = O + (size_t)(row0 + ai * 128 + m * 16) * 1024 + col0;
#pragma unroll
                for (int bj = 0; bj < 2; ++bj) { const f32x4 v0 = acc[ai][bj][m][0] * (W8_INV * ACT8_INV), v1 = acc[ai][bj][m][1] * (W8_INV * ACT8_INV);
                    v4u w; w.x = cvt_pk_bf16(v0[0], v0[1]); w.y = cvt_pk_bf16(v0[2], v0[3]); w.z = cvt_pk_bf16(v1[0], v1[1]); w.w = cvt_pk_bf16(v1[2], v1[3]);
                    *(v4u*)(rowp + bj * 128) = w; } }
    }
};

template <class RowMap>
__device__ __forceinline__ void p0_transpose_item(const float* W, int N, bf16* WT, const RowMap& rm, LAS float* scr, int item, int lane) {
    const int nblk = N / 32, kb = item / nblk, nb = item % nblk, k0 = 64 * kb, n0 = 32 * nb;
#pragma unroll 8
    for (int i = 0; i < 32; ++i) { const int kk = 2 * i + (lane >> 5); scr[kk * 33 + (lane & 31)] = W[(size_t)(k0 + kk) * N + n0 + (lane & 31)]; }
    LDS_WAIT(); asm volatile("" ::: "memory");
    const int c = lane & 7;
#pragma unroll
    for (int j = 0; j < 4; ++j) { const int n = (lane >> 3) + 8 * j; const LAS float* s = scr + (8 * c) * 33 + n;
        v4u o; o.x = cvt_pk_bf16(s[0 * 33], s[1 * 33]); o.y = cvt_pk_bf16(s[2 * 33], s[3 * 33]); o.z = cvt_pk_bf16(s[4 * 33], s[5 * 33]); o.w = cvt_pk_bf16(s[6 * 33], s[7 * 33]);
        *(v4u*)(WT + (size_t)rm(n0 + n) * 1024 + k0 + 8 * c) = o; }
    LDS_WAIT(); asm volatile("" ::: "memory");
}
template <class RowMap>
__device__ __forceinline__ void p0_transpose_item8(const float* W, int N, unsigned char* WT, const RowMap& rm, LAS float* scr, int item, int lane) {
    const int nblk = N / 32, kb = item / nblk, nb = item % nblk, k0 = 64 * kb, n0 = 32 * nb;
#pragma unroll 16
    for (int i = 0; i < 32; ++i) { const int kk = 2 * i + (lane >> 5); scr[kk * 33 + (lane & 31)] = W[(size_t)(k0 + kk) * N + n0 + (lane & 31)] * W8_SCALE; }
    LDS_WAIT(); asm volatile("" ::: "memory");
    const int c = lane & 7;
#pragma unroll
    for (int j = 0; j < 4; ++j) { const int n = (lane >> 3) + 8 * j; const LAS float* s = scr + (8 * c) * 33 + n;
        u32x2 o; o.x = cvt4_fp8(s[0 * 33], s[1 * 33], s[2 * 33], s[3 * 33]); o.y = cvt4_fp8(s[4 * 33], s[5 * 33], s[6 * 33], s[7 * 33]);
        *(u32x2*)(WT + (size_t)rm(n0 + n) * 1024 + k0 + 8 * c) = o; }
    LDS_WAIT(); asm volatile("" ::: "memory");
}
struct RmId { __device__ __forceinline__ int operator()(int n) const { return n; } };
struct RmGU { int type; __device__ __forceinline__ int operator()(int n) const { return ((n >> 7) << 8) + type * 128 + (n & 127); } };
struct RmQKV { __device__ __forceinline__ int operator()(int n) const { if (n >= 1280) return n; const int ps = n & 63; return (n & ~63) + (ps < 32 ? 2 * ps : 2 * (ps - 32) + 1); } };

__device__ __forceinline__ void p0_prologue(Frame& F) {
    LAS float* scr = (LAS float*)(F.lds + F.wave * 16384);
    const int gw = F.vcu * NWAVES + F.wave, NGW = F.G * NWAVES;
    constexpr int I_E = 512, N_EXP = 4 * 3 * 16 * I_E;
    constexpr int I_IN = 16 * 80, I_SQ = 512, I_QKV = 16 * 48;
    constexpr int NITEMS = N_EXP + 2 * I_IN + 2 * I_SQ + 2 * I_QKV + 2 * I_SQ;
    for (int it = gw; it < NITEMS; it += NGW) {
        int r = it;
        if (r < N_EXP) { const int mtx = r / I_E, item = r % I_E, layer = mtx / 48, rem = mtx % 48, type = rem / 16, e = rem % 16; const size_t mo = (size_t)(layer * 16 + e) * 1048576;
            if (type == 2) p0_transpose_item8(F.w_ed + mo, 1024, (unsigned char*)F.W2T + mo, RmId{}, scr, item, F.lane);
            else p0_transpose_item8((type ? F.w_eu : F.w_eg) + mo, 1024, (unsigned char*)F.W1T + 2 * mo, RmGU{type}, scr, item, F.lane);
            continue; }
        r -= N_EXP;
        if (r < 2 * I_IN) { const int i = r / I_IN; if (IN8) p0_transpose_item8(F.w_in_even + (size_t)i * 1024 * EVEN_IN, EVEN_IN, (unsigned char*)F.WIN + (size_t)i * EVEN_IN * 1024, RmId{}, scr, r % I_IN, F.lane); else p0_transpose_item(F.w_in_even + (size_t)i * 1024 * EVEN_IN, EVEN_IN, F.WIN + (size_t)i * EVEN_IN * 1024, RmId{}, scr, r % I_IN, F.lane); continue; } r -= 2 * I_IN;
        if (r < 2 * I_SQ) { const int i = r / I_SQ; p0_transpose_item(F.w_out_even + (size_t)i * 1048576, 1024, F.WOUT + (size_t)i * 1048576, RmId{}, scr, r % I_SQ, F.lane); continue; } r -= 2 * I_SQ;
        if (r < 2 * I_QKV) { const int i = r / I_QKV; if (QKV8) p0_transpose_item8(F.w_qkv + (size_t)i * 1024 * ODD_IN, ODD_IN, (unsigned char*)F.WQKV + (size_t)i * ODD_IN * 1024, RmQKV{}, scr, r % I_QKV, F.lane); else p0_transpose_item(F.w_qkv + (size_t)i * 1024 * ODD_IN, ODD_IN, F.WQKV + (size_t)i * ODD_IN * 1024, RmQKV{}, scr, r % I_QKV, F.lane); continue; } r -= 2 * I_QKV;
        { const int i = r / I_SQ; p0_transpose_item(F.w_o + (size_t)i * 1048576, 1024, F.WO + (size_t)i * 1048576, RmId{}, scr, r % I_SQ, F.lane); }
    }
    { const int gt = F.vcu * 512 + F.tid, GT = F.G * 512;
      for (int i = gt; i < 2 * 4 * 128 * 128 / 4; i += GT) { const f32x4 v = ((const f32x4*)F.sg_w)[i]; u32x2 w; w.x = cvt_pk_bf16(v[0], v[1]); w.y = cvt_pk_bf16(v[2], v[3]); ((u32x2*)F.SGW)[i] = w; }
      for (int i = gt; i < 64 * 32; i += GT) { const int pos = i >> 5, fi = i & 31; const float inv = fexp2(-(float)fi * (13.287712379549449f / 32.0f)); const float rev = __builtin_amdgcn_fractf((float)pos * inv * 0.15915494309189535f);
          F.ROPE[2 * i] = __builtin_amdgcn_cosf(rev); F.ROPE[2 * i + 1] = __builtin_amdgcn_sinf(rev); } }
    __syncthreads();
    LAS float* sc = (LAS float*)F.lds;
    LAS float* part = (LAS float*)(F.lds + 49152);
    for (int i = F.tid; i < 9 * 1024; i += 512) { const int bb = i >> 10, k = i & 1023; const float cv = bb < 8 ? F.c_in[bb * 1024 + k] : F.cctx_in[k]; sc[k * 12 + bb] = silu_f(cv); }
    __syncthreads();
    for (int it = F.vcu; it < 4 * 96; it += F.G) {
        const int l = it / 96, n = (it % 96) * 64 + F.lane;
        float a[9];
#pragma unroll
        for (int bb = 0; bb < 9; ++bb) a[bb] = 0.f;
        const float* wp = F.w_mod + ((size_t)l * 1024 + F.wave * 128) * 6144 + n;
#pragma unroll 8
        for (int k = 0; k < 128; ++k) { const float wv = wp[(size_t)k * 6144]; const LAS float* sp = sc + (F.wave * 128 + k) * 12;
            const f32x4 s0 = *(const LAS f32x4*)sp, s1 = *(const LAS f32x4*)(sp + 4); const float s8 = sp[8];
            a[0] += s0[0] * wv; a[1] += s0[1] * wv; a[2] += s0[2] * wv; a[3] += s0[3] * wv; a[4] += s1[0] * wv; a[5] += s1[1] * wv; a[6] += s1[2] * wv; a[7] += s1[3] * wv; a[8] += s8 * wv; }
#pragma unroll
        for (int bb = 0; bb < 9; ++bb) part[(F.wave * 9 + bb) * 64 + F.lane] = a[bb];
        __syncthreads();
        for (int i = F.tid; i < 9 * 64; i += 512) { const int bb = i >> 6, ln = i & 63; float s = 0.f;
#pragma unroll
            for (int w = 0; w < 8; ++w) s += part[(w * 9 + bb) * 64 + ln];
            const int nn = (it % 96) * 64 + ln; F.MOD[((size_t)l * 9 + bb) * 6144 + nn] = s + F.b_mod[l * 6144 + nn]; }
        __syncthreads();
    }
}

template <bool COMBINE, bool ROUTE, bool FINAL, bool FIN>
__device__ __forceinline__ void norm_phase(Frame& F, int l, int nrows, int sel, bool h8) {
    const int rpb = (nrows + F.G - 1) / F.G, r0 = F.vcu * rpb, r1 = (r0 + rpb < nrows) ? r0 + rpb : nrows;
    LAS float* wrl = (LAS float*)F.lds;
    LAS int* rinfo = (LAS int*)(F.lds + 81920);
    LAS int* lcnt = (LAS int*)(F.lds + 81920 + 12288);
    if (ROUTE) {
        for (int i = F.tid; i < 1024 * 4; i += 512) { const int k = i >> 2, q4 = i & 3; const f32x4 v = *(const f32x4*)(F.w_router + k * 16 + q4 * 4);
            *(LAS f32x4*)(wrl + (((k >> 8) * 4 + (k & 3)) * 64 + ((k >> 2) & 63)) * 20 + q4 * 4) = v; }
        if (F.tid < 16) lcnt[F.tid] = 0;
    }
    if (COMBINE) { if (F.tid == 0) { int s = 0;
#pragma unroll 1
        for (int e = 0; e < 16; ++e) { lcnt[32 + e] = s; const int cn = (int)__hip_atomic_load(F.ctl + CW_CNT + 64 * (l - 1) + e, RLX_AGENT); s += ((cn + 255) >> 8) << 8; } } }
    __syncthreads();
    const int cnt = (r1 - r0 - F.wave + 7) >> 3;
    typedef typename std::conditional<FIN, f32x4, u32x2>::type XR;
#define NP_ROW(i) ({ int _r = r0 + F.wave + 8 * (i); _r < r1 ? _r : r1 - 1; })
#define NP_LOAD_TK(dst, i) do { if constexpr (COMBINE) dst = F.TOK[NP_ROW(i)]; } while (0)
#define NP_LOAD_ROW(XQ_, O0, O1, TK, i) do { const int _rr = NP_ROW(i); \
        if constexpr (FIN) { const float* _xr = _rr < RL ? F.x_in + (size_t)_rr * D : F.ctx_in + (size_t)(_rr - RL) * D; \
            _Pragma("unroll") for (int j = 0; j < 4; ++j) XQ_[j] = ((const XR*)_xr)[F.lane + 64 * j]; } \
        else { _Pragma("unroll") for (int j = 0; j < 4; ++j) XQ_[j] = ((const XR*)(F.X + (size_t)_rr * D))[F.lane + 64 * j]; } \
        if constexpr (COMBINE) { const int _s0 = lcnt[32 + (TK.x & 15)] + (int)(TK.x >> 4), _s1 = lcnt[32 + (TK.y & 15)] + (int)(TK.y >> 4); \
            const u32x2* _o0 = (const u32x2*)(F.CS + (size_t)_s0 * 1024); const u32x2* _o1 = (const u32x2*)(F.CS + (size_t)_s1 * 1024); \
            _Pragma("unroll") for (int j = 0; j < 4; ++j) { O0[j] = _o0[F.lane + 64 * j]; O1[j] = _o1[F.lane + 64 * j]; } } } while (0)
    if (cnt > 0) {
        v4u tkA = {0u, 0u, 0u, 0u}, tkB = tkA; XR xa[4], xn[4]; u32x2 oa0[4], oa1[4], on0[4], on1[4];
#pragma unroll
        for (int j = 0; j < 4; ++j) { oa0[j] = (u32x2){0u, 0u}; oa1[j] = oa0[j]; on0[j] = oa0[j]; on1[j] = oa0[j]; }
        NP_LOAD_TK(tkA, 0); NP_LOAD_TK(tkB, 1);
        NP_LOAD_ROW(xa, oa0, oa1, tkA, 0);
#pragma unroll 1
        for (int i = 0; i < cnt; ++i) {
            const int r = r0 + F.wave + 8 * i;
            v4u tkC = tkB; NP_LOAD_TK(tkC, i + 2);
            NP_LOAD_ROW(xn, on0, on1, tkB, i + 1);
            const int bb = r < RL ? (r >> 12) : 8;
            f32x4 v[4];
#pragma unroll
            for (int j = 0; j < 4; ++j) { if constexpr (FIN) v[j] = xa[j]; else v[j] = (f32x4){bf_lo(xa[j].x), bf_hi(xa[j].x), bf_lo(xa[j].y), bf_hi(xa[j].y)}; }
            if (COMBINE) {
                const float w0 = __uint_as_float(tkA.z), w1 = __uint_as_float(tkA.w);
                const float* g2 = F.MOD + ((size_t)(l - 1) * 9 + bb) * 6144 + 5 * 1024;
#pragma unroll
                for (int j = 0; j < 4; ++j) { const u32x2 a = oa0[j], b = oa1[j]; const f32x4 gg = ((const f32x4*)g2)[F.lane + 64 * j];
                    v[j][0] += gg[0] * (w0 * bf_lo(a.x) + w1 * bf_lo(b.x)); v[j][1] += gg[1] * (w0 * bf_hi(a.x) + w1 * bf_hi(b.x));
                    v[j][2] += gg[2] * (w0 * bf_lo(a.y) + w1 * bf_lo(b.y)); v[j][3] += gg[3] * (w0 * bf_hi(a.y) + w1 * bf_hi(b.y)); }
                if (!FINAL) {
#pragma unroll
                    for (int j = 0; j < 4; ++j) { u32x2 w; w.x = cvt_pk_bf16(v[j][0], v[j][1]); w.y = cvt_pk_bf16(v[j][2], v[j][3]); ((u32x2*)(F.X + (size_t)r * D))[F.lane + 64 * j] = w; } }
            }
            float ss = 0.f;
#pragma unroll
            for (int j = 0; j < 4; ++j) ss += (v[j][0] * v[j][0] + v[j][1] * v[j][1]) + (v[j][2] * v[j][2] + v[j][3] * v[j][3]);
            const float rstd = frsq(wave_sum(ss, F.lane) * (1.0f / D) + EPS);
            if (FINAL) {
#pragma unroll
                for (int j = 0; j < 4; ++j) { const f32x4 fg = ((const f32x4*)F.final_g)[F.lane + 64 * j]; ((f32x4*)(F.out + (size_t)r * D))[F.lane + 64 * j] = v[j] * rstd * fg; }
            } else {
                const float* ng = F.norm_g + (size_t)(l * 2 + sel) * D; const float* md = F.MOD + ((size_t)l * 9 + bb) * 6144;
                const float* shp = md + (sel ? 3 : 0) * 1024; const float* scp = md + (sel ? 4 : 1) * 1024;
                f32x4 h[4];
#pragma unroll
                for (int j = 0; j < 4; ++j) { const f32x4 g = ((const f32x4*)ng)[F.lane + 64 * j], sc = ((const f32x4*)scp)[F.lane + 64 * j], sh = ((const f32x4*)shp)[F.lane + 64 * j];
                    h[j] = v[j] * rstd * g * (sc + 1.0f) + sh;
                    if (h8) ((unsigned*)((unsigned char*)F.H + (size_t)r * D))[F.lane + 64 * j] = cvt4_fp8(h[j][0], h[j][1], h[j][2], h[j][3]);
                    else { u32x2 w; w.x = cvt_pk_bf16(h[j][0], h[j][1]); w.y = cvt_pk_bf16(h[j][2], h[j][3]); ((u32x2*)(F.H + (size_t)r * D))[F.lane + 64 * j] = w; } }
                if (ROUTE) {
                    float a[16];
#pragma unroll
                    for (int e = 0; e < 16; ++e) a[e] = 0.f;
#pragma unroll
                    for (int j = 0; j < 4; ++j)
#pragma unroll
                        for (int q = 0; q < 4; ++q) { const LAS float* wp = wrl + ((j * 4 + q) * 64 + F.lane) * 20; const float hk = h[j][q];
                            const f32x4 w0 = *(const LAS f32x4*)wp, w1 = *(const LAS f32x4*)(wp + 4), w2 = *(const LAS f32x4*)(wp + 8), w3 = *(const LAS f32x4*)(wp + 12);
                            a[0] += hk * w0[0]; a[1] += hk * w0[1]; a[2] += hk * w0[2]; a[3] += hk * w0[3]; a[4] += hk * w1[0]; a[5] += hk * w1[1]; a[6] += hk * w1[2]; a[7] += hk * w1[3];
                            a[8] += hk * w2[0]; a[9] += hk * w2[1]; a[10] += hk * w2[2]; a[11] += hk * w2[3]; a[12] += hk * w3[0]; a[13] += hk * w3[1]; a[14] += hk * w3[2]; a[15] += hk * w3[3]; }
                    float mx = -3.0e38f;
#pragma unroll
                    for (int e = 0; e < 16; ++e) { a[e] = wave_sum(a[e], F.lane) + F.b_router[e]; mx = fmaxf(mx, a[e]); }
#pragma unroll
                    for (int e = 0; e < 16; ++e) a[e] = fexp(a[e] - mx);
                    float bs = -1.f, ba = 0.f, bbv = 0.f; int bi0 = 0, bi1 = 1;
#pragma unroll
                    for (int g = 0; g < 4; ++g) {
                        float p0 = a[4 * g]; int i0 = 0;
#pragma unroll
                        for (int k = 1; k < 4; ++k) if (a[4 * g + k] > p0) { p0 = a[4 * g + k]; i0 = k; }
                        float p1 = -1.f; int i1 = 0;
#pragma unroll
                        for (int k = 0; k < 4; ++k) if (k != i0 && a[4 * g + k] > p1) { p1 = a[4 * g + k]; i1 = k; }
                        const float gs = p0 + p1;
                        if (gs > bs) { bs = gs; ba = p0; bbv = p1; bi0 = 4 * g + i0; bi1 = 4 * g + i1; }
                    }
                    if (F.lane == 0) { const float inv = 1.0f / (ba + bbv);
                        const int lp0 = atomicAdd((int*)(lcnt + bi0), 1), lp1 = atomicAdd((int*)(lcnt + bi1), 1);
                        LAS int* ri = rinfo + (r - r0) * 6; ri[0] = bi0; ri[1] = lp0; ri[2] = bi1; ri[3] = lp1; ri[4] = (int)__float_as_uint(ba * inv); ri[5] = (int)__float_as_uint(bbv * inv); }
                }
            }
#pragma unroll
            for (int j = 0; j < 4; ++j) { xa[j] = xn[j]; oa0[j] = on0[j]; oa1[j] = on1[j]; }
            tkA = tkB; tkB = tkC;
        }
    }
#undef NP_ROW
#undef NP_LOAD_TK
#undef NP_LOAD_ROW
    if (ROUTE) {
        __syncthreads();
        if (F.tid < 16) lcnt[16 + F.tid] = (int)__hip_atomic_fetch_add(F.ctl + CW_CNT + 64 * l + F.tid, (unsigned)lcnt[F.tid], RLX_AGENT);
        __syncthreads();
        for (int i = F.tid; i < r1 - r0; i += 512) { const LAS int* ri = rinfo + i * 6; const int e0 = ri[0], e1 = ri[2], p0 = lcnt[16 + e0] + ri[1], p1 = lcnt[16 + e1] + ri[3];
            v4u tk; tk.x = (unsigned)e0 | ((unsigned)p0 << 4); tk.y = (unsigned)e1 | ((unsigned)p1 << 4); tk.z = (unsigned)ri[4]; tk.w = (unsigned)ri[5]; F.TOK[r0 + i] = tk;
            F.LIST[(size_t)e0 * RT + p0] = r0 + i; F.LIST[(size_t)e1 * RT + p1] = r0 + i; }
    }
    __syncthreads();
}

__device__ __forceinline__ const LAS int* moe_table(Frame& F, int l) {
    LAS int* tab = (LAS int*)(F.MISC + 16);
    __syncthreads();
    if (F.tid == 0) { int s = 0;
#pragma unroll 1
        for (int e = 0; e < 16; ++e) { const int cn = (int)__hip_atomic_load(F.ctl + CW_CNT + 64 * l + e, RLX_AGENT); tab[e] = s; tab[32 + e] = cn; s += (cn + 255) >> 8; } tab[16] = s; }
    __syncthreads();
    return tab;
}

#define MMA16(acc, afrag, bfrag) acc = __builtin_amdgcn_mfma_f32_16x16x32_bf16(bfrag, afrag, acc, 0, 0, 0)
constexpr int TP = 136;
__device__ __forceinline__ int chunk_row0(int b, int c) { return c < 2 ? RL + b * LC + c * 128 : b * SEQ + (c - 2) * 128; }

__device__ __forceinline__ void stage_vt(Frame& F, LAS bf16* VT, const bf16* src  , int ld) {
    const int j = F.tid >> 2, e0 = (F.tid & 3) * 32;
    const v4u* p = (const v4u*)(src + (size_t)j * ld + e0);
    v4u q[4];
#pragma unroll
    for (int t = 0; t < 4; ++t) q[t] = p[t];
#pragma unroll
    for (int t = 0; t < 4; ++t) { const unsigned w[4] = {q[t].x, q[t].y, q[t].z, q[t].w};
#pragma unroll
        for (int k = 0; k < 4; ++k) { VT[(e0 + t * 8 + 2 * k) * TP + j] = (bf16)(w[k] & 0xffffu); VT[(e0 + t * 8 + 2 * k + 1) * TP + j] = (bf16)(w[k] >> 16); } }
}

__device__ __forceinline__ void ret_kv_phase(Frame& F, int li) {
    LAS bf16* KTf = (LAS bf16*)F.lds; LAS bf16* KTb = KTf + 64 * TP; LAS bf16* VT = KTb + 64 * TP;
    const int fr = F.lane & 15, fq = F.lane >> 4;
    for (int u = F.vcu; u < NB * NCH * 4; u += F.G) {
        const int h = u & 3, c = (u >> 2) % NCH, b = u / (NCH * 4); const int row0 = chunk_row0(b, c);
        const float l2f = -fexp(F.ret_ld[(li * 2 + 0) * 4 + h]) * 1.4426950409f, l2b = -fexp(F.ret_ld[(li * 2 + 1) * 4 + h]) * 1.4426950409f;
        { const int j = F.tid >> 2, d0 = (F.tid & 3) * 16; const v4u* kp = (const v4u*)(F.BIG + (size_t)(row0 + j) * EVEN_IN + 256 + h * 64 + d0);
          const v4u k0 = kp[0], k1 = kp[1]; const float wf = fexp2((float)(127 - j) * l2f), wb = fexp2((float)j * l2b);
          const unsigned w[8] = {k0.x, k0.y, k0.z, k0.w, k1.x, k1.y, k1.z, k1.w};
#pragma unroll
          for (int k = 0; k < 8; ++k) { const float lo = bf_lo(w[k]), hi = bf_hi(w[k]);
              KTf[(d0 + 2 * k) * TP + j] = f2bf(lo * wf); KTf[(d0 + 2 * k + 1) * TP + j] = f2bf(hi * wf);
              KTb[(d0 + 2 * k) * TP + j] = f2bf(lo * wb); KTb[(d0 + 2 * k + 1) * TP + j] = f2bf(hi * wb); } }
        stage_vt(F, VT, F.BIG + (size_t)row0 * EVEN_IN + 512 + h * 128, EVEN_IN);
        __syncthreads();
        const int dir = F.wave >> 2, mp = F.wave & 3; const LAS bf16* KT = dir ? KTb : KTf;
        f32x4 acc[2][4];
#pragma unroll
        for (int mi = 0; mi < 2; ++mi)
#pragma unroll
            for (int n = 0; n < 4; ++n) acc[mi][n] = (f32x4){0.f, 0.f, 0.f, 0.f};
#pragma unroll
        for (int ks = 0; ks < 4; ++ks) { bf16x8 bv[4];
#pragma unroll
            for (int n = 0; n < 4; ++n) bv[n] = *(const LAS bf16x8*)(KT + (16 * n + fr) * TP + 32 * ks + 8 * fq);
#pragma unroll
            for (int mi = 0; mi < 2; ++mi) { const bf16x8 a = *(const LAS bf16x8*)(VT + (32 * mp + 16 * mi + fr) * TP + 32 * ks + 8 * fq);
#pragma unroll
                for (int n = 0; n < 4; ++n) MMA16(acc[mi][n], a, bv[n]); } }
        float* op = F.KV + ((size_t)(((b * NCH + c) * 4 + h) * 2 + dir) * 128 + 32 * mp + fr) * 64 + 4 * fq;
#pragma unroll
        for (int mi = 0; mi < 2; ++mi)
#pragma unroll
            for (int n = 0; n < 4; ++n) *(f32x4*)(op + (size_t)mi * 16 * 64 + 16 * n) = acc[mi][n];
        __syncthreads();
    }
}

__device__ __forceinline__ void ret_scan_phase(Frame& F, int li) {
    const int gt = F.vcu * 512 + F.tid, GT = F.G * 512;
    for (int it = gt; it < 64 * 128 * 16; it += GT) {
        const int dg = it & 15, e = (it >> 4) & 127, chain = it >> 11, dir = chain & 1, h = (chain >> 1) & 3, b = chain >> 3;
        const float l2 = -fexp(F.ret_ld[(li * 2 + dir) * 4 + h]) * 1.4426950409f; const float cd = fexp2(128.f * l2);
        f32x4 s = {0.f, 0.f, 0.f, 0.f};
        const size_t eo = (size_t)e * 64 + 4 * dg;
#define SC_BLK(st) ((size_t)(((b * NCH + (dir ? ((st) == 0 ? 1 : ((st) == 1 ? 0 : 35 - (st))) : (st))) * 4 + h) * 2 + dir) * 8192)
#pragma unroll 1
        for (int s0 = 0; s0 < NCH; s0 += 8) {
            f32x4 kvv[8];
#pragma unroll
            for (int k = 0; k < 8; ++k) { const int st = (s0 + k < NCH) ? s0 + k : NCH - 1; kvv[k] = *(const f32x4*)(F.KV + SC_BLK(st) + eo); }
#pragma unroll
            for (int k = 0; k < 8; ++k) { if (s0 + k < NCH) { u32x2 w; w.x = cvt_pk_bf16(s[0], s[1]); w.y = cvt_pk_bf16(s[2], s[3]);
                *(u32x2*)(F.ST + SC_BLK(s0 + k) + eo) = w; s = s * cd + kvv[k]; } }
        }
#undef SC_BLK
    }
}

__device__ __forceinline__ void mixer_phase(Frame& F, int li) {
    LAS bf16* VT = (LAS bf16*)F.lds; LAS bf16* PB = VT + 128 * TP; LAS bf16* SN = PB + 128 * TP; LAS f32x2* stats = (LAS f32x2*)(F.lds + 3 * 128 * TP * 2);
    const int fr = F.lane & 15, fq = F.lane >> 4, irow = 16 * F.wave + fr;
    for (int u = F.vcu; u < NB * NCH * 4; u += F.G) {
        const int h = u & 3, c = (u >> 2) % NCH, b = u / (NCH * 4), row0 = chunk_row0(b, c); const size_t grow = (size_t)(row0 + irow);
        const bf16* Pr = F.BIG + grow * EVEN_IN;
        const float l2f = -fexp(F.ret_ld[(li * 2 + 0) * 4 + h]) * 1.4426950409f, l2b = -fexp(F.ret_ld[(li * 2 + 1) * 4 + h]) * 1.4426950409f;
        bf16x8 qf[2], kf[8][2];
#pragma unroll
        for (int ks = 0; ks < 2; ++ks) qf[ks] = *(const bf16x8*)(Pr + h * 64 + 32 * ks + 8 * fq);
#pragma unroll
        for (int n = 0; n < 8; ++n)
#pragma unroll
            for (int ks = 0; ks < 2; ++ks) kf[n][ks] = *(const bf16x8*)(F.BIG + (size_t)(row0 + 16 * n + fr) * EVEN_IN + 256 + h * 64 + 32 * ks + 8 * fq);
        stage_vt(F, VT, F.BIG + (size_t)row0 * EVEN_IN + 512 + h * 128, EVEN_IN);
        { v4u sv[16];
#pragma unroll
          for (int tt = 0; tt < 16; ++tt) sv[tt] = *(const v4u*)(F.BIG + (size_t)(row0 + 16 * F.wave + tt) * EVEN_IN + 2048 + 8 * F.lane);
#pragma unroll
          for (int tt = 0; tt < 16; ++tt) { const float x[8] = {bf_lo(sv[tt].x), bf_hi(sv[tt].x), bf_lo(sv[tt].y), bf_hi(sv[tt].y), bf_lo(sv[tt].z), bf_hi(sv[tt].z), bf_lo(sv[tt].w), bf_hi(sv[tt].w)};
            float s = 0.f;
#pragma unroll
            for (int k = 0; k < 8; ++k) s += x[k];
            const float mean = wave_sum(s, F.lane) * (1.0f / 512.0f); float q = 0.f;
#pragma unroll
            for (int k = 0; k < 8; ++k) q += (x[k] - mean) * (x[k] - mean);
            const float rstd = frsq(wave_sum(q, F.lane) * (1.0f / 512.0f) + EPS);
            if (F.lane == 0) stats[16 * F.wave + tt] = (f32x2){mean, rstd}; } }
        __syncthreads();
        {
            const int qt = F.tid >> 2, c0 = (F.tid & 3) * 32; const f32x2 st = stats[qt];
            const v4u* p = (const v4u*)(F.BIG + (size_t)(row0 + qt) * EVEN_IN + 2048 + h * 128 + c0);
            const float* lg = F.sg_ln_g + li * 512 + h * 128 + c0; const float* lb = F.sg_ln_b + li * 512 + h * 128 + c0;
#pragma unroll
            for (int t = 0; t < 4; ++t) { const v4u sv = p[t]; const unsigned w[4] = {sv.x, sv.y, sv.z, sv.w}; const f32x4 g0 = *(const f32x4*)(lg + 8 * t), g1 = *(const f32x4*)(lg + 8 * t + 4), b0 = *(const f32x4*)(lb + 8 * t), b1 = *(const f32x4*)(lb + 8 * t + 4);
                const float gg[8] = {g0[0], g0[1], g0[2], g0[3], g1[0], g1[1], g1[2], g1[3]}, bbv[8] = {b0[0], b0[1], b0[2], b0[3], b1[0], b1[1], b1[2], b1[3]};
#pragma unroll
                for (int k = 0; k < 4; ++k) { const float lo = (bf_lo(w[k]) - st.x) * st.y * gg[2 * k] + bbv[2 * k], hi = (bf_hi(w[k]) - st.x) * st.y * gg[2 * k + 1] + bbv[2 * k + 1];
                    SN[(c0 + 8 * t + 2 * k) * TP + qt] = f2bf(lo); SN[(c0 + 8 * t + 2 * k + 1) * TP + qt] = f2bf(hi); } }
        }
        {
            f32x4 acc[8];
#pragma unroll
            for (int n = 0; n < 8; ++n) acc[n] = (f32x4){0.f, 0.f, 0.f, 0.f};
#pragma unroll
            for (int n = 0; n < 8; ++n)
#pragma unroll
                for (int ks = 0; ks < 2; ++ks) MMA16(acc[n], qf[ks], kf[n][ks]);
#pragma unroll
            for (int n = 0; n < 8; ++n) { float pv[4];
#pragma unroll
                for (int r = 0; r < 4; ++r) { const int dl = irow - (16 * n + 4 * fq + r); const float dec = dl > 0 ? fexp2((float)dl * l2f) : (dl < 0 ? fexp2((float)(-dl) * l2b) : 2.0f); pv[r] = acc[n][r] * dec; }
                u32x2 w; w.x = cvt_pk_bf16(pv[0], pv[1]); w.y = cvt_pk_bf16(pv[2], pv[3]); *(LAS u32x2*)(PB + irow * TP + 16 * n + 4 * fq) = w; }
        }
        const bf16* sp = F.ST + (size_t)((((b * NCH + c) * 4 + h) * 2) * 128 + fr) * 64 + 8 * fq;
        bf16x8 sfr[8][2];
#pragma unroll
        for (int n = 0; n < 8; ++n)
#pragma unroll
            for (int ks = 0; ks < 2; ++ks) sfr[n][ks] = *(const bf16x8*)(sp + (16 * n) * 64 + 32 * ks);
        LDS_WAIT();
        f32x4 ao[8];
#pragma unroll
        for (int n = 0; n < 8; ++n) ao[n] = (f32x4){0.f, 0.f, 0.f, 0.f};
#pragma unroll
        for (int ks = 0; ks < 4; ++ks) { const bf16x8 a = *(const LAS bf16x8*)(PB + irow * TP + 32 * ks + 8 * fq);
#pragma unroll
            for (int n = 0; n < 8; ++n) { const bf16x8 bv = *(const LAS bf16x8*)(VT + (16 * n + fr) * TP + 32 * ks + 8 * fq); MMA16(ao[n], a, bv); } }
#pragma unroll
        for (int dir = 0; dir < 2; ++dir) {
            const float xi = dir ? fexp2((float)(128 - irow) * l2b) : fexp2((float)(irow + 1) * l2f);
            f32x4 ax[8];
#pragma unroll
            for (int n = 0; n < 8; ++n) ax[n] = (f32x4){0.f, 0.f, 0.f, 0.f};
#pragma unroll
            for (int n = 0; n < 8; ++n)
#pragma unroll
                for (int ks = 0; ks < 2; ++ks) MMA16(ax[n], qf[ks], sfr[n][ks]);
            if (dir == 0) {
#pragma unroll
                for (int n = 0; n < 8; ++n)
#pragma unroll
                    for (int ks = 0; ks < 2; ++ks) sfr[n][ks] = *(const bf16x8*)(sp + 128 * 64 + (16 * n) * 64 + 32 * ks); }
#pragma unroll
            for (int n = 0; n < 8; ++n) ao[n] = ao[n] + ax[n] * xi;
        }
        float s = 0.f;
#pragma unroll
        for (int n = 0; n < 8; ++n) s += (ao[n][0] + ao[n][1]) + (ao[n][2] + ao[n][3]);
        s = col_sum4(s);
        const float mean = s * (1.0f / 128.0f); float q = 0.f;
#pragma unroll
        for (int n = 0; n < 8; ++n) { const f32x4 d = ao[n] - mean; q += (d[0] * d[0] + d[1] * d[1]) + (d[2] * d[2] + d[3] * d[3]); }
        q = col_sum4(q);
        const float rstd = frsq(q * (1.0f / 128.0f) + EPS);
#pragma unroll
        for (int n = 0; n < 8; ++n) { const int e0 = 16 * n + 4 * fq; const u32x2 gt = *(const u32x2*)(Pr + 1024 + h * 128 + e0); const f32x4 gn = *(const f32x4*)(F.ret_gn + li * 512 + h * 128 + e0);
            const float y0 = (ao[n][0] - mean) * rstd * gn[0] * silu_f(bf_lo(gt.x)), y1 = (ao[n][1] - mean) * rstd * gn[1] * silu_f(bf_hi(gt.x));
            const float y2 = (ao[n][2] - mean) * rstd * gn[2] * silu_f(bf_lo(gt.y)), y3 = (ao[n][3] - mean) * rstd * gn[3] * silu_f(bf_hi(gt.y));
            u32x2 w; w.x = cvt_pk_bf16(y0, y1); w.y = cvt_pk_bf16(y2, y3); *(u32x2*)(F.MIX + grow * D + h * 128 + e0) = w; }
        __syncthreads();
        {
            f32x4 acc[8];
#pragma unroll
            for (int n = 0; n < 8; ++n) acc[n] = (f32x4){0.f, 0.f, 0.f, 0.f};
#pragma unroll
            for (int ks = 0; ks < 4; ++ks) { const bf16x8 a = *(const bf16x8*)(F.SGW + ((size_t)(li * 4 + h) * 128 + irow) * 128 + 32 * ks + 8 * fq);
#pragma unroll
                for (int n = 0; n < 8; ++n) { const bf16x8 bv = *(const LAS bf16x8*)(SN + (16 * n + fr) * TP + 32 * ks + 8 * fq); MMA16(acc[n], a, bv); } }
            const float bsv = F.sg_b[(li * 4 + h) * 128 + irow];
#pragma unroll
            for (int n = 0; n < 8; ++n) { const int c0 = 16 * n + 4 * fq; const u32x2 uu = *(const u32x2*)(Pr + 1536 + h * 128 + c0);
                u32x2 w; w.x = cvt_pk_bf16(bf_lo(uu.x) * (acc[n][0] + bsv), bf_hi(uu.x) * (acc[n][1] + bsv)); w.y = cvt_pk_bf16(bf_lo(uu.y) * (acc[n][2] + bsv), bf_hi(uu.y) * (acc[n][3] + bsv));
                *(u32x2*)(F.MIX + grow * D + 512 + h * 128 + c0) = w; }
        }
        __syncthreads();
    }
}

namespace att {
constexpr int QBLK = 32, KVBLK = 64, DH = 128;
constexpr float SCALE = 0.088388347648318440f;
constexpr float THR = 8.f;
constexpr int LDQ = 1024, LDK = 256, LDO = 1024;
constexpr size_t SHM_V = KVBLK * DH * 2, SHM_K = KVBLK * DH * 2, SHM_ATTN = 2 * SHM_V + 2 * SHM_K + NWAVES * 64 * 4;
#define KSWZ(row, colB) ((row) * 256 + ((colB) ^ (((row) & 7) << 4)))
#define SBAR() __builtin_amdgcn_sched_barrier(0)
__device__ __forceinline__ int crow(int r, int hi) { return (r & 3) + 8 * (r >> 2) + 4 * hi; }
__device__ __forceinline__ void partialSM(f32x16& p0, f32x16& p1, float& m_reg, float& mn, float& alpha) {
  constexpr float C = SCALE * 1.4426950408889634f;
  float pmax = p0[0]; for (int r = 1; r < 16; ++r) pmax = fmaxf(pmax, p0[r]); for (int r = 0; r < 16; ++r) pmax = fmaxf(pmax, p1[r]);
  { auto rr = __builtin_amdgcn_permlane32_swap(__float_as_uint(pmax), __float_as_uint(pmax), false, false);
    pmax = fmaxf(__uint_as_float(rr[0]), __uint_as_float(rr[1])); }
  if (__builtin_expect(__all(pmax - m_reg <= THR / SCALE), 1)) { mn = m_reg; alpha = 1.f; }
  else { mn = fmaxf(m_reg, pmax); alpha = __builtin_amdgcn_exp2f((m_reg - mn) * C); m_reg = mn; }
  float mnC = -mn * C;
  for (int r = 0; r < 16; ++r) p0[r] = fmaf(p0[r], C, mnC); for (int r = 0; r < 16; ++r) p1[r] = fmaf(p1[r], C, mnC);
  for (int r = 0; r < 16; ++r) p0[r] = __builtin_amdgcn_exp2f(p0[r]);
}
__device__ __forceinline__ void finishSM(f32x16& p0, f32x16& p1, float alpha, float& l_reg, bf16x8& pa0, bf16x8& pa1, bf16x8& pa2, bf16x8& pa3) {
  for (int r = 0; r < 16; ++r) p1[r] = __builtin_amdgcn_exp2f(p1[r]);
  float ps = 0; for (int r = 0; r < 16; ++r) ps += p0[r]; for (int r = 0; r < 16; ++r) ps += p1[r];
  { auto rr = __builtin_amdgcn_permlane32_swap(__float_as_uint(ps), __float_as_uint(ps), false, false);
    ps = __uint_as_float(rr[0]) + __uint_as_float(rr[1]); }
  l_reg = l_reg * alpha + ps;
#define PK4(P, BASE, OUT) do { unsigned a0 = cvt_pk_bf16(P[BASE + 0], P[BASE + 1]), a1 = cvt_pk_bf16(P[BASE + 2], P[BASE + 3]);   \
    unsigned b0 = cvt_pk_bf16(P[BASE + 4], P[BASE + 5]), b1 = cvt_pk_bf16(P[BASE + 6], P[BASE + 7]);                              \
    auto r0 = __builtin_amdgcn_permlane32_swap(a0, b0, false, false); auto r1 = __builtin_amdgcn_permlane32_swap(a1, b1, false, false); \
    v4u w = {r0[0], r1[0], r0[1], r1[1]}; OUT = *reinterpret_cast<bf16x8*>(&w); } while (0)
  PK4(p0, 0, pa0); PK4(p0, 8, pa1); PK4(p1, 0, pa2); PK4(p1, 8, pa3);
#undef PK4
}
__device__ __forceinline__ void qkt(f32x16& p0, f32x16& p1, const int (&kb4)[4], int boff, const bf16x8* qr) {
  p0 = f32x16{}; p1 = f32x16{};
#pragma unroll
  for (int d0 = 0; d0 < 8; ++d0) { const LAS char* kp = (const LAS char*)(uintptr_t)(unsigned)(kb4[d0 & 3] + boff);
    bf16x8 b0 = *reinterpret_cast<const LAS bf16x8*>(kp + (d0 >> 2) * 128);
    bf16x8 b1 = *reinterpret_cast<const LAS bf16x8*>(kp + (d0 >> 2) * 128 + 8192);
    p0 = __builtin_amdgcn_mfma_f32_32x32x16_bf16(b0, qr[d0], p0, 0, 0, 0);
    p1 = __builtin_amdgcn_mfma_f32_32x32x16_bf16(b1, qr[d0], p1, 0, 0, 0); }
}
__device__ __forceinline__ void mask_tile(f32x16& p0, f32x16& p1, int mk, int jb, int i, int hi) {
  if (mk == 1) { for (int r = 0; r < 16; ++r) { const int j = jb + crow(r, hi); p0[r] = (j >= i) ? p0[r] : -1e30f; p1[r] = (j + 32 >= i) ? p1[r] : -1e30f; } }
  else if (mk == 2) { for (int r = 0; r < 16; ++r) { const int j = jb + crow(r, hi); p0[r] = (j <= i) ? p0[r] : -1e30f; p1[r] = (j + 32 <= i) ? p1[r] : -1e30f; } }
}
__device__ __forceinline__ int v_st(int k, int c) { const int kk = (k & ~0xC) | ((k & 4) << 1) | ((k & 8) >> 1); return ((kk >> 3) * 4 + (c >> 5)) * 512 + ((kk & 7) * 32 + (c & 31)) * 2; }
__device__ __forceinline__ int v_rd_base(int lane) { return ((lane & 3) << 3) | (((lane >> 2) & 3) << 6) | (((lane >> 4) & 1) << 5) | (((lane >> 5) & 1) << 8); }
constexpr int v_rd_off(int d0, int ks, int half) { return d0 * 512 + ks * 4096 + half * 2048; }
template <int OFF> __device__ __forceinline__ s16x4 tr_read(int vb) {
  s16x4 r; asm volatile("ds_read_b64_tr_b16 %0, %1 offset:%2" : "=&v"(r) : "v"(vb), "i"(OFF) : "memory"); return r;
}
template <int D0> __device__ __forceinline__ void pv_one(f32x16& od, int vb, bf16x8 pa0, bf16x8 pa1, bf16x8 pa2, bf16x8 pa3) {
  const s16x4 l0 = tr_read<v_rd_off(D0, 0, 0)>(vb), h0 = tr_read<v_rd_off(D0, 0, 1)>(vb), l1 = tr_read<v_rd_off(D0, 1, 0)>(vb), h1 = tr_read<v_rd_off(D0, 1, 1)>(vb);
  const s16x4 l2 = tr_read<v_rd_off(D0, 2, 0)>(vb), h2 = tr_read<v_rd_off(D0, 2, 1)>(vb), l3 = tr_read<v_rd_off(D0, 3, 0)>(vb), h3 = tr_read<v_rd_off(D0, 3, 1)>(vb);
  asm volatile("s_waitcnt lgkmcnt(0)" ::: "memory"); SBAR();
#define PK(L, H) (bf16x8){L[0], L[1], L[2], L[3], H[0], H[1], H[2], H[3]}
  od = __builtin_amdgcn_mfma_f32_32x32x16_bf16(pa0, PK(l0, h0), od, 0, 0, 0);
  od = __builtin_amdgcn_mfma_f32_32x32x16_bf16(pa1, PK(l1, h1), od, 0, 0, 0);
  od = __builtin_amdgcn_mfma_f32_32x32x16_bf16(pa2, PK(l2, h2), od, 0, 0, 0);
  od = __builtin_amdgcn_mfma_f32_32x32x16_bf16(pa3, PK(l3, h3), od, 0, 0, 0);
#undef PK
}
__device__ __forceinline__ void pv_d0(f32x16* o, int vb, bf16x8 pa0, bf16x8 pa1, bf16x8 pa2, bf16x8 pa3) {
  pv_one<0>(o[0], vb, pa0, pa1, pa2, pa3); pv_one<1>(o[1], vb, pa0, pa1, pa2, pa3); pv_one<2>(o[2], vb, pa0, pa1, pa2, pa3); pv_one<3>(o[3], vb, pa0, pa1, pa2, pa3);
}

__device__ __forceinline__ void attn_unit(const bf16* __restrict__ Q, const bf16* __restrict__ Kb, const bf16* __restrict__ Vb, bf16* __restrict__ O, const float* __restrict__ sinkp,
                                          int qrow0, int h0, int kvh, int klat, int kctx, int add0, int skipnext, int NT, char* lds, const int tid) {
  const int wid = tid >> 6, lane = tid & 63, r32 = lane & 31, hi = lane >> 5;
  bf16* V_lds = (bf16*)lds; bf16* K_lds = (bf16*)(lds + 2 * SHM_V);
  float* ws = (float*)(lds + 2 * SHM_V + 2 * SHM_K) + wid * 64; float* li_l = ws; float* al_l = ws + 32;
  const int head = h0 + (wid >> 2), iq = (wid & 3) * QBLK + r32;
  float m_reg = sinkp[head] * (1.0f / SCALE), l_reg = 1.0f; f32x16 o[4] = {}; bf16x8 qr[8];
  const bf16* Qw = Q + (size_t)(qrow0 + iq) * LDQ + head * DH + hi * 8;
#pragma unroll
  for (int d0 = 0; d0 < 8; ++d0) qr[d0] = *reinterpret_cast<const bf16x8*>(Qw + d0 * 16);
  const int sr = tid >> 4, sc = (tid & 15) * 8, vst0 = v_st(sr, sc), vst1 = v_st(32 + sr, sc);
  const int vb0 = (int)(uintptr_t)V_lds + v_rd_base(lane);
  int kb4[4];
#pragma unroll
  for (int q = 0; q < 4; ++q) kb4[q] = (int)(uintptr_t)K_lds + r32 * 256 + ((q << 5) ^ ((hi << 4) ^ ((r32 & 7) << 4)));
  const unsigned kvoff = (unsigned)((sr * LDK + kvh * DH + sc) * 2);
  struct { bf16x8 vs0, vs1, ks0, ks1; } sr_[2];
#define TILE_T(s) ({ int _t = (s) + add0; if (skipnext && _t >= 4) _t += 2; _t; })
#define TILE_ROW(t) ((t) < 6 ? klat + 64 * (t) : kctx + 64 * ((t) - 6))
#define TILE_MK(t) ((t) < 2 ? 1 : (((t) >= 4 && (t) < 6) ? 2 : 0))
#define SLOAD(i, s) do { const int _t = TILE_T(s); const size_t _k0 = (size_t)TILE_ROW(_t) * (LDK * 2); const char* _kp = (const char*)Kb + _k0; const char* _vp = (const char*)Vb + _k0; \
    sr_[i].vs0 = *reinterpret_cast<const bf16x8*>(_vp + kvoff); sr_[i].vs1 = *reinterpret_cast<const bf16x8*>(_vp + 32 * LDK * 2 + kvoff); \
    sr_[i].ks0 = *reinterpret_cast<const bf16x8*>(_kp + kvoff); sr_[i].ks1 = *reinterpret_cast<const bf16x8*>(_kp + 32 * LDK * 2 + kvoff); } while (0)
#define SWRITE(b, i) do { *(bf16x8*)((char*)V_lds + (b) * SHM_V + vst0) = sr_[i].vs0;          \
    *(bf16x8*)((char*)V_lds + (b) * SHM_V + vst1) = sr_[i].vs1; int kc = sc * 2;               \
    *(bf16x8*)((char*)K_lds + (b) * SHM_K + KSWZ(sr, kc)) = sr_[i].ks0;                       \
    *(bf16x8*)((char*)K_lds + (b) * SHM_K + KSWZ(32 + sr, kc)) = sr_[i].ks1; } while (0)
#define SWAIT() asm volatile("s_waitcnt vmcnt(4)" ::: "memory")
#define RESC(a) do { if (__any((a) < 1.f)) { if (hi == 0) al_l[r32] = (a); asm volatile("s_waitcnt lgkmcnt(0)" ::: "memory"); \
    for (int d = 0; d < 4; ++d) for (int r = 0; r < 16; ++r) o[d][r] *= al_l[crow(r, hi)]; } } while (0)
#define MASK(P0, P1, s) do { const int _t = TILE_T(s); mask_tile(P0, P1, TILE_MK(_t), 64 * (_t & 1), iq, hi); } while (0)
  f32x16 pA0, pA1, pB0, pB1; float mnA, mnB, alA, alB; bf16x8 pa0, pa1, pa2, pa3;
  constexpr int SE = 0, SO = 1;
  SLOAD(SE, 0); asm volatile("s_waitcnt vmcnt(0)" ::: "memory"); SWRITE(0, SE); __syncthreads();
  qkt(pA0, pA1, kb4, 0, qr); MASK(pA0, pA1, 0); partialSM(pA0, pA1, m_reg, mnA, alA);
  SLOAD(SO, 1); if (2 < NT) SLOAD(SE, 2);
  SWAIT(); SWRITE(1, SO); __syncthreads();
  for (int j = 1; j + 1 < NT; j += 2) {
    SBAR(); qkt(pB0, pB1, kb4, (int)SHM_K, qr); MASK(pB0, pB1, j);
    finishSM(pA0, pA1, alA, l_reg, pa0, pa1, pa2, pa3); SBAR();
    SLOAD(SO, j + 2); SBAR();
    pv_d0(o, vb0, pa0, pa1, pa2, pa3); partialSM(pB0, pB1, m_reg, mnB, alB);
    __syncthreads(); SWAIT(); SWRITE(0, SE);
    RESC(alB); __syncthreads();
    SBAR(); qkt(pA0, pA1, kb4, 0, qr); MASK(pA0, pA1, j + 1);
    finishSM(pB0, pB1, alB, l_reg, pa0, pa1, pa2, pa3); SBAR();
    if (j + 3 < NT) SLOAD(SE, j + 3); SBAR();
    pv_d0(o, vb0 + (int)SHM_V, pa0, pa1, pa2, pa3); partialSM(pA0, pA1, m_reg, mnA, alA);
    __syncthreads(); SWAIT(); SWRITE(1, SO);
    RESC(alA); __syncthreads();
  }
  SBAR(); qkt(pB0, pB1, kb4, (int)SHM_K, qr); MASK(pB0, pB1, NT - 1);
  finishSM(pA0, pA1, alA, l_reg, pa0, pa1, pa2, pa3); SBAR();
  pv_d0(o, vb0, pa0, pa1, pa2, pa3); partialSM(pB0, pB1, m_reg, mnB, alB);
  __syncthreads(); RESC(alB);
  finishSM(pB0, pB1, alB, l_reg, pa0, pa1, pa2, pa3); SBAR();
  pv_d0(o, vb0 + (int)SHM_V, pa0, pa1, pa2, pa3);
  if (hi == 0) li_l[r32] = l_reg; asm volatile("s_waitcnt lgkmcnt(0)" ::: "memory");
  float rli[16];
#pragma unroll
  for (int r = 0; r < 16; ++r) rli[r] = __builtin_amdgcn_rcpf(li_l[crow(r, hi)]);
  bf16* Ow = O + (size_t)(qrow0 + (wid & 3) * QBLK) * LDO + head * DH;
#pragma unroll
  for (int r = 0; r < 16; ++r) { int orow = crow(r, hi);
    for (int d0 = 0; d0 < 4; ++d0) Ow[(size_t)orow * LDO + d0 * 32 + r32] = f2bf(o[d0][r] * rli[r]); }
  __syncthreads();
#undef TILE_T
#undef TILE_ROW
#undef TILE_MK
#undef SLOAD
#undef SWRITE
#undef SWAIT
#undef RESC
#undef MASK
}
}

__device__ __forceinline__ void attn_phase(Frame& F, int li, bool need_ctx) {
    const bf16* Q = F.BIG; const bf16* Kb = (const bf16*)((const char*)F.BIG + BIG_K); const bf16* Vb = (const bf16*)((const char*)F.BIG + BIG_V);
    const float* sinkp = F.sink + li * 8;
    const int NU = 1024 + (need_ctx ? 64 : 0);
    for (int u = F.vcu; u < NU; u += F.G) {
        if (u < 1024) { const int pair = u & 1, kvh = (u >> 1) & 1, n = (u >> 2) & 31, b = u >> 7;
            const int add0 = (n == 0) ? 2 : 0, skipnext = (n == 31) ? 1 : 0, NT = 10 - ((n == 0 || n == 31) ? 2 : 0);
            att::attn_unit(Q, Kb, Vb, F.MIX, sinkp, b * SEQ + n * 128, kvh * 4 + pair * 2, kvh, b * SEQ + (n - 1) * 128, RL + b * LC, add0, skipnext, NT, F.ldsg, F.tid);
        } else { const int v = u - 1024, pair = v & 1, kvh = (v >> 1) & 1, cb = (v >> 2) & 1, b = v >> 3;
            att::attn_unit(Q, Kb, Vb, F.MIX, sinkp, RL + b * LC + cb * 128, kvh * 4 + pair * 2, kvh, 0, RL + b * LC, 6, 0, 4, F.ldsg, F.tid);
        }
    }
}

#ifndef MK_SINGLE
#define MK_SINGLE 1
#endif
#ifndef REP_SET
#define REP_SET 0
#endif
#define RP(n) ((REP_SET == 200 + (n)) ? 2 : 1)
constexpr int REPS[14] = {RP(0), RP(1), RP(2), RP(3), RP(4), RP(5), RP(6), RP(7), RP(8), RP(9), RP(10), RP(11), RP(12), RP(13)};
#ifdef ONLY
#define ONLYX(n, stmt) do { if constexpr (ONLY == (n)) { stmt; } } while (0)
#else
#define ONLYX(n, stmt) do { for (int rep_ = 0; rep_ < REPS[n]; ++rep_) { stmt; if (rep_ + 1 < REPS[n]) xcd_barrier(bar); } } while (0)
#endif
constexpr int PPL = 9;
constexpr int NPHASE = 1 + DEPTH * PPL + 1;

#define CAS __attribute__((address_space(4)))
__device__ __forceinline__ void fill_ptrs(Frame& F, LAS unsigned char* ldsbase, int wv) {
    const CAS char* ka = (const CAS char*)__builtin_amdgcn_kernarg_segment_ptr(); asm volatile("" : "+s"(ka));
    { F.lds = ldsbase; F.ldsg = (char*)ldsbase; F.MISC = (volatile LAS unsigned*)(ldsbase + MISC_OFF); }
    { asm volatile("" : "+s"(wv)); unsigned am = ~0u; asm volatile("" : "+s"(am)); int ln = (int)__builtin_amdgcn_mbcnt_hi(am, __builtin_amdgcn_mbcnt_lo(am, 0u)); asm volatile("" : "+v"(ln)); F.lane = ln; F.wave = wv; F.tid = wv * 64 + ln; }
    { int g = gridDim.x, bx = blockIdx.x; asm volatile("" : "+s"(g), "+s"(bx)); F.G = g; F.vcu = (g % 8 == 0) ? (bx % 8) * (g / 8) + bx / 8 : bx; F.bx = bx; }
#define KIN(k) (*(const float* const CAS*)(ka + 8 * (k)))
    F.x_in = KIN(0); F.c_in = KIN(1); F.ctx_in = KIN(2); F.cctx_in = KIN(3); F.w_mod = KIN(4); F.b_mod = KIN(5); F.norm_g = KIN(6);
    F.w_in_even = KIN(7); F.w_out_even = KIN(8); F.ret_ld = KIN(9); F.ret_gn = KIN(10); F.sg_ln_g = KIN(11); F.sg_ln_b = KIN(12); F.sg_w = KIN(13); F.sg_b = KIN(14);
    F.w_qkv = KIN(15); F.w_o = KIN(16); F.sink = KIN(17); F.w_router = KIN(18); F.b_router = KIN(19); F.w_eg = KIN(20); F.w_eu = KIN(21); F.w_ed = KIN(22); F.final_g = KIN(23);
    F.out = *(float* const CAS*)(ka + 8 * 24);
    unsigned char* ws = *(unsigned char* const CAS*)(ka + 8 * 25);
#undef KIN
    F.ctl = (unsigned*)(ws + WS_CTL);
    F.MOD = (float*)(ws + WS_MOD); F.ROPE = (float*)(ws + WS_ROPE); F.X = (bf16*)(ws + WS_X); F.KV = (float*)(ws + WS_C);
    F.SGW = (bf16*)(ws + WS_SGW); F.W1T = (bf16*)(ws + WS_W1T); F.W2T = (bf16*)(ws + WS_W2T); F.WIN = (bf16*)(ws + WS_WIN); F.WOUT = (bf16*)(ws + WS_WOUT); F.WQKV = (bf16*)(ws + WS_WQKV); F.WO = (bf16*)(ws + WS_WO);
    F.H = (bf16*)(ws + WS_H); F.BIG = (bf16*)(ws + WS_BIG); F.MIX = (bf16*)(ws + WS_MIX); F.CS = (bf16*)(ws + WS_C); F.ST = (bf16*)(ws + WS_C + C_ST);
    F.TOK = (v4u*)(ws + WS_TOK); F.LIST = (int*)(ws + WS_LIST);
}
struct Args { const float* in[24]; float* out; unsigned char* ws; int ph_lo, ph_hi; };

__global__ void __launch_bounds__(NWAVES * 64, 2) fwd_kernel(Args args) {
    extern __shared__ __attribute__((aligned(16))) unsigned char lds[];
    Frame F; const int wv0 = __builtin_amdgcn_readfirstlane((int)threadIdx.x >> 6);
    fill_ptrs(F, (LAS unsigned char*)lds, wv0);
    for (int u = F.tid; u < (LDS_BYTES - MISC_OFF) / 4; u += NWAVES * 64) ((LAS unsigned*)(F.lds + MISC_OFF))[u] = 0u;
    __syncthreads();
    XcdBarrier bar; bar.bar = F.ctl + CW_BAR; bar.x = 0; bar.st = nullptr;
    if (MK_SINGLE) bar = xcd_barrier_post(F.ctl + CW_BAR, F.MISC);
    const int lo = args.ph_lo, hi = args.ph_hi;
#define IN(k) (lo <= (k) && (k) < hi)
#define SEAM(k) do { if (IN((k) + 1)) xcd_barrier(bar); } while (0)

    if (IN(0)) { fill_ptrs(F, (LAS unsigned char*)lds, wv0); ONLYX(0, p0_prologue(F)); SEAM(0); }

#pragma unroll 1
    for (int l = 0; l < DEPTH; ++l) {
        const int pb = 1 + l * PPL, li = l >> 1; const bool even = !(l & 1), need_ctx = l < DEPTH - 1;
        const int nrows = need_ctx ? RT : RL;
        if (IN(pb + 0)) { fill_ptrs(F, (LAS unsigned char*)lds, wv0); if (l == 0) { ONLYX(1, (norm_phase<false, false, false, true>(F, l, RT, 0, even ? IN8 : QKV8))); } else { ONLYX(2, (norm_phase<true, false, false, false>(F, l, RT, 0, even ? IN8 : QKV8))); } SEAM(pb + 0); }
        if (IN(pb + 1)) {
            fill_ptrs(F, (LAS unsigned char*)lds, wv0);
            if (even) { pg8::Gemm g{F.H, (const bf16*)((const unsigned char*)F.WIN + (size_t)li * EVEN_IN * 1024 * (IN8 ? 1 : 2)), 0}; pg8::StaticOrder S; S.init(RT, EVEN_IN, F.G, F.bx); EpiIn E{F.BIG};
                ONLYX(3, (pg8::gemm_phase<EpiIn, pg8::StaticOrder, true, false, IN8>(F.lds, g, S, E, F.tid))); }
            else { pg8::Gemm g{F.H, (const bf16*)((const unsigned char*)F.WQKV + (size_t)li * ODD_IN * 1024 * (QKV8 ? 1 : 2)), 0}; pg8::StaticOrder S; S.init(RT, ODD_IN, F.G, F.bx);
                EpiQKV E{F.BIG, (bf16*)((char*)F.BIG + BIG_K), (bf16*)((char*)F.BIG + BIG_V), F.ROPE};
                ONLYX(4, (pg8::gemm_phase<EpiQKV, pg8::StaticOrder, true, false, QKV8>(F.lds, g, S, E, F.tid))); }
            SEAM(pb + 1);
        }
        if (even) {
            if (IN(pb + 2)) { fill_ptrs(F, (LAS unsigned char*)lds, wv0); ONLYX(5, ret_kv_phase(F, li)); SEAM(pb + 2); }
            if (IN(pb + 3)) { fill_ptrs(F, (LAS unsigned char*)lds, wv0); ONLYX(6, ret_scan_phase(F, li)); SEAM(pb + 3); }
            if (IN(pb + 4)) { fill_ptrs(F, (LAS unsigned char*)lds, wv0); ONLYX(7, mixer_phase(F, li)); SEAM(pb + 4); }
        } else {
            if (IN(pb + 4)) { fill_ptrs(F, (LAS unsigned char*)lds, wv0); ONLYX(8, attn_phase(F, li, need_ctx)); SEAM(pb + 4); }
        }
        if (IN(pb + 5)) {
            fill_ptrs(F, (LAS unsigned char*)lds, wv0);
            pg8::Gemm g{F.MIX, (even ? F.WOUT : F.WO) + (size_t)li * 1048576, 0}; pg8::StaticOrder S; S.init(nrows, D, F.G, F.bx);
            EpiRes E{l == 0 ? F.x_in : nullptr, l == 0 ? F.ctx_in : nullptr, F.X, F.MOD + (size_t)l * 9 * 6144};
            ONLYX(9, (pg8::gemm_phase<EpiRes, pg8::StaticOrder, true, false, false>(F.lds, g, S, E, F.tid)));
            SEAM(pb + 5);
        }
        if (IN(pb + 6)) { fill_ptrs(F, (LAS unsigned char*)lds, wv0); ONLYX(10, (norm_phase<false, true, false, false>(F, l, nrows, 1, true))); SEAM(pb + 6); }
        if (IN(pb + 7)) {
            fill_ptrs(F, (LAS unsigned char*)lds, wv0);
            const LAS int* tab = moe_table(F, l);
            pg8::Gemm g{F.H, (const bf16*)((const unsigned char*)F.W1T + (size_t)l * 16 * 2048 * 1024), (size_t)2048 * 1024}; pg8::MoeOrder S; S.init(tab, F.LIST, 8, F.G, F.bx); EpiMoe1 E{(unsigned char*)F.BIG};
            ONLYX(11, (pg8::gemm_phase<EpiMoe1, pg8::MoeOrder, true, true, true>(F.lds, g, S, E, F.tid)));
            SEAM(pb + 7);
        }
        if (IN(pb + 8)) {
            fill_ptrs(F, (LAS unsigned char*)lds, wv0);
            const LAS int* tab = moe_table(F, l);
            pg8::Gemm g{F.BIG, (const bf16*)((const unsigned char*)F.W2T + (size_t)l * 16 * 1048576), (size_t)1048576}; pg8::MoeOrder S; S.init(tab, F.LIST, 4, F.G, F.bx); EpiBf8 E{F.CS};
            ONLYX(12, (pg8::gemm_phase<EpiBf8, pg8::MoeOrder, true, false, true>(F.lds, g, S, E, F.tid)));
            SEAM(pb + 8);
        }
    }
    if (IN(NPHASE - 1)) { fill_ptrs(F, (LAS unsigned char*)lds, wv0); ONLYX(13, (norm_phase<true, false, true, false>(F, DEPTH, RL, 0, true))); }
#undef IN
#undef SEAM
}

extern "C" void kernel_launch(void* const* d_in, const int* in_sizes, int n_in, void* d_out, int out_size, void* d_ws, size_t ws_size, hipStream_t stream) {
    static int grid = 0;
    if (grid == 0) {
        if (n_in != 24 || in_sizes[0] != RL * D || out_size != RL * D || ws_size < WS_END) { fprintf(stderr, "kernel_launch: shape mismatch: n_in %d in0 %d out %d ws %zu (need %zu)\n", n_in, n_in > 0 ? in_sizes[0] : -1, out_size, ws_size, (size_t)WS_END); grid = -1; return; }
        int dev = 0, cus = 0, per_cu = 0;
        if (hipGetDevice(&dev) != hipSuccess || hipDeviceGetAttribute(&cus, hipDeviceAttributeMultiprocessorCount, dev) != hipSuccess) { fprintf(stderr, "kernel_launch: device query failed\n"); grid = -1; return; }
        if (hipFuncSetAttribute((const void*)fwd_kernel, hipFuncAttributeMaxDynamicSharedMemorySize, LDS_BYTES) != hipSuccess) { fprintf(stderr, "kernel_launch: hipFuncSetAttribute failed\n"); grid = -1; return; }
        if (hipOccupancyMaxActiveBlocksPerMultiprocessor(&per_cu, (const void*)fwd_kernel, NWAVES * 64, LDS_BYTES) != hipSuccess || per_cu < 1) { fprintf(stderr, "kernel_launch: occupancy query reports %d workgroups per CU\n", per_cu); }
        (void)hipGetLastError();
        grid = cus;
    }
    if (grid < 0) return;
    if (hipMemsetAsync((char*)d_ws + WS_CTL, 0, CTL_ZERO_BYTES, stream) != hipSuccess) { fprintf(stderr, "kernel_launch: memset failed\n"); return; }
    Args a{};
    for (int i = 0; i < 24; ++i) a.in[i] = (const float*)d_in[i];
    a.out = (float*)d_out; a.ws = (unsigned char*)d_ws;
#if MK_SINGLE
    a.ph_lo = 0; a.ph_hi = NPHASE;
    hipLaunchKernelGGL(fwd_kernel, dim3(grid), dim3(NWAVES * 64), LDS_BYTES, stream, a);
#else
    for (int p = 0; p < NPHASE; ++p) {
        if (p >= 1 && p < NPHASE - 1) { const int l = (p - 1) / PPL, k = (p - 1) % PPL; if ((l & 1) && (k == 2 || k == 3)) continue; }
        a.ph_lo = p; a.ph_hi = p + 1;
        hipLaunchKernelGGL(fwd_kernel, dim3(grid), dim3(NWAVES * 64), LDS_BYTES, stream, a);
    }
#endif
    const hipError_t le = hipPeekAtLastError();
    if (le != hipSuccess) fprintf(stderr, "kernel_launch: launch failed: %s\n", hipGetErrorName(le));
}
```

```cpp
#include <hip/hip_runtime.h>
#include <cstdio>
#include <cstdint>
#include <type_traits>

#define GAS __attribute__((address_space(1)))
#define LAS __attribute__((address_space(3)))
typedef unsigned short bf16;
typedef unsigned v4u __attribute__((ext_vector_type(4)));
typedef unsigned u32x2 __attribute__((ext_vector_type(2)));
typedef float f32x2 __attribute__((ext_vector_type(2)));
typedef float f32x4 __attribute__((ext_vector_type(4)));
typedef float f32x16 __attribute__((ext_vector_type(16)));
typedef short bf16x8 __attribute__((ext_vector_type(8)));
typedef short s16x4 __attribute__((ext_vector_type(4)));
typedef GAS unsigned gu32;
#define RLX_AGENT __ATOMIC_RELAXED, __HIP_MEMORY_SCOPE_AGENT
#define LDS_WAIT() asm volatile("s_waitcnt lgkmcnt(0)" ::: "memory")
#define VM_WAIT() asm volatile("s_waitcnt vmcnt(0)" ::: "memory")

constexpr int D = 1024, NB = 8, SEQ = 4096, LC = 256, DEPTH = 4;
constexpr int RL = NB * SEQ;
constexpr int RC = NB * LC;
constexpr int RT = RL + RC;
constexpr int NCH = 34;
constexpr int EVEN_IN = 2560, ODD_IN = 1536;
constexpr int NE = 16;
constexpr float EPS = 1e-6f;
constexpr int MAXSLOT = 73728;

__device__ __forceinline__ unsigned cvt_pk_bf16(float lo, float hi) { unsigned r; asm volatile("v_cvt_pk_bf16_f32 %0, %1, %2" : "=v"(r) : "v"(lo), "v"(hi)); return r; }
__device__ __forceinline__ float bf_lo(unsigned w) { return __uint_as_float(w << 16); }
__device__ __forceinline__ float bf_hi(unsigned w) { return __uint_as_float(w & 0xffff0000u); }
__device__ __forceinline__ float bf2f(unsigned short h) { return __uint_as_float(((unsigned)h) << 16); }
__device__ __forceinline__ unsigned short f2bf(float f) { return (unsigned short)(cvt_pk_bf16(f, 0.f) & 0xffffu); }
__device__ __forceinline__ float gelu_tanh(float x) { const float u = x + 0.044715f * x * x * x; return x * __builtin_amdgcn_rcpf(1.0f + __builtin_amdgcn_exp2f(-2.302208198f * u)); }
__device__ __forceinline__ float silu_f(float x) { return x * __builtin_amdgcn_rcpf(1.0f + __builtin_amdgcn_exp2f(-1.4426950409f * x)); }
__device__ __forceinline__ float fexp2(float x) { return __builtin_amdgcn_exp2f(x); }
__device__ __forceinline__ float fexp(float x) { return __builtin_amdgcn_exp2f(x * 1.4426950409f); }
__device__ __forceinline__ float frsq(float x) { return __builtin_amdgcn_rsqf(x); }
__device__ __forceinline__ float dpp_f(float v, const int ctrl_b1, const int sel) {
    const int x = __float_as_int(v);
    const int y = sel == 0 ? __builtin_amdgcn_mov_dpp(x, 0xB1, 0xf, 0xf, true) : sel == 1 ? __builtin_amdgcn_mov_dpp(x, 0x4E, 0xf, 0xf, true) : sel == 2 ? __builtin_amdgcn_mov_dpp(x, 0x141, 0xf, 0xf, true) : __builtin_amdgcn_mov_dpp(x, 0x140, 0xf, 0xf, true);
    return __int_as_float(y);
}
__device__ __forceinline__ float row_sum16(float v) { v += dpp_f(v, 0, 0); v += dpp_f(v, 0, 1); v += dpp_f(v, 0, 2); v += dpp_f(v, 0, 3); return v; }
__device__ __forceinline__ float wave_sum(float v, int) {
    v = row_sum16(v);
    const int x = __float_as_int(v);
    return (__int_as_float(__builtin_amdgcn_readlane(x, 0)) + __int_as_float(__builtin_amdgcn_readlane(x, 16))) + (__int_as_float(__builtin_amdgcn_readlane(x, 32)) + __int_as_float(__builtin_amdgcn_readlane(x, 48)));
}
__device__ __forceinline__ float col_sum4(float v) {
    { auto r = __builtin_amdgcn_permlane16_swap(__float_as_uint(v), __float_as_uint(v), false, false); v = __uint_as_float(r[0]) + __uint_as_float(r[1]); }
    { auto r = __builtin_amdgcn_permlane32_swap(__float_as_uint(v), __float_as_uint(v), false, false); v = __uint_as_float(r[0]) + __uint_as_float(r[1]); }
    return v;
}

namespace pg8 {
typedef unsigned short bf16_t;
constexpr int BM = 256, BK = 64, HALF = 128, HTB = HALF * BK * 2, STAGE_BYTES = 8 * HTB, NXCD = 8, WGM = 8, KD = 1024;

__host__ __device__ __forceinline__ int lds_byte(int r, int c) { const int st = (r >> 4) * 2 + (c >> 5), rr = r & 15, cc = c & 31, ob = rr * 64 + cc * 2; return st * 1024 + (ob ^ (((ob >> 9) & 1) << 5)); }
__host__ __device__ __forceinline__ void stage_rc(int b, int& R, int& C) { const int st = b / 1024, sb = b % 1024, swz = sb ^ (((sb >> 9) & 1) << 5); R = (st >> 1) * 16 + swz / 64; C = (st & 1) * 32 + (swz % 64) / 2; }
__host__ __device__ __forceinline__ int perm32(int rho) { const int n = rho >> 4, i = rho & 15; return 8 * (i >> 2) + 4 * n + (i & 3); }

struct Unit { int pm, pn, e, nvalid; const int* gidx; };
typedef int i32x8 __attribute__((ext_vector_type(8)));
typedef int i32x4 __attribute__((ext_vector_type(4)));
typedef i32x8 Frag;
__device__ __forceinline__ bf16x8 frag_half(const Frag& f, int k) { const i32x4 q = k ? __builtin_shufflevector(f, f, 4, 5, 6, 7) : __builtin_shufflevector(f, f, 0, 1, 2, 3); return __builtin_bit_cast(bf16x8, q); }
struct Gemm { const bf16_t* A; const bf16_t* Bt; size_t bstride; };

struct StaticOrder {
    int nM, nN, nwg, G, c;
    __device__ void init(int M, int N, int G_, int c_) { nM = M / BM; nN = N / BM; nwg = nM * nN; G = G_; c = c_; }
    __device__ bool next(int i, Unit& u) const {
        const long L = (long)i * G + c; if (L >= nwg) return false;
        int wgid = (int)L; { const int q = nwg / NXCD, r = nwg % NXCD, xcd = wgid % NXCD, off = wgid / NXCD; wgid = (xcd < r ? xcd * (q + 1) : r * (q + 1) + (xcd - r) * q) + off; }
        const int nig = WGM * nN, gid = wgid / nig, fm = gid * WGM, gsz = (nM - fm) < WGM ? (nM - fm) : WGM;
        u.pm = fm + ((wgid % nig) % gsz); u.pn = (wgid % nig) / gsz; u.e = 0; u.nvalid = 256; u.gidx = nullptr; return true;
    }
};
struct MoeOrder {
    const LAS int* tab; const int* lists; int npn, G, c, nwg;
    __device__ void init(const LAS int* tab_, const int* lists_, int npn_, int G_, int c_) { tab = tab_; lists = lists_; npn = npn_; G = G_; c = c_; nwg = tab_[16] * npn_; }
    __device__ bool next(int i, Unit& u) const {
        const long L = (long)i * G + c; if (L >= nwg) return false;
        int wgid = (int)L; { const int q = nwg / NXCD, r = nwg % NXCD, xcd = wgid % NXCD, off = wgid / NXCD; wgid = (xcd < r ? xcd * (q + 1) : r * (q + 1) + (xcd - r) * q) + off; }
        int e = 0;
#pragma unroll 1
        for (int k = 1; k < 16; ++k) if (wgid >= tab[k] * npn) e = k;
        const int t0 = tab[e], loc = wgid - t0 * npn, mt = loc / npn;
        u.pm = t0 + mt; u.pn = loc - mt * npn; u.e = e; u.nvalid = tab[32 + e] - mt * 256; u.gidx = lists + (size_t)e * RT + mt * 256; return true;
    }
};

template <class Epi, class Sched, bool ALIGN_EPI, bool GATHER, bool FP8>
__device__ __forceinline__ void gemm_phase(LAS unsigned char* lds, const Gemm g, const Sched& S, const Epi& E, const int tid) {
    const int wid = __builtin_amdgcn_readfirstlane(tid >> 6), lane = tid & 63, wr = wid >> 2, wc = wid & 3, fr = lane & 15, fq = lane >> 4;
    constexpr int ROWB = FP8 ? 1024 : 2048, nt = ROWB / 128;
    unsigned voffA[2], voffB[2]; int RA[2]; unsigned CA2[2];
#pragma unroll
    for (int i = 0; i < 2; ++i) { int R, C; stage_rc(tid * 16 + i * 8192, R, C); const int Rb = Epi::PERM ? ((R & ~31) + perm32(R & 31)) : R;
        voffA[i] = (unsigned)(R * ROWB + C * 2); voffB[i] = (unsigned)(Rb * ROWB + C * 2); RA[i] = R; CA2[i] = (unsigned)C * 2u; }
    const size_t kstep = (size_t)(BK * 2);
    const size_t hstep = (size_t)HALF * ROWB;
    const size_t tstep = 2 * hstep;
    const unsigned ldsw = (unsigned)wid * 1024u;
    const int aoff = lds_byte(wr * 64 + fr, fq * 8), boff = lds_byte(wc * 32 + fr, fq * 8);
#define PG8_SA(b, h) (((b) * 2 + (h)) * HTB)
#define PG8_SB(b, h) ((4 + (b) * 2 + (h)) * HTB)
#define PG8_STAGE(bufoff, gbase, voff) do { _Pragma("unroll") for (int _i = 0; _i < 2; ++_i) \
        __builtin_amdgcn_global_load_lds((const unsigned*)((const char*)(gbase) + (voff)[_i]), (LAS unsigned*)(lds + (bufoff) + ldsw + _i * 8192), 16, 0, 0); } while (0)
#define PG8_STA(bufoff, kptr, H, VG) do { if constexpr (GATHER) { PG8_STAGE(bufoff, kptr, VG[H]); } else { PG8_STAGE(bufoff, (kptr) + (H) * hstep, voffA); } } while (0)
#define PG8_LDA(dst, b, h) do { _Pragma("unroll") for (int m = 0; m < 4; ++m) dst[m] = __builtin_shufflevector(*(const LAS i32x4*)(lds + PG8_SA(b, h) + aoff + m * 2048), *(const LAS i32x4*)(lds + PG8_SA(b, h) + aoff + m * 2048 + 1024), 0, 1, 2, 3, 4, 5, 6, 7); } while (0)
#define PG8_LDB(dst, b, h) do { _Pragma("unroll") for (int n = 0; n < 2; ++n) dst[n] = __builtin_shufflevector(*(const LAS i32x4*)(lds + PG8_SB(b, h) + boff + n * 2048), *(const LAS i32x4*)(lds + PG8_SB(b, h) + boff + n * 2048 + 1024), 0, 1, 2, 3, 4, 5, 6, 7); } while (0)
#define PG8_MMA(ai, bj, At, Bt) do { __builtin_amdgcn_s_setprio(1); _Pragma("unroll") for (int m = 0; m < 4; ++m) _Pragma("unroll") for (int n = 0; n < 2; ++n) { \
        if constexpr (FP8) asm volatile("v_mfma_scale_f32_16x16x128_f8f6f4 %0, %1, %2, %0, %3, %3 op_sel_hi:[0,0,0]" : "+v"(acc[ai][bj][m][n]) : "v"(Bt[n]), "v"(At[m]), "v"(sc1)); \
        else { _Pragma("unroll") for (int k = 0; k < 2; ++k) acc[ai][bj][m][n] = __builtin_amdgcn_mfma_f32_16x16x32_bf16(frag_half(Bt[n], k), frag_half(At[m], k), acc[ai][bj][m][n], 0, 0, 0); } } \
        __builtin_amdgcn_s_setprio(0); } while (0)
#define PG8_WAIT_V(n) asm volatile("s_waitcnt vmcnt(" #n ")" ::: "memory")
#define PG8_WAIT_L(n) asm volatile("s_waitcnt lgkmcnt(" #n ")" ::: "memory")
#define PG8_BAR __builtin_amdgcn_s_barrier()
#define PG8_SCHED __builtin_amdgcn_sched_barrier(0)
#define PG8_GLOAD(U, TK) do { _Pragma("unroll") for (int _h = 0; _h < 2; ++_h) _Pragma("unroll") for (int _i = 0; _i < 2; ++_i) { const int _r = _h * HALF + RA[_i]; \
        const int _rc = _r < (U).nvalid ? _r : (U).nvalid - 1; TK[_h][_i] = (U).gidx[_rc]; } } while (0)
#define PG8_GADDR(TK, VG) do { _Pragma("unroll") for (int _h = 0; _h < 2; ++_h) _Pragma("unroll") for (int _i = 0; _i < 2; ++_i) VG[_h][_i] = (unsigned)TK[_h][_i] * (unsigned)ROWB + CA2[_i]; } while (0)
    Unit cur, nxt; int ui = 0;
    if (!S.next(0, cur)) return;
    f32x4 acc[2][2][4][2];
#pragma unroll
    for (int a = 0; a < 2; ++a)
#pragma unroll
        for (int b = 0; b < 2; ++b)
#pragma unroll
            for (int m = 0; m < 4; ++m)
#pragma unroll
                for (int n = 0; n < 2; ++n) acc[a][b][m][n] = (f32x4){0.f, 0.f, 0.f, 0.f};
    Frag At[4], B0[2], B1[2];
    const int sc1 = 0x7f7f7f7f;
    unsigned vgc[2][2] = {{0u, 0u}, {0u, 0u}}, vgn[2][2] = {{0u, 0u}, {0u, 0u}};
    int tkn[2][2] = {{0, 0}, {0, 0}};
    if constexpr (GATHER) { PG8_GLOAD(cur, tkn); PG8_GADDR(tkn, vgc); }
    const char* cA = GATHER ? (const char*)g.A : (const char*)g.A + (size_t)cur.pm * tstep;
    const char* cB = (const char*)g.Bt + (size_t)cur.e * g.bstride + (size_t)cur.pn * tstep;
    PG8_STAGE(PG8_SB(0, 0), cB, voffB); PG8_STAGE(PG8_SB(0, 1), cB + hstep, voffB); PG8_STA(PG8_SA(0, 0), cA, 0, vgc); PG8_STA(PG8_SA(0, 1), cA, 1, vgc);
    if (wr == 1) PG8_BAR;
    PG8_WAIT_V(2); PG8_BAR;
    PG8_STAGE(PG8_SB(1, 0), cB + kstep, voffB); PG8_STA(PG8_SA(1, 0), cA + kstep, 0, vgc); PG8_STAGE(PG8_SB(1, 1), cB + hstep + kstep, voffB);
    PG8_WAIT_V(6); PG8_BAR;
    for (;;) {
        const bool has_next = S.next(ui + 1, nxt);
        if constexpr (GATHER) { if (has_next) { PG8_GLOAD(nxt, tkn); } }
        const char* nA = GATHER ? (const char*)g.A : (has_next ? (const char*)g.A + (size_t)nxt.pm * tstep : cA);
        const char* nB = has_next ? (const char*)g.Bt + (size_t)nxt.e * g.bstride + (size_t)nxt.pn * tstep : cB;
#pragma unroll 1
        for (int t = 0; t < nt; t += 2) {
            const bool last = (t == nt - 2);
            const char* a1 = cA + (size_t)(t + 1) * kstep;
            const char* a2 = last ? nA : cA + (size_t)(t + 2) * kstep; const char* b2 = last ? nB : cB + (size_t)(t + 2) * kstep;
            const char* a3 = a2 + kstep; const char* b3 = b2 + kstep;
            unsigned va2[2][2] = {{vgc[0][0], vgc[0][1]}, {vgc[1][0], vgc[1][1]}};
            if constexpr (GATHER) { if (last && has_next) { asm volatile("" : "+v"(tkn[0][0]), "+v"(tkn[0][1]), "+v"(tkn[1][0]), "+v"(tkn[1][1])); PG8_GADDR(tkn, vgn);
                va2[0][0] = vgn[0][0]; va2[0][1] = vgn[0][1]; va2[1][0] = vgn[1][0]; va2[1][1] = vgn[1][1]; } }
            PG8_LDB(B0, 0, 0); PG8_LDB(B1, 0, 1); PG8_SCHED; PG8_LDA(At, 0, 0); PG8_STA(PG8_SA(1, 1), a1, 1, vgc);
            PG8_WAIT_V(8); PG8_WAIT_L(0); PG8_BAR; PG8_MMA(0, 0, At, B0); PG8_MMA(0, 1, At, B1); PG8_BAR; PG8_SCHED;
            PG8_LDA(At, 0, 1); PG8_STAGE(PG8_SB(0, 0), b2, voffB); PG8_STAGE(PG8_SB(0, 1), b2 + hstep, voffB); PG8_STA(PG8_SA(0, 0), a2, 0, va2);
            PG8_WAIT_V(8); PG8_WAIT_L(0); PG8_BAR; PG8_MMA(1, 0, At, B0); PG8_MMA(1, 1, At, B1); PG8_BAR; PG8_SCHED;
            PG8_LDB(B0, 1, 0); PG8_LDB(B1, 1, 1); PG8_SCHED; PG8_LDA(At, 1, 0); PG8_STA(PG8_SA(0, 1), a2, 1, va2);
            PG8_WAIT_V(8); PG8_WAIT_L(0); PG8_BAR; PG8_MMA(0, 0, At, B0); PG8_MMA(0, 1, At, B1); PG8_BAR; PG8_SCHED;
            PG8_LDA(At, 1, 1); PG8_STAGE(PG8_SB(1, 0), b3, voffB); PG8_STAGE(PG8_SB(1, 1), b3 + hstep, voffB); PG8_STA(PG8_SA(1, 0), a3, 0, va2);
            PG8_WAIT_V(8); PG8_WAIT_L(0); PG8_BAR; PG8_MMA(1, 0, At, B0); PG8_MMA(1, 1, At, B1); PG8_BAR; PG8_SCHED;
        }
        if constexpr (ALIGN_EPI) { if (wr == 0) PG8_BAR; }
        if constexpr (FP8) asm volatile("s_nop 15\n\ts_nop 15" ::: "memory");
        E(acc, cur, wr, wc, fr, fq);
        if (!has_next) break;
#pragma unroll
        for (int a = 0; a < 2; ++a)
#pragma unroll
            for (int b = 0; b < 2; ++b)
#pragma unroll
                for (int m = 0; m < 4; ++m)
#pragma unroll
                    for (int n = 0; n < 2; ++n) acc[a][b][m][n] = (f32x4){0.f, 0.f, 0.f, 0.f};
        cur = nxt; cA = nA; cB = nB; ++ui;
        if constexpr (GATHER) {
#pragma unroll
            for (int h = 0; h < 2; ++h)
#pragma unroll
                for (int i = 0; i < 2; ++i) vgc[h][i] = vgn[h][i]; }
        if constexpr (ALIGN_EPI) { if (wr == 1) PG8_BAR; }
    }
    PG8_WAIT_V(0);
    if constexpr (!ALIGN_EPI) { if (wr == 0) PG8_BAR; }
    PG8_BAR;
#undef PG8_SA
#undef PG8_SB
#undef PG8_STAGE
#undef PG8_STA
#undef PG8_LDA
#undef PG8_LDB
#undef PG8_MMA
#undef PG8_WAIT_V
#undef PG8_WAIT_L
#undef PG8_BAR
#undef PG8_SCHED
#undef PG8_GLOAD
#undef PG8_GADDR
}
}
#define XB_TMO      128
#define XB_XCNT(j)  (256  + 64 * (j))
#define XB_XSUB(j)  (1280 + 64 * (j))
#define XB_XGEN(j)  (2304 + 64 * (j))
#define XB_TOP      3328
#define XB_TOPGEN   3392
#define XCD_BAR_WORDS 3456
#define XB_SPIN_CAP (1u << 22)

__device__ __forceinline__ unsigned xb_ld(unsigned* p)              { return __hip_atomic_load(p, __ATOMIC_RELAXED, __HIP_MEMORY_SCOPE_AGENT); }
__device__ __forceinline__ unsigned xb_add(unsigned* p, unsigned v) { return __hip_atomic_fetch_add(p, v, __ATOMIC_RELAXED, __HIP_MEMORY_SCOPE_AGENT); }
__device__ __forceinline__ unsigned xb_xcc_id() { return (unsigned)__builtin_amdgcn_s_getreg((3 << 11) | 20) & 0xFu; }
#define XB_SPIN(cond, bar) do { unsigned _sp = 0; while (cond) { __builtin_amdgcn_s_sleep(1); \
    if ((++_sp & 255u) == 0u) { if (xb_ld(&(bar)[XB_TMO])) break; if (_sp > XB_SPIN_CAP) { atomicAdd(&(bar)[XB_TMO], 1u); break; } } } } while (0)

struct XcdBarrier {
    unsigned* bar; unsigned x;
    volatile LAS unsigned* st;
};

__device__ __forceinline__ XcdBarrier xcd_barrier_post(unsigned* bar, volatile LAS unsigned* st) {
    XcdBarrier b; b.bar = bar; b.x = xb_xcc_id(); b.st = st;
    if (threadIdx.x == 0) (void)xb_add(&bar[XB_XCNT(b.x)], 1u);
    return b;
}
__device__ __forceinline__ void xcd_barrier_complete(unsigned* bar, unsigned x, unsigned& nloc, unsigned& nx) {
    const unsigned G = gridDim.x * gridDim.y * gridDim.z;
    unsigned sum, cnt, mine, sp = 0u;
    for (;;) {
        sum = 0u; cnt = 0u; mine = 0u;
#pragma unroll
        for (unsigned j = 0; j < 16; ++j) { const unsigned c = xb_ld(&bar[XB_XCNT(j)]); sum += c; cnt += (c > 0u) ? 1u : 0u; mine = (j == x) ? c : mine; }
        if (sum == G) break;
        __builtin_amdgcn_s_sleep(1);
        if ((++sp & 255u) == 0u) { if (xb_ld(&bar[XB_TMO])) break; if (sp > XB_SPIN_CAP) { atomicAdd(&bar[XB_TMO], 1u); break; } }
    }
    nloc = mine > 0u ? mine : 1u; nx = cnt > 0u ? cnt : 1u;
}

__device__ __forceinline__ void xcd_barrier(const XcdBarrier& b) {
    asm volatile("s_waitcnt vmcnt(0)" ::: "memory");
    __syncthreads();
    if (threadIdx.x == 0) {
        unsigned* bar = b.bar; unsigned bxx = b.x; asm volatile("" : "+s"(bxx), "+s"(bar));
        __builtin_amdgcn_s_waitcnt(0);
        unsigned nloc = b.st[0], nx = b.st[1];
        if (nloc == 0u) { xcd_barrier_complete(bar, bxx, nloc, nx); b.st[0] = nloc; b.st[1] = nx; }
        const unsigned old = xb_add(&bar[XB_XSUB(bxx)], 1u);
        const unsigned gen = old / nloc;
        if (old + 1u == (gen + 1u) * nloc) {
            __builtin_amdgcn_fence(__ATOMIC_RELEASE, "agent");
            asm volatile("s_waitcnt vmcnt(0)" ::: "memory");
            const unsigned og = xb_add(&bar[XB_TOP], 1u);
            const unsigned tg = og / nx;
            if (og + 1u == (tg + 1u) * nx) xb_add(&bar[XB_TOPGEN], 1u);
            else XB_SPIN(xb_ld(&bar[XB_TOPGEN]) == tg, bar);
            __builtin_amdgcn_fence(__ATOMIC_ACQUIRE, "agent");
            xb_add(&bar[XB_XGEN(bxx)], 1u);
            asm volatile("s_waitcnt vmcnt(0)" ::: "memory");
        } else {
            XB_SPIN(xb_ld(&bar[XB_XGEN(bxx)]) == gen, bar);
            __builtin_amdgcn_fence(__ATOMIC_ACQUIRE, "agent");
            asm volatile("s_waitcnt vmcnt(0)" ::: "memory");
        }
    }
    __syncthreads();
}

constexpr size_t MiB = 1u << 20;
constexpr size_t WS_CTL = 0, CTL_ZERO_BYTES = 1 * MiB;
constexpr size_t WS_MOD = 1 * MiB;
constexpr size_t WS_ROPE = 2 * MiB;
constexpr size_t WS_SGW = 2 * MiB + 65536;
constexpr size_t WS_TOK = 3 * MiB;
constexpr size_t WS_LIST = 4 * MiB;
constexpr size_t WS_W1T = 8 * MiB;
constexpr size_t WS_W2T = 264 * MiB;
constexpr size_t WS_WIN = 392 * MiB;
constexpr size_t WS_WOUT = 402 * MiB;
constexpr size_t WS_WQKV = 406 * MiB;
constexpr size_t WS_WO = 412 * MiB;
constexpr size_t WS_X = 416 * MiB;
constexpr size_t WS_H = 552 * MiB;
constexpr size_t WS_BIG = 620 * MiB;
constexpr size_t WS_MIX = 790 * MiB;
constexpr size_t WS_C = 858 * MiB;
constexpr size_t WS_END = 1002 * MiB;
constexpr size_t BIG_K = 68 * MiB, BIG_V = 85 * MiB, C_ST = 68 * MiB;
constexpr int CW_TMO = 0, CW_BAR = 4096, CW_CNT = 8192;

constexpr int RING_BYTES = 131072, MISC_OFF = RING_BYTES, LDS_BYTES = 147456;
constexpr int NWAVES = 8;

struct Frame {
    LAS unsigned char* lds; char* ldsg;
    volatile LAS unsigned* MISC;
    unsigned* ctl;
    int tid, lane, wave, vcu, G, bx;
    const float *x_in, *c_in, *ctx_in, *cctx_in, *w_mod, *b_mod, *norm_g, *w_in_even, *w_out_even, *ret_ld, *ret_gn, *sg_ln_g, *sg_ln_b, *sg_w, *sg_b,
                *w_qkv, *w_o, *sink, *w_router, *b_router, *w_eg, *w_eu, *w_ed, *final_g;
    float* out;
    float *MOD, *ROPE, *KV;
    bf16 *X, *SGW, *W1T, *W2T, *WIN, *WOUT, *WQKV, *WO, *H, *BIG, *MIX, *CS, *ST;
    v4u* TOK; int* LIST;
};

using pg8::Unit;
__device__ __forceinline__ unsigned cvt4_fp8(float a, float b, float c, float d) { int w = 0; w = __builtin_amdgcn_cvt_pk_fp8_f32(a, b, w, false); w = __builtin_amdgcn_cvt_pk_fp8_f32(c, d, w, true); return (unsigned)w; }
__device__ __forceinline__ float clamp448(float x) { return __builtin_amdgcn_fmed3f(x, -448.f, 448.f); }
constexpr bool IN8 = true, QKV8 = true;
constexpr float W8_SCALE = 32.f, W8_INV = 1.f / 32.f;
constexpr float ACT8_SCALE = 4.f, ACT8_INV = 0.25f;
struct EpiIn {
    static constexpr bool PERM = true;
    bf16* O;
    __device__ __forceinline__ void operator()(const f32x4 (&acc)[2][2][4][2], const Unit& u, int wr, int wc, int fr, int fq) const {
        const int row0 = u.pm * 256 + wr * 64 + fr, col0 = u.pn * 256 + wc * 32 + 8 * fq;
        const int mode = (u.pn == 1) ? 1 : (u.pn >= 6 ? 2 : 0);
#pragma unroll
        for (int ai = 0; ai < 2; ++ai)
#pragma unroll
            for (int m = 0; m < 4; ++m) { bf16* rowp = O + (size_t)(row0 + ai * 128 + m * 16) * EVEN_IN + col0;
#pragma unroll
                for (int bj = 0; bj < 2; ++bj) { f32x4 v0 = acc[ai][bj][m][0] * (IN8 ? W8_INV : 1.f), v1 = acc[ai][bj][m][1] * (IN8 ? W8_INV : 1.f);
                    if (mode == 1) { v0 = v0 * 0.125f; v1 = v1 * 0.125f; }
                    if (mode == 2) {
#pragma unroll
                        for (int j = 0; j < 4; ++j) { v0[j] = gelu_tanh(v0[j]); v1[j] = gelu_tanh(v1[j]); } }
                    v4u w; w.x = cvt_pk_bf16(v0[0], v0[1]); w.y = cvt_pk_bf16(v0[2], v0[3]); w.z = cvt_pk_bf16(v1[0], v1[1]); w.w = cvt_pk_bf16(v1[2], v1[3]);
                    *(v4u*)(rowp + bj * 128) = w; } }
    }
};
struct EpiRes {
    static constexpr bool PERM = true;
    const float* xlat; const float* xctx; bf16* X; const float* modl;
    __device__ __forceinline__ void operator()(const f32x4 (&acc)[2][2][4][2], const Unit& u, int wr, int wc, int fr, int fq) const {
        const int row0 = u.pm * 256 + wr * 64 + fr, col0 = u.pn * 256 + wc * 32 + 8 * fq;
        const bool lat = u.pm < (RL / 256); const int bb = lat ? (u.pm >> 4) : 8;
        const float* gp = modl + bb * 6144 + 2 * 1024 + col0;
        f32x4 gv[2][2];
#pragma unroll
        for (int bj = 0; bj < 2; ++bj)
#pragma unroll
            for (int n = 0; n < 2; ++n) gv[bj][n] = *(const f32x4*)(gp + bj * 128 + n * 4);
#pragma unroll
        for (int ai = 0; ai < 2; ++ai) {
            f32x4 x0[4][2], x1[4][2];
#pragma unroll
            for (int m = 0; m < 4; ++m) { const int r = row0 + ai * 128 + m * 16; const bf16* xo = X + (size_t)r * D + col0;
#pragma unroll
                for (int bj = 0; bj < 2; ++bj) {
                    if (xlat) { const float* xi = (lat ? xlat + (size_t)r * D : xctx + (size_t)(r - RL) * D) + col0 + bj * 128; x0[m][bj] = *(const f32x4*)xi; x1[m][bj] = *(const f32x4*)(xi + 4); }
                    else { const v4u xw = *(const v4u*)(xo + bj * 128); x0[m][bj] = (f32x4){bf_lo(xw.x), bf_hi(xw.x), bf_lo(xw.y), bf_hi(xw.y)}; x1[m][bj] = (f32x4){bf_lo(xw.z), bf_hi(xw.z), bf_lo(xw.w), bf_hi(xw.w)}; } } }
#pragma unroll
            for (int m = 0; m < 4; ++m) { const int r = row0 + ai * 128 + m * 16; bf16* xo = X + (size_t)r * D + col0;
#pragma unroll
                for (int bj = 0; bj < 2; ++bj) {
                    const f32x4 v0 = x0[m][bj] + gv[bj][0] * acc[ai][bj][m][0], v1 = x1[m][bj] + gv[bj][1] * acc[ai][bj][m][1];
                    v4u w; w.x = cvt_pk_bf16(v0[0], v0[1]); w.y = cvt_pk_bf16(v0[2], v0[3]); w.z = cvt_pk_bf16(v1[0], v1[1]); w.w = cvt_pk_bf16(v1[2], v1[3]);
                    *(v4u*)(xo + bj * 128) = w; } }
        }
    }
};
struct EpiQKV {
    static constexpr bool PERM = true;
    bf16 *Q, *K, *V; const float* rope;
    __device__ __forceinline__ void operator()(const f32x4 (&acc)[2][2][4][2], const Unit& u, int wr, int wc, int fr, int fq) const {
        const int row0 = u.pm * 256 + wr * 64 + fr; const int cin = wc * 32 + 8 * fq;
        const bool lat = u.pm < (RL / 256); const bool dorope = lat && (u.pn < 5);
        bf16* base; int ld;
        if (u.pn < 4) { base = Q + u.pn * 256; ld = 1024; } else if (u.pn == 4) { base = K; ld = 256; } else { base = V; ld = 256; }
        const int half = (cin >> 6) & 1, i0 = (cin & 63) >> 1;
#pragma unroll
        for (int ai = 0; ai < 2; ++ai)
#pragma unroll
            for (int m = 0; m < 4; ++m) { const int r = row0 + ai * 128 + m * 16; bf16* rowp = base + (size_t)r * ld + cin;
                f32x4 cs0 = {1.f, 0.f, 1.f, 0.f}, cs1 = {1.f, 0.f, 1.f, 0.f};
                if (dorope) { const int t = r & (SEQ - 1); const int pos = half ? (t & 63) : (t >> 6); const float* tp = rope + (size_t)(pos * 32 + i0) * 2; cs0 = *(const f32x4*)tp; cs1 = *(const f32x4*)(tp + 4); }
#pragma unroll
                for (int bj = 0; bj < 2; ++bj) { const f32x4 v0 = acc[ai][bj][m][0] * (QKV8 ? W8_INV : 1.f), v1 = acc[ai][bj][m][1] * (QKV8 ? W8_INV : 1.f);
                    const float a0 = v0[0] * cs0[0] - v0[1] * cs0[1], a1 = v0[1] * cs0[0] + v0[0] * cs0[1];
                    const float a2 = v0[2] * cs0[2] - v0[3] * cs0[3], a3 = v0[3] * cs0[2] + v0[2] * cs0[3];
                    const float a4 = v1[0] * cs1[0] - v1[1] * cs1[1], a5 = v1[1] * cs1[0] + v1[0] * cs1[1];
                    const float a6 = v1[2] * cs1[2] - v1[3] * cs1[3], a7 = v1[3] * cs1[2] + v1[2] * cs1[3];
                    v4u w; w.x = cvt_pk_bf16(a0, a1); w.y = cvt_pk_bf16(a2, a3); w.z = cvt_pk_bf16(a4, a5); w.w = cvt_pk_bf16(a6, a7);
                    *(v4u*)(rowp + bj * 128) = w; } }
    }
};
struct EpiMoe1 {
    static constexpr bool PERM = true;
    unsigned char* O;
    __device__ __forceinline__ void operator()(const f32x4 (&acc)[2][2][4][2], const Unit& u, int wr, int wc, int fr, int fq) const {
        const int row0 = u.pm * 256 + wr * 64 + fr, col0 = u.pn * 128 + wc * 32 + 8 * fq;
#pragma unroll
        for (int ai = 0; ai < 2; ++ai)
#pragma unroll
            for (int m = 0; m < 4; ++m) { unsigned char* rowp = O + (size_t)(row0 + ai * 128 + m * 16) * 1024 + col0;
                const f32x4 g0 = acc[ai][0][m][0] * W8_INV, g1 = acc[ai][0][m][1] * W8_INV, u0 = acc[ai][1][m][0] * (W8_INV * ACT8_SCALE), u1 = acc[ai][1][m][1] * (W8_INV * ACT8_SCALE);
                f32x4 v0, v1;
#pragma unroll
                for (int j = 0; j < 4; ++j) { v0[j] = clamp448(silu_f(g0[j]) * u0[j]); v1[j] = clamp448(silu_f(g1[j]) * u1[j]); }
                u32x2 w; w.x = cvt4_fp8(v0[0], v0[1], v0[2], v0[3]); w.y = cvt4_fp8(v1[0], v1[1], v1[2], v1[3]);
                *(u32x2*)rowp = w; }
    }
};
struct EpiBf8 {
    static constexpr bool PERM = true;
    bf16* O;
    __device__ __forceinline__ void operator()(const f32x4 (&acc)[2][2][4][2], const Unit& u, int wr, int wc, int fr, int fq) const {
        const int row0 = u.pm * 256 + wr * 64 + fr, col0 = u.pn * 256 + wc * 32 + 8 * fq;
#pragma unroll
        for (int ai = 0; ai < 2; ++ai)
#pragma unroll
            for (int m = 0; m < 4; ++m) { bf16* rowp = O + (size_t)(row0 + ai * 128 + m * 16) * 1024 + col0;
#pragma unroll
                for (int bj = 0; bj < 2; ++bj) { const f32x4 v0 = acc[ai][bj][m][0] * (W8_INV * ACT8_INV), v1 = acc[ai][bj][m][1] * (W8_INV * ACT8_INV);
                    v4u w; w.x = cvt_pk_bf16(v0[0], v0[1]); w.y = cvt_pk_bf16(v0[2], v0[3]); w.z = cvt_pk_bf16(v1[0], v1[1]); w.w = cvt_pk_bf16(v1[2], v1[3]);
                    *(v4u*)(rowp + bj * 128) = w; } }
    }
};

template <class RowMap>
__device__ __forceinline__ void p0_transpose_item(const float* W, int N, bf16* WT, const RowMap& rm, LAS float* scr, int item, int lane) {
    const int nblk = N / 32, kb = item / nblk, nb = item % nblk, k0 = 64 * kb, n0 = 32 * nb;
#pragma unroll 8
    for (int i = 0; i < 32; ++i) { const int kk = 2 * i + (lane >> 5); scr[kk * 33 + (lane & 31)] = W[(size_t)(k0 + kk) * N + n0 + (lane & 31)]; }
    LDS_WAIT(); asm volatile("" ::: "memory");
    const int c = lane & 7;
#pragma unroll
    for (int j = 0; j < 4; ++j) { const int n = (lane >> 3) + 8 * j; const LAS float* s = scr + (8 * c) * 33 + n;
        v4u o; o.x = cvt_pk_bf16(s[0 * 33], s[1 * 33]); o.y = cvt_pk_bf16(s[2 * 33], s[3 * 33]); o.z = cvt_pk_bf16(s[4 * 33], s[5 * 33]); o.w = cvt_pk_bf16(s[6 * 33], s[7 * 33]);
        *(v4u*)(WT + (size_t)rm(n0 + n) * 1024 + k0 + 8 * c) = o; }
    LDS_WAIT(); asm volatile("" ::: "memory");
}
template <class RowMap>
__device__ __forceinline__ void p0_transpose_item8(const float* W, int N, unsigned char* WT, const RowMap& rm, LAS float* scr, int item, int lane) {
    const int nblk = N / 32, kb = item / nblk, nb = item % nblk, k0 = 64 * kb, n0 = 32 * nb;
#pragma unroll 16
    for (int i = 0; i < 32; ++i) { const int kk = 2 * i + (lane >> 5); scr[kk * 33 + (lane & 31)] = W[(size_t)(k0 + kk) * N + n0 + (lane & 31)] * W8_SCALE; }
    LDS_WAIT(); asm volatile("" ::: "memory");
    const int c = lane & 7;
#pragma unroll
    for (int j = 0; j < 4; ++j) { const int n = (lane >> 3) + 8 * j; const LAS float* s = scr + (8 * c) * 33 + n;
        u32x2 o; o.x = cvt4_fp8(s[0 * 33], s[1 * 33], s[2 * 33], s[3 * 33]); o.y = cvt4_fp8(s[4 * 33], s[5 * 33], s[6 * 33], s[7 * 33]);
        *(u32x2*)(WT + (size_t)rm(n0 + n) * 1024 + k0 + 8 * c) = o; }
    LDS_WAIT(); asm volatile("" ::: "memory");
}
struct RmId { __device__ __forceinline__ int operator()(int n) const { return n; } };
struct RmGU { int type; __device__ __forceinline__ int operator()(int n) const { return ((n >> 7) << 8) + type * 128 + (n & 127); } };
struct RmQKV { __device__ __forceinline__ int operator()(int n) const { if (n >= 1280) return n; const int ps = n & 63; return (n & ~63) + (ps < 32 ? 2 * ps : 2 * (ps - 32) + 1); } };

__device__ __forceinline__ void p0_prologue(Frame& F) {
    LAS float* scr = (LAS float*)(F.lds + F.wave * 16384);
    const int gw = F.vcu * NWAVES + F.wave, NGW = F.G * NWAVES;
    constexpr int I_E = 512, N_EXP = 4 * 3 * 16 * I_E;
    constexpr int I_IN = 16 * 80, I_SQ = 512, I_QKV = 16 * 48;
    constexpr int NITEMS = N_EXP + 2 * I_IN + 2 * I_SQ + 2 * I_QKV + 2 * I_SQ;
    for (int it = gw; it < NITEMS; it += NGW) {
        int r = it;
        if (r < N_EXP) { const int mtx = r / I_E, item = r % I_E, layer = mtx / 48, rem = mtx % 48, type = rem / 16, e = rem % 16; const size_t mo = (size_t)(layer * 16 + e) * 1048576;
            if (type == 2) p0_transpose_item8(F.w_ed + mo, 1024, (unsigned char*)F.W2T + mo, RmId{}, scr, item, F.lane);
            else p0_transpose_item8((type ? F.w_eu : F.w_eg) + mo, 1024, (unsigned char*)F.W1T + 2 * mo, RmGU{type}, scr, item, F.lane);
            continue; }
        r -= N_EXP;
        if (r < 2 * I_IN) { const int i = r / I_IN; if (IN8) p0_transpose_item8(F.w_in_even + (size_t)i * 1024 * EVEN_IN, EVEN_IN, (unsigned char*)F.WIN + (size_t)i * EVEN_IN * 1024, RmId{}, scr, r % I_IN, F.lane); else p0_transpose_item(F.w_in_even + (size_t)i * 1024 * EVEN_IN, EVEN_IN, F.WIN + (size_t)i * EVEN_IN * 1024, RmId{}, scr, r % I_IN, F.lane); continue; } r -= 2 * I_IN;
        if (r < 2 * I_SQ) { const int i = r / I_SQ; p0_transpose_item(F.w_out_even + (size_t)i * 1048576, 1024, F.WOUT + (size_t)i * 1048576, RmId{}, scr, r % I_SQ, F.lane); continue; } r -= 2 * I_SQ;
        if (r < 2 * I_QKV) { const int i = r / I_QKV; if (QKV8) p0_transpose_item8(F.w_qkv + (size_t)i * 1024 * ODD_IN, ODD_IN, (unsigned char*)F.WQKV + (size_t)i * ODD_IN * 1024, RmQKV{}, scr, r % I_QKV, F.lane); else p0_transpose_item(F.w_qkv + (size_t)i * 1024 * ODD_IN, ODD_IN, F.WQKV + (size_t)i * ODD_IN * 1024, RmQKV{}, scr, r % I_QKV, F.lane); continue; } r -= 2 * I_QKV;
        { const int i = r / I_SQ; p0_transpose_item(F.w_o + (size_t)i * 1048576, 1024, F.WO + (size_t)i * 1048576, RmId{}, scr, r % I_SQ, F.lane); }
    }
    { const int gt = F.vcu * 512 + F.tid, GT = F.G * 512;
      for (int i = gt; i < 2 * 4 * 128 * 128 / 4; i += GT) { const f32x4 v = ((const f32x4*)F.sg_w)[i]; u32x2 w; w.x = cvt_pk_bf16(v[0], v[1]); w.y = cvt_pk_bf16(v[2], v[3]); ((u32x2*)F.SGW)[i] = w; }
      for (int i = gt; i < 64 * 32; i += GT) { const int pos = i >> 5, fi = i & 31; const float inv = fexp2(-(float)fi * (13.287712379549449f / 32.0f)); const float rev = __builtin_amdgcn_fractf((float)pos * inv * 0.15915494309189535f);
          F.ROPE[2 * i] = __builtin_amdgcn_cosf(rev); F.ROPE[2 * i + 1] = __builtin_amdgcn_sinf(rev); } }
    __syncthreads();
    LAS float* sc = (LAS float*)F.lds;
    LAS float* part = (LAS float*)(F.lds + 49152);
    for (int i = F.tid; i < 9 * 1024; i += 512) { const int bb = i >> 10, k = i & 1023; const float cv = bb < 8 ? F.c_in[bb * 1024 + k] : F.cctx_in[k]; sc[k * 12 + bb] = silu_f(cv); }
    __syncthreads();
    for (int it = F.vcu; it < 4 * 96; it += F.G) {
        const int l = it / 96, n = (it % 96) * 64 + F.lane;
        float a[9];
#pragma unroll
        for (int bb = 0; bb < 9; ++bb) a[bb] = 0.f;
        const float* wp = F.w_mod + ((size_t)l * 1024 + F.wave * 128) * 6144 + n;
#pragma unroll 8
        for (int k = 0; k < 128; ++k) { const float wv = wp[(size_t)k * 6144]; const LAS float* sp = sc + (F.wave * 128 + k) * 12;
            const f32x4 s0 = *(const LAS f32x4*)sp, s1 = *(const LAS f32x4*)(sp + 4); const float s8 = sp[8];
            a[0] += s0[0] * wv; a[1] += s0[1] * wv; a[2] += s0[2] * wv; a[3] += s0[3] * wv; a[4] += s1[0] * wv; a[5] += s1[1] * wv; a[6] += s1[2] * wv; a[7] += s1[3] * wv; a[8] += s8 * wv; }
#pragma unroll
        for (int bb = 0; bb < 9; ++bb) part[(F.wave * 9 + bb) * 64 + F.lane] = a[bb];
        __syncthreads();
        for (int i = F.tid; i < 9 * 64; i += 512) { const int bb = i >> 6, ln = i & 63; float s = 0.f;
#pragma unroll
            for (int w = 0; w < 8; ++w) s += part[(w * 9 + bb) * 64 + ln];
            const int nn = (it % 96) * 64 + ln; F.MOD[((size_t)l * 9 + bb) * 6144 + nn] = s + F.b_mod[l * 6144 + nn]; }
        __syncthreads();
    }
}

template <bool COMBINE, bool ROUTE, bool FINAL, bool FIN>
__device__ __forceinline__ void norm_phase(Frame& F, int l, int nrows, int sel, bool h8) {
    const int rpb = (nrows + F.G - 1) / F.G, r0 = F.vcu * rpb, r1 = (r0 + rpb < nrows) ? r0 + rpb : nrows;
    LAS float* wrl = (LAS float*)F.lds;
    LAS int* rinfo = (LAS int*)(F.lds + 81920);
    LAS int* lcnt = (LAS int*)(F.lds + 81920 + 12288);
    if (ROUTE) {
        for (int i = F.tid; i < 1024 * 4; i += 512) { const int k = i >> 2, q4 = i & 3; const f32x4 v = *(const f32x4*)(F.w_router + k * 16 + q4 * 4);
            *(LAS f32x4*)(wrl + (((k >> 8) * 4 + (k & 3)) * 64 + ((k >> 2) & 63)) * 20 + q4 * 4) = v; }
        if (F.tid < 16) lcnt[F.tid] = 0;
    }
    if (COMBINE) { if (F.tid == 0) { int s = 0;
#pragma unroll 1
        for (int e = 0; e < 16; ++e) { lcnt[32 + e] = s; const int cn = (int)__hip_atomic_load(F.ctl + CW_CNT + 64 * (l - 1) + e, RLX_AGENT); s += ((cn + 255) >> 8) << 8; } } }
    __syncthreads();
    const int cnt = (r1 - r0 - F.wave + 7) >> 3;
    typedef typename std::conditional<FIN, f32x4, u32x2>::type XR;
#define NP_ROW(i) ({ int _r = r0 + F.wave + 8 * (i); _r < r1 ? _r : r1 - 1; })
#define NP_LOAD_TK(dst, i) do { if constexpr (COMBINE) dst = F.TOK[NP_ROW(i)]; } while (0)
#define NP_LOAD_ROW(XQ_, O0, O1, TK, i) do { const int _rr = NP_ROW(i); \
        if constexpr (FIN) { const float* _xr = _rr < RL ? F.x_in + (size_t)_rr * D : F.ctx_in + (size_t)(_rr - RL) * D; \
            _Pragma("unroll") for (int j = 0; j < 4; ++j) XQ_[j] = ((const XR*)_xr)[F.lane + 64 * j]; } \
        else { _Pragma("unroll") for (int j = 0; j < 4; ++j) XQ_[j] = ((const XR*)(F.X + (size_t)_rr * D))[F.lane + 64 * j]; } \
        if constexpr (COMBINE) { const int _s0 = lcnt[32 + (TK.x & 15)] + (int)(TK.x >> 4), _s1 = lcnt[32 + (TK.y & 15)] + (int)(TK.y >> 4); \
            const u32x2* _o0 = (const u32x2*)(F.CS + (size_t)_s0 * 1024); const u32x2* _o1 = (const u32x2*)(F.CS + (size_t)_s1 * 1024); \
            _Pragma("unroll") for (int j = 0; j < 4; ++j) { O0[j] = _o0[F.lane + 64 * j]; O1[j] = _o1[F.lane + 64 * j]; } } } while (0)
    if (cnt > 0) {
        v4u tkA = {0u, 0u, 0u, 0u}, tkB = tkA; XR xa[4], xn[4]; u32x2 oa0[4], oa1[4], on0[4], on1[4];
#pragma unroll
        for (int j = 0; j < 4; ++j) { oa0[j] = (u32x2){0u, 0u}; oa1[j] = oa0[j]; on0[j] = oa0[j]; on1[j] = oa0[j]; }
        NP_LOAD_TK(tkA, 0); NP_LOAD_TK(tkB, 1);
        NP_LOAD_ROW(xa, oa0, oa1, tkA, 0);
#pragma unroll 1
        for (int i = 0; i < cnt; ++i) {
            const int r = r0 + F.wave + 8 * i;
            v4u tkC = tkB; NP_LOAD_TK(tkC, i + 2);
            NP_LOAD_ROW(xn, on0, on1, tkB, i + 1);
            const int bb = r < RL ? (r >> 12) : 8;
            f32x4 v[4];
#pragma unroll
            for (int j = 0; j < 4; ++j) { if constexpr (FIN) v[j] = xa[j]; else v[j] = (f32x4){bf_lo(xa[j].x), bf_hi(xa[j].x), bf_lo(xa[j].y), bf_hi(xa[j].y)}; }
            if (COMBINE) {
                const float w0 = __uint_as_float(tkA.z), w1 = __uint_as_float(tkA.w);
                const float* g2 = F.MOD + ((size_t)(l - 1) * 9 + bb) * 6144 + 5 * 1024;
#pragma unroll
                for (int j = 0; j < 4; ++j) { const u32x2 a = oa0[j], b = oa1[j]; const f32x4 gg = ((const f32x4*)g2)[F.lane + 64 * j];
                    v[j][0] += gg[0] * (w0 * bf_lo(a.x) + w1 * bf_lo(b.x)); v[j][1] += gg[1] * (w0 * bf_hi(a.x) + w1 * bf_hi(b.x));
                    v[j][2] += gg[2] * (w0 * bf_lo(a.y) + w1 * bf_lo(b.y)); v[j][3] += gg[3] * (w0 * bf_hi(a.y) + w1 * bf_hi(b.y)); }
                if (!FINAL) {
#pragma unroll
                    for (int j = 0; j < 4; ++j) { u32x2 w; w.x = cvt_pk_bf16(v[j][0], v[j][1]); w.y = cvt_pk_bf16(v[j][2], v[j][3]); ((u32x2*)(F.X + (size_t)r * D))[F.lane + 64 * j] = w; } }
            }
            float ss = 0.f;
#pragma unroll
            for (int j = 0; j < 4; ++j) ss += (v[j][0] * v[j][0] + v[j][1] * v[j][1]) + (v[j][2] * v[j][2] + v[j][3] * v[j][3]);
            const float rstd = frsq(wave_sum(ss, F.lane) * (1.0f / D) + EPS);
            if (FINAL) {
#pragma unroll
                for (int j = 0; j < 4; ++j) { const f32x4 fg = ((const f32x4*)F.final_g)[F.lane + 64 * j]; ((f32x4*)(F.out + (size_t)r * D))[F.lane + 64 * j] = v[j] * rstd * fg; }
            } else {
                const float* ng = F.norm_g + (size_t)(l * 2 + sel) * D; const float* md = F.MOD + ((size_t)l * 9 + bb) * 6144;
                const float* shp = md + (sel ? 3 : 0) * 1024; const float* scp = md + (sel ? 4 : 1) * 1024;
                f32x4 h[4];
#pragma unroll
                for (int j = 0; j < 4; ++j) { const f32x4 g = ((const f32x4*)ng)[F.lane + 64 * j], sc = ((const f32x4*)scp)[F.lane + 64 * j], sh = ((const f32x4*)shp)[F.lane + 64 * j];
                    h[j] = v[j] * rstd * g * (sc + 1.0f) + sh;
                    if (h8) ((unsigned*)((unsigned char*)F.H + (size_t)r * D))[F.lane + 64 * j] = cvt4_fp8(h[j][0], h[j][1], h[j][2], h[j][3]);
                    else { u32x2 w; w.x = cvt_pk_bf16(h[j][0], h[j][1]); w.y = cvt_pk_bf16(h[j][2], h[j][3]); ((u32x2*)(F.H + (size_t)r * D))[F.lane + 64 * j] = w; } }
                if (ROUTE) {
                    float a[16];
#pragma unroll
                    for (int e = 0; e < 16; ++e) a[e] = 0.f;
#pragma unroll
                    for (int j = 0; j < 4; ++j)
#pragma unroll
                        for (int q = 0; q < 4; ++q) { const LAS float* wp = wrl + ((j * 4 + q) * 64 + F.lane) * 20; const float hk = h[j][q];
                            const f32x4 w0 = *(const LAS f32x4*)wp, w1 = *(const LAS f32x4*)(wp + 4), w2 = *(const LAS f32x4*)(wp + 8), w3 = *(const LAS f32x4*)(wp + 12);
                            a[0] += hk * w0[0]; a[1] += hk * w0[1]; a[2] += hk * w0[2]; a[3] += hk * w0[3]; a[4] += hk * w1[0]; a[5] += hk * w1[1]; a[6] += hk * w1[2]; a[7] += hk * w1[3];
                            a[8] += hk * w2[0]; a[9] += hk * w2[1]; a[10] += hk * w2[2]; a[11] += hk * w2[3]; a[12] += hk * w3[0]; a[13] += hk * w3[1]; a[14] += hk * w3[2]; a[15] += hk * w3[3]; }
                    float mx = -3.0e38f;
#pragma unroll
                    for (int e = 0; e < 16; ++e) { a[e] = wave_sum(a[e], F.lane) + F.b_router[e]; mx = fmaxf(mx, a[e]); }
#pragma unroll
                    for (int e = 0; e < 16; ++e) a[e] = fexp(a[e] - mx);
                    float bs = -1.f, ba = 0.f, bbv = 0.f; int bi0 = 0, bi1 = 1;
#pragma unroll
                    for (int g = 0; g < 4; ++g) {
                        float p0 = a[4 * g]; int i0 = 0;
#pragma unroll
                        for (int k = 1; k < 4; ++k) if (a[4 * g + k] > p0) { p0 = a[4 * g + k]; i0 = k; }
                        float p1 = -1.f; int i1 = 0;
#pragma unroll
                        for (int k = 0; k < 4; ++k) if (k != i0 && a[4 * g + k] > p1) { p1 = a[4 * g + k]; i1 = k; }
                        const float gs = p0 + p1;
                        if (gs > bs) { bs = gs; ba = p0; bbv = p1; bi0 = 4 * g + i0; bi1 = 4 * g + i1; }
                    }
                    if (F.lane == 0) { const float inv = 1.0f / (ba + bbv);
                        const int lp0 = atomicAdd((int*)(lcnt + bi0), 1), lp1 = atomicAdd((int*)(lcnt + bi1), 1);
                        LAS int* ri = rinfo + (r - r0) * 6; ri[0] = bi0; ri[1] = lp0; ri[2] = bi1; ri[3] = lp1; ri[4] = (int)__float_as_uint(ba * inv); ri[5] = (int)__float_as_uint(bbv * inv); }
                }
            }
#pragma unroll
            for (int j = 0; j < 4; ++j) { xa[j] = xn[j]; oa0[j] = on0[j]; oa1[j] = on1[j]; }
            tkA = tkB; tkB = tkC;
        }
    }
#undef NP_ROW
#undef NP_LOAD_TK
#undef NP_LOAD_ROW
    if (ROUTE) {
        __syncthreads();
        if (F.tid < 16) lcnt[16 + F.tid] = (int)__hip_atomic_fetch_add(F.ctl + CW_CNT + 64 * l + F.tid, (unsigned)lcnt[F.tid], RLX_AGENT);
        __syncthreads();
        for (int i = F.tid; i < r1 - r0; i += 512) { const LAS int* ri = rinfo + i * 6; const int e0 = ri[0], e1 = ri[2], p0 = lcnt[16 + e0] + ri[1], p1 = lcnt[16 + e1] + ri[3];
            v4u tk; tk.x = (unsigned)e0 | ((unsigned)p0 << 4); tk.y = (unsigned)e1 | ((unsigned)p1 << 4); tk.z = (unsigned)ri[4]; tk.w = (unsigned)ri[5]; F.TOK[r0 + i] = tk;
            F.LIST[(size_t)e0 * RT + p0] = r0 + i; F.LIST[(size_t)e1 * RT + p1] = r0 + i; }
    }
    __syncthreads();
}

__device__ __forceinline__ const LAS int* moe_table(Frame& F, int l) {
    LAS int* tab = (LAS int*)(F.MISC + 16);
    __syncthreads();
    if (F.tid == 0) { int s = 0;
#pragma unroll 1
        for (int e = 0; e < 16; ++e) { const int cn = (int)__hip_atomic_load(F.ctl + CW_CNT + 64 * l + e, RLX_AGENT); tab[e] = s; tab[32 + e] = cn; s += (cn + 255) >> 8; } tab[16] = s; }
    __syncthreads();
    return tab;
}

#define MMA16(acc, afrag, bfrag) acc = __builtin_amdgcn_mfma_f32_16x16x32_bf16(bfrag, afrag, acc, 0, 0, 0)
constexpr int TP = 136;
__device__ __forceinline__ int chunk_row0(int b, int c) { return c < 2 ? RL + b * LC + c * 128 : b * SEQ + (c - 2) * 128; }

__device__ __forceinline__ void stage_vt(Frame& F, LAS bf16* VT, const bf16* src  , int ld) {
    const int j = F.tid >> 2, e0 = (F.tid & 3) * 32;
    const v4u* p = (const v4u*)(src + (size_t)j * ld + e0);
    v4u q[4];
#pragma unroll
    for (int t = 0; t < 4; ++t) q[t] = p[t];
#pragma unroll
    for (int t = 0; t < 4; ++t) { const unsigned w[4] = {q[t].x, q[t].y, q[t].z, q[t].w};
#pragma unroll
        for (int k = 0; k < 4; ++k) { VT[(e0 + t * 8 + 2 * k) * TP + j] = (bf16)(w[k] & 0xffffu); VT[(e0 + t * 8 + 2 * k + 1) * TP + j] = (bf16)(w[k] >> 16); } }
}

__device__ __forceinline__ void ret_kv_phase(Frame& F, int li) {
    LAS bf16* KTf = (LAS bf16*)F.lds; LAS bf16* KTb = KTf + 64 * TP; LAS bf16* VT = KTb + 64 * TP;
    const int fr = F.lane & 15, fq = F.lane >> 4;
    for (int u = F.vcu; u < NB * NCH * 4; u += F.G) {
        const int h = u & 3, c = (u >> 2) % NCH, b = u / (NCH * 4); const int row0 = chunk_row0(b, c);
        const float l2f = -fexp(F.ret_ld[(li * 2 + 0) * 4 + h]) * 1.4426950409f, l2b = -fexp(F.ret_ld[(li * 2 + 1) * 4 + h]) * 1.4426950409f;
        { const int j = F.tid >> 2, d0 = (F.tid & 3) * 16; const v4u* kp = (const v4u*)(F.BIG + (size_t)(row0 + j) * EVEN_IN + 256 + h * 64 + d0);
          const v4u k0 = kp[0], k1 = kp[1]; const float wf = fexp2((float)(127 - j) * l2f), wb = fexp2((float)j * l2b);
          const unsigned w[8] = {k0.x, k0.y, k0.z, k0.w, k1.x, k1.y, k1.z, k1.w};
#pragma unroll
          for (int k = 0; k < 8; ++k) { const float lo = bf_lo(w[k]), hi = bf_hi(w[k]);
              KTf[(d0 + 2 * k) * TP + j] = f2bf(lo * wf); KTf[(d0 + 2 * k + 1) * TP + j] = f2bf(hi * wf);
              KTb[(d0 + 2 * k) * TP + j] = f2bf(lo * wb); KTb[(d0 + 2 * k + 1) * TP + j] = f2bf(hi * wb); } }
        stage_vt(F, VT, F.BIG + (size_t)row0 * EVEN_IN + 512 + h * 128, EVEN_IN);
        __syncthreads();
        const int dir = F.wave >> 2, mp = F.wave & 3; const LAS bf16* KT = dir ? KTb : KTf;
        f32x4 acc[2][4];
#pragma unroll
        for (int mi = 0; mi < 2; ++mi)
#pragma unroll
            for (int n = 0; n < 4; ++n) acc[mi][n] = (f32x4){0.f, 0.f, 0.f, 0.f};
#pragma unroll
        for (int ks = 0; ks < 4; ++ks) { bf16x8 bv[4];
#pragma unroll
            for (int n = 0; n < 4; ++n) bv[n] = *(const LAS bf16x8*)(KT + (16 * n + fr) * TP + 32 * ks + 8 * fq);
#pragma unroll
            for (int mi = 0; mi < 2; ++mi) { const bf16x8 a = *(const LAS bf16x8*)(VT + (32 * mp + 16 * mi + fr) * TP + 32 * ks + 8 * fq);
#pragma unroll
                for (int n = 0; n < 4; ++n) MMA16(acc[mi][n], a, bv[n]); } }
        float* op = F.KV + ((size_t)(((b * NCH + c) * 4 + h) * 2 + dir) * 128 + 32 * mp + fr) * 64 + 4 * fq;
#pragma unroll
        for (int mi = 0; mi < 2; ++mi)
#pragma unroll
            for (int n = 0; n < 4; ++n) *(f32x4*)(op + (size_t)mi * 16 * 64 + 16 * n) = acc[mi][n];
        __syncthreads();
    }
}

__device__ __forceinline__ void ret_scan_phase(Frame& F, int li) {
    const int gt = F.vcu * 512 + F.tid, GT = F.G * 512;
    for (int it = gt; it < 64 * 128 * 16; it += GT) {
        const int dg = it & 15, e = (it >> 4) & 127, chain = it >> 11, dir = chain & 1, h = (chain >> 1) & 3, b = chain >> 3;
        const float l2 = -fexp(F.ret_ld[(li * 2 + dir) * 4 + h]) * 1.4426950409f; const float cd = fexp2(128.f * l2);
        f32x4 s = {0.f, 0.f, 0.f, 0.f};
        const size_t eo = (size_t)e * 64 + 4 * dg;
#define SC_BLK(st) ((size_t)(((b * NCH + (dir ? ((st) == 0 ? 1 : ((st) == 1 ? 0 : 35 - (st))) : (st))) * 4 + h) * 2 + dir) * 8192)
#pragma unroll 1
        for (int s0 = 0; s0 < NCH; s0 += 8) {
            f32x4 kvv[8];
#pragma unroll
            for (int k = 0; k < 8; ++k) { const int st = (s0 + k < NCH) ? s0 + k : NCH - 1; kvv[k] = *(const f32x4*)(F.KV + SC_BLK(st) + eo); }
#pragma unroll
            for (int k = 0; k < 8; ++k) { if (s0 + k < NCH) { u32x2 w; w.x = cvt_pk_bf16(s[0], s[1]); w.y = cvt_pk_bf16(s[2], s[3]);
                *(u32x2*)(F.ST + SC_BLK(s0 + k) + eo) = w; s = s * cd + kvv[k]; } }
        }
#undef SC_BLK
    }
}

__device__ __forceinline__ void mixer_phase(Frame& F, int li) {
    LAS bf16* VT = (LAS bf16*)F.lds; LAS bf16* PB = VT + 128 * TP; LAS bf16* SN = PB + 128 * TP; LAS f32x2* stats = (LAS f32x2*)(F.lds + 3 * 128 * TP * 2);
    const int fr = F.lane & 15, fq = F.lane >> 4, irow = 16 * F.wave + fr;
    for (int u = F.vcu; u < NB * NCH * 4; u += F.G) {
        const int h = u & 3, c = (u >> 2) % NCH, b = u / (NCH * 4), row0 = chunk_row0(b, c); const size_t grow = (size_t)(row0 + irow);
        const bf16* Pr = F.BIG + grow * EVEN_IN;
        const float l2f = -fexp(F.ret_ld[(li * 2 + 0) * 4 + h]) * 1.4426950409f, l2b = -fexp(F.ret_ld[(li * 2 + 1) * 4 + h]) * 1.4426950409f;
        bf16x8 qf[2], kf[8][2];
#pragma unroll
        for (int ks = 0; ks < 2; ++ks) qf[ks] = *(const bf16x8*)(Pr + h * 64 + 32 * ks + 8 * fq);
#pragma unroll
        for (int n = 0; n < 8; ++n)
#pragma unroll
            for (int ks = 0; ks < 2; ++ks) kf[n][ks] = *(const bf16x8*)(F.BIG + (size_t)(row0 + 16 * n + fr) * EVEN_IN + 256 + h * 64 + 32 * ks + 8 * fq);
        stage_vt(F, VT, F.BIG + (size_t)row0 * EVEN_IN + 512 + h * 128, EVEN_IN);
        { v4u sv[16];
#pragma unroll
          for (int tt = 0; tt < 16; ++tt) sv[tt] = *(const v4u*)(F.BIG + (size_t)(row0 + 16 * F.wave + tt) * EVEN_IN + 2048 + 8 * F.lane);
#pragma unroll
          for (int tt = 0; tt < 16; ++tt) { const float x[8] = {bf_lo(sv[tt].x), bf_hi(sv[tt].x), bf_lo(sv[tt].y), bf_hi(sv[tt].y), bf_lo(sv[tt].z), bf_hi(sv[tt].z), bf_lo(sv[tt].w), bf_hi(sv[tt].w)};
            float s = 0.f;
#pragma unroll
            for (int k = 0; k < 8; ++k) s += x[k];
            const float mean = wave_sum(s, F.lane) * (1.0f / 512.0f); float q = 0.f;
#pragma unroll
            for (int k = 0; k < 8; ++k) q += (x[k] - mean) * (x[k] - mean);
            const float rstd = frsq(wave_sum(q, F.lane) * (1.0f / 512.0f) + EPS);
            if (F.lane == 0) stats[16 * F.wave + tt] = (f32x2){mean, rstd}; } }
        __syncthreads();
        {
            const int qt = F.tid >> 2, c0 = (F.tid & 3) * 32; const f32x2 st = stats[qt];
            const v4u* p = (const v4u*)(F.BIG + (size_t)(row0 + qt) * EVEN_IN + 2048 + h * 128 + c0);
            const float* lg = F.sg_ln_g + li * 512 + h * 128 + c0; const float* lb = F.sg_ln_b + li * 512 + h * 128 + c0;
#pragma unroll
            for (int t = 0; t < 4; ++t) { const v4u sv = p[t]; const unsigned w[4] = {sv.x, sv.y, sv.z, sv.w}; const f32x4 g0 = *(const f32x4*)(lg + 8 * t), g1 = *(const f32x4*)(lg + 8 * t + 4), b0 = *(const f32x4*)(lb + 8 * t), b1 = *(const f32x4*)(lb + 8 * t + 4);
                const float gg[8] = {g0[0], g0[1], g0[2], g0[3], g1[0], g1[1], g1[2], g1[3]}, bbv[8] = {b0[0], b0[1], b0[2], b0[3], b1[0], b1[1], b1[2], b1[3]};
#pragma unroll
                for (int k = 0; k < 4; ++k) { const float lo = (bf_lo(w[k]) - st.x) * st.y * gg[2 * k] + bbv[2 * k], hi = (bf_hi(w[k]) - st.x) * st.y * gg[2 * k + 1] + bbv[2 * k + 1];
                    SN[(c0 + 8 * t + 2 * k) * TP + qt] = f2bf(lo); SN[(c0 + 8 * t + 2 * k + 1) * TP + qt] = f2bf(hi); } }
        }
        {
            f32x4 acc[8];
#pragma unroll
            for (int n = 0; n < 8; ++n) acc[n] = (f32x4){0.f, 0.f, 0.f, 0.f};
#pragma unroll
            for (int n = 0; n < 8; ++n)
#pragma unroll
                for (int ks = 0; ks < 2; ++ks) MMA16(acc[n], qf[ks], kf[n][ks]);
#pragma unroll
            for (int n = 0; n < 8; ++n) { float pv[4];
#pragma unroll
                for (int r = 0; r < 4; ++r) { const int dl = irow - (16 * n + 4 * fq + r); const float dec = dl > 0 ? fexp2((float)dl * l2f) : (dl < 0 ? fexp2((float)(-dl) * l2b) : 2.0f); pv[r] = acc[n][r] * dec; }
                u32x2 w; w.x = cvt_pk_bf16(pv[0], pv[1]); w.y = cvt_pk_bf16(pv[2], pv[3]); *(LAS u32x2*)(PB + irow * TP + 16 * n + 4 * fq) = w; }
        }
        const bf16* sp = F.ST + (size_t)((((b * NCH + c) * 4 + h) * 2) * 128 + fr) * 64 + 8 * fq;
        bf16x8 sfr[8][2];
#pragma unroll
        for (int n = 0; n < 8; ++n)
#pragma unroll
            for (int ks = 0; ks < 2; ++ks) sfr[n][ks] = *(const bf16x8*)(sp + (16 * n) * 64 + 32 * ks);
        LDS_WAIT();
        f32x4 ao[8];
#pragma unroll
        for (int n = 0; n < 8; ++n) ao[n] = (f32x4){0.f, 0.f, 0.f, 0.f};
#pragma unroll
        for (int ks = 0; ks < 4; ++ks) { const bf16x8 a = *(const LAS bf16x8*)(PB + irow * TP + 32 * ks + 8 * fq);
#pragma unroll
            for (int n = 0; n < 8; ++n) { const bf16x8 bv = *(const LAS bf16x8*)(VT + (16 * n + fr) * TP + 32 * ks + 8 * fq); MMA16(ao[n], a, bv); } }
#pragma unroll
        for (int dir = 0; dir < 2; ++dir) {
            const float xi = dir ? fexp2((float)(128 - irow) * l2b) : fexp2((float)(irow + 1) * l2f);
            f32x4 ax[8];
#pragma unroll
            for (int n = 0; n < 8; ++n) ax[n] = (f32x4){0.f, 0.f, 0.f, 0.f};
#pragma unroll
            for (int n = 0; n < 8; ++n)
#pragma unroll
                for (int ks = 0; ks < 2; ++ks) MMA16(ax[n], qf[ks], sfr[n][ks]);
            if (dir == 0) {
#pragma unroll
                for (int n = 0; n < 8; ++n)
#pragma unroll
                    for (int ks = 0; ks < 2; ++ks) sfr[n][ks] = *(const bf16x8*)(sp + 128 * 64 + (16 * n) * 64 + 32 * ks); }
#pragma unroll
            for (int n = 0; n < 8; ++n) ao[n] = ao[n] + ax[n] * xi;
        }
        float s = 0.f;
#pragma unroll
        for (int n = 0; n < 8; ++n) s += (ao[n][0] + ao[n][1]) + (ao[n][2] + ao[n][3]);
        s = col_sum4(s);
        const float mean = s * (1.0f / 128.0f); float q = 0.f;
#pragma unroll
        for (int n = 0; n < 8; ++n) { const f32x4 d = ao[n] - mean; q += (d[0] * d[0] + d[1] * d[1]) + (d[2] * d[2] + d[3] * d[3]); }
        q = col_sum4(q);
        const float rstd = frsq(q * (1.0f / 128.0f) + EPS);
#pragma unroll
        for (int n = 0; n < 8; ++n) { const int e0 = 16 * n + 4 * fq; const u32x2 gt = *(const u32x2*)(Pr + 1024 + h * 128 + e0); const f32x4 gn = *(const f32x4*)(F.ret_gn + li * 512 + h * 128 + e0);
            const float y0 = (ao[n][0] - mean) * rstd * gn[0] * silu_f(bf_lo(gt.x)), y1 = (ao[n][1] - mean) * rstd * gn[1] * silu_f(bf_hi(gt.x));
            const float y2 = (ao[n][2] - mean) * rstd * gn[2] * silu_f(bf_lo(gt.y)), y3 = (ao[n][3] - mean) * rstd * gn[3] * silu_f(bf_hi(gt.y));
            u32x2 w; w.x = cvt_pk_bf16(y0, y1); w.y = cvt_pk_bf16(y2, y3); *(u32x2*)(F.MIX + grow * D + h * 128 + e0) = w; }
        __syncthreads();
        {
            f32x4 acc[8];
#pragma unroll
            for (int n = 0; n < 8; ++n) acc[n] = (f32x4){0.f, 0.f, 0.f, 0.f};
#pragma unroll
            for (int ks = 0; ks < 4; ++ks) { const bf16x8 a = *(const bf16x8*)(F.SGW + ((size_t)(li * 4 + h) * 128 + irow) * 128 + 32 * ks + 8 * fq);
#pragma unroll
                for (int n = 0; n < 8; ++n) { const bf16x8 bv = *(const LAS bf16x8*)(SN + (16 * n + fr) * TP + 32 * ks + 8 * fq); MMA16(acc[n], a, bv); } }
            const float bsv = F.sg_b[(li * 4 + h) * 128 + irow];
#pragma unroll
            for (int n = 0; n < 8; ++n) { const int c0 = 16 * n + 4 * fq; const u32x2 uu = *(const u32x2*)(Pr + 1536 + h * 128 + c0);
                u32x2 w; w.x = cvt_pk_bf16(bf_lo(uu.x) * (acc[n][0] + bsv), bf_hi(uu.x) * (acc[n][1] + bsv)); w.y = cvt_pk_bf16(bf_lo(uu.y) * (acc[n][2] + bsv), bf_hi(uu.y) * (acc[n][3] + bsv));
                *(u32x2*)(F.MIX + grow * D + 512 + h * 128 + c0) = w; }
        }
        __syncthreads();
    }
}

namespace att {
constexpr int QBLK = 32, KVBLK = 64, DH = 128;
constexpr float SCALE = 0.088388347648318440f;
constexpr float THR = 8.f;
constexpr int LDQ = 1024, LDK = 256, LDO = 1024;
constexpr size_t SHM_V = KVBLK * DH * 2, SHM_K = KVBLK * DH * 2, SHM_ATTN = 2 * SHM_V + 2 * SHM_K + NWAVES * 64 * 4;
#define KSWZ(row, colB) ((row) * 256 + ((colB) ^ (((row) & 7) << 4)))
#define SBAR() __builtin_amdgcn_sched_barrier(0)
__device__ __forceinline__ int crow(int r, int hi) { return (r & 3) + 8 * (r >> 2) + 4 * hi; }
__device__ __forceinline__ void partialSM(f32x16& p0, f32x16& p1, float& m_reg, float& mn, float& alpha) {
  constexpr float C = SCALE * 1.4426950408889634f;
  float pmax = p0[0]; for (int r = 1; r < 16; ++r) pmax = fmaxf(pmax, p0[r]); for (int r = 0; r < 16; ++r) pmax = fmaxf(pmax, p1[r]);
  { auto rr = __builtin_amdgcn_permlane32_swap(__float_as_uint(pmax), __float_as_uint(pmax), false, false);
    pmax = fmaxf(__uint_as_float(rr[0]), __uint_as_float(rr[1])); }
  if (__builtin_expect(__all(pmax - m_reg <= THR / SCALE), 1)) { mn = m_reg; alpha = 1.f; }
  else { mn = fmaxf(m_reg, pmax); alpha = __builtin_amdgcn_exp2f((m_reg - mn) * C); m_reg = mn; }
  float mnC = -mn * C;
  for (int r = 0; r < 16; ++r) p0[r] = fmaf(p0[r], C, mnC); for (int r = 0; r < 16; ++r) p1[r] = fmaf(p1[r], C, mnC);
  for (int r = 0; r < 16; ++r) p0[r] = __builtin_amdgcn_exp2f(p0[r]);
}
__device__ __forceinline__ void finishSM(f32x16& p0, f32x16& p1, float alpha, float& l_reg, bf16x8& pa0, bf16x8& pa1, bf16x8& pa2, bf16x8& pa3) {
  for (int r = 0; r < 16; ++r) p1[r] = __builtin_amdgcn_exp2f(p1[r]);
  float ps = 0; for (int r = 0; r < 16; ++r) ps += p0[r]; for (int r = 0; r < 16; ++r) ps += p1[r];
  { auto rr = __builtin_amdgcn_permlane32_swap(__float_as_uint(ps), __float_as_uint(ps), false, false);
    ps = __uint_as_float(rr[0]) + __uint_as_float(rr[1]); }
  l_reg = l_reg * alpha + ps;
#define PK4(P, BASE, OUT) do { unsigned a0 = cvt_pk_bf16(P[BASE + 0], P[BASE + 1]), a1 = cvt_pk_bf16(P[BASE + 2], P[BASE + 3]);   \
    unsigned b0 = cvt_pk_bf16(P[BASE + 4], P[BASE + 5]), b1 = cvt_pk_bf16(P[BASE + 6], P[BASE + 7]);                              \
    auto r0 = __builtin_amdgcn_permlane32_swap(a0, b0, false, false); auto r1 = __builtin_amdgcn_permlane32_swap(a1, b1, false, false); \
    v4u w = {r0[0], r1[0], r0[1], r1[1]}; OUT = *reinterpret_cast<bf16x8*>(&w); } while (0)
  PK4(p0, 0, pa0); PK4(p0, 8, pa1); PK4(p1, 0, pa2); PK4(p1, 8, pa3);
#undef PK4
}
__device__ __forceinline__ void qkt(f32x16& p0, f32x16& p1, const int (&kb4)[4], int boff, const bf16x8* qr) {
  p0 = f32x16{}; p1 = f32x16{};
#pragma unroll
  for (int d0 = 0; d0 < 8; ++d0) { const LAS char* kp = (const LAS char*)(uintptr_t)(unsigned)(kb4[d0 & 3] + boff);
    bf16x8 b0 = *reinterpret_cast<const LAS bf16x8*>(kp + (d0 >> 2) * 128);
    bf16x8 b1 = *reinterpret_cast<const LAS bf16x8*>(kp + (d0 >> 2) * 128 + 8192);
    p0 = __builtin_amdgcn_mfma_f32_32x32x16_bf16(b0, qr[d0], p0, 0, 0, 0);
    p1 = __builtin_amdgcn_mfma_f32_32x32x16_bf16(b1, qr[d0], p1, 0, 0, 0); }
}
__device__ __forceinline__ void mask_tile(f32x16& p0, f32x16& p1, int mk, int jb, int i, int hi) {
  if (mk == 1) { for (int r = 0; r < 16; ++r) { const int j = jb + crow(r, hi); p0[r] = (j >= i) ? p0[r] : -1e30f; p1[r] = (j + 32 >= i) ? p1[r] : -1e30f; } }
  else if (mk == 2) { for (int r = 0; r < 16; ++r) { const int j = jb + crow(r, hi); p0[r] = (j <= i) ? p0[r] : -1e30f; p1[r] = (j + 32 <= i) ? p1[r] : -1e30f; } }
}
__device__ __forceinline__ int v_st(int k, int c) { const int kk = (k & ~0xC) | ((k & 4) << 1) | ((k & 8) >> 1); return ((kk >> 3) * 4 + (c >> 5)) * 512 + ((kk & 7) * 32 + (c & 31)) * 2; }
__device__ __forceinline__ int v_rd_base(int lane) { return ((lane & 3) << 3) | (((lane >> 2) & 3) << 6) | (((lane >> 4) & 1) << 5) | (((lane >> 5) & 1) << 8); }
constexpr int v_rd_off(int d0, int ks, int half) { return d0 * 512 + ks * 4096 + half * 2048; }
template <int OFF> __device__ __forceinline__ s16x4 tr_read(int vb) {
  s16x4 r; asm volatile("ds_read_b64_tr_b16 %0, %1 offset:%2" : "=&v"(r) : "v"(vb), "i"(OFF) : "memory"); return r;
}
template <int D0> __device__ __forceinline__ void pv_one(f32x16& od, int vb, bf16x8 pa0, bf16x8 pa1, bf16x8 pa2, bf16x8 pa3) {
  const s16x4 l0 = tr_read<v_rd_off(D0, 0, 0)>(vb), h0 = tr_read<v_rd_off(D0, 0, 1)>(vb), l1 = tr_read<v_rd_off(D0, 1, 0)>(vb), h1 = tr_read<v_rd_off(D0, 1, 1)>(vb);
  const s16x4 l2 = tr_read<v_rd_off(D0, 2, 0)>(vb), h2 = tr_read<v_rd_off(D0, 2, 1)>(vb), l3 = tr_read<v_rd_off(D0, 3, 0)>(vb), h3 = tr_read<v_rd_off(D0, 3, 1)>(vb);
  asm volatile("s_waitcnt lgkmcnt(0)" ::: "memory"); SBAR();
#define PK(L, H) (bf16x8){L[0], L[1], L[2], L[3], H[0], H[1], H[2], H[3]}
  od = __builtin_amdgcn_mfma_f32_32x32x16_bf16(pa0, PK(l0, h0), od, 0, 0, 0);
  od = __builtin_amdgcn_mfma_f32_32x32x16_bf16(pa1, PK(l1, h1), od, 0, 0, 0);
  od = __builtin_amdgcn_mfma_f32_32x32x16_bf16(pa2, PK(l2, h2), od, 0, 0, 0);
  od = __builtin_amdgcn_mfma_f32_32x32x16_bf16(pa3, PK(l3, h3), od, 0, 0, 0);
#undef PK
}
__device__ __forceinline__ void pv_d0(f32x16* o, int vb, bf16x8 pa0, bf16x8 pa1, bf16x8 pa2, bf16x8 pa3) {
  pv_one<0>(o[0], vb, pa0, pa1, pa2, pa3); pv_one<1>(o[1], vb, pa0, pa1, pa2, pa3); pv_one<2>(o[2], vb, pa0, pa1, pa2, pa3); pv_one<3>(o[3], vb, pa0, pa1, pa2, pa3);
}

__device__ __forceinline__ void attn_unit(const bf16* __restrict__ Q, const bf16* __restrict__ Kb, const bf16* __restrict__ Vb, bf16* __restrict__ O, const float* __restrict__ sinkp,
                                          int qrow0, int h0, int kvh, int klat, int kctx, int add0, int skipnext, int NT, char* lds, const int tid) {
  const int wid = tid >> 6, lane = tid & 63, r32 = lane & 31, hi = lane >> 5;
  bf16* V_lds = (bf16*)lds; bf16* K_lds = (bf16*)(lds + 2 * SHM_V);
  float* ws = (float*)(lds + 2 * SHM_V + 2 * SHM_K) + wid * 64; float* li_l = ws; float* al_l = ws + 32;
  const int head = h0 + (wid >> 2), iq = (wid & 3) * QBLK + r32;
  float m_reg = sinkp[head] * (1.0f / SCALE), l_reg = 1.0f; f32x16 o[4] = {}; bf16x8 qr[8];
  const bf16* Qw = Q + (size_t)(qrow0 + iq) * LDQ + head * DH + hi * 8;
#pragma unroll
  for (int d0 = 0; d0 < 8; ++d0) qr[d0] = *reinterpret_cast<const bf16x8*>(Qw + d0 * 16);
  const int sr = tid >> 4, sc = (tid & 15) * 8, vst0 = v_st(sr, sc), vst1 = v_st(32 + sr, sc);
  const int vb0 = (int)(uintptr_t)V_lds + v_rd_base(lane);
  int kb4[4];
#pragma unroll
  for (int q = 0; q < 4; ++q) kb4[q] = (int)(uintptr_t)K_lds + r32 * 256 + ((q << 5) ^ ((hi << 4) ^ ((r32 & 7) << 4)));
  const unsigned kvoff = (unsigned)((sr * LDK + kvh * DH + sc) * 2);
  struct { bf16x8 vs0, vs1, ks0, ks1; } sr_[2];
#define TILE_T(s) ({ int _t = (s) + add0; if (skipnext && _t >= 4) _t += 2; _t; })
#define TILE_ROW(t) ((t) < 6 ? klat + 64 * (t) : kctx + 64 * ((t) - 6))
#define TILE_MK(t) ((t) < 2 ? 1 : (((t) >= 4 && (t) < 6) ? 2 : 0))
#define SLOAD(i, s) do { const int _t = TILE_T(s); const size_t _k0 = (size_t)TILE_ROW(_t) * (LDK * 2); const char* _kp = (const char*)Kb + _k0; const char* _vp = (const char*)Vb + _k0; \
    sr_[i].vs0 = *reinterpret_cast<const bf16x8*>(_vp + kvoff); sr_[i].vs1 = *reinterpret_cast<const bf16x8*>(_vp + 32 * LDK * 2 + kvoff); \
    sr_[i].ks0 = *reinterpret_cast<const bf16x8*>(_kp + kvoff); sr_[i].ks1 = *reinterpret_cast<const bf16x8*>(_kp + 32 * LDK * 2 + kvoff); } while (0)
#define SWRITE(b, i) do { *(bf16x8*)((char*)V_lds + (b) * SHM_V + vst0) = sr_[i].vs0;          \
    *(bf16x8*)((char*)V_lds + (b) * SHM_V + vst1) = sr_[i].vs1; int kc = sc * 2;               \
    *(bf16x8*)((char*)K_lds + (b) * SHM_K + KSWZ(sr, kc)) = sr_[i].ks0;                       \
    *(bf16x8*)((char*)K_lds + (b) * SHM_K + KSWZ(32 + sr, kc)) = sr_[i].ks1; } while (0)
#define SWAIT() asm volatile("s_waitcnt vmcnt(4)" ::: "memory")
#define RESC(a) do { if (__any((a) < 1.f)) { if (hi == 0) al_l[r32] = (a); asm volatile("s_waitcnt lgkmcnt(0)" ::: "memory"); \
    for (int d = 0; d < 4; ++d) for (int r = 0; r < 16; ++r) o[d][r] *= al_l[crow(r, hi)]; } } while (0)
#define MASK(P0, P1, s) do { const int _t = TILE_T(s); mask_tile(P0, P1, TILE_MK(_t), 64 * (_t & 1), iq, hi); } while (0)
  f32x16 pA0, pA1, pB0, pB1; float mnA, mnB, alA, alB; bf16x8 pa0, pa1, pa2, pa3;
  constexpr int SE = 0, SO = 1;
  SLOAD(SE, 0); asm volatile("s_waitcnt vmcnt(0)" ::: "memory"); SWRITE(0, SE); __syncthreads();
  qkt(pA0, pA1, kb4, 0, qr); MASK(pA0, pA1, 0); partialSM(pA0, pA1, m_reg, mnA, alA);
  SLOAD(SO, 1); if (2 < NT) SLOAD(SE, 2);
  SWAIT(); SWRITE(1, SO); __syncthreads();
  for (int j = 1; j + 1 < NT; j += 2) {
    SBAR(); qkt(pB0, pB1, kb4, (int)SHM_K, qr); MASK(pB0, pB1, j);
    finishSM(pA0, pA1, alA, l_reg, pa0, pa1, pa2, pa3); SBAR();
    SLOAD(SO, j + 2); SBAR();
    pv_d0(o, vb0, pa0, pa1, pa2, pa3); partialSM(pB0, pB1, m_reg, mnB, alB);
    __syncthreads(); SWAIT(); SWRITE(0, SE);
    RESC(alB); __syncthreads();
    SBAR(); qkt(pA0, pA1, kb4, 0, qr); MASK(pA0, pA1, j + 1);
    finishSM(pB0, pB1, alB, l_reg, pa0, pa1, pa2, pa3); SBAR();
    if (j + 3 < NT) SLOAD(SE, j + 3); SBAR();
    pv_d0(o, vb0 + (int)SHM_V, pa0, pa1, pa2, pa3); partialSM(pA0, pA1, m_reg, mnA, alA);
    __syncthreads(); SWAIT(); SWRITE(1, SO);
    RESC(alA); __syncthreads();
  }
  SBAR(); qkt(pB0, pB1, kb4, (int)SHM_K, qr); MASK(pB0, pB1, NT - 1);
  finishSM(pA0, pA1, alA, l_reg, pa0, pa1, pa2, pa3); SBAR();
  pv_d0(o, vb0, pa0, pa1, pa2, pa3); partialSM(pB0, pB1, m_reg, mnB, alB);
  __syncthreads(); RESC(alB);
  finishSM(pB0, pB1, alB, l_reg, pa0, pa1, pa2, pa3); SBAR();
  pv_d0(o, vb0 + (int)SHM_V, pa0, pa1, pa2, pa3);
  if (hi == 0) li_l[r32] = l_reg; asm volatile("s_waitcnt lgkmcnt(0)" ::: "memory");
  float rli[16];
#pragma unroll
  for (int r = 0; r < 16; ++r) rli[r] = __builtin_amdgcn_rcpf(li_l[crow(r, hi)]);
  bf16* Ow = O + (size_t)(qrow0 + (wid & 3) * QBLK) * LDO + head * DH;
#pragma unroll
  for (int r = 0; r < 16; ++r) { int orow = crow(r, hi);
    for (int d0 = 0; d0 < 4; ++d0) Ow[(size_t)orow * LDO + d0 * 32 + r32] = f2bf(o[d0][r] * rli[r]); }
  __syncthreads();
#undef TILE_T
#undef TILE_ROW
#undef TILE_MK
#undef SLOAD
#undef SWRITE
#undef SWAIT
#undef RESC
#undef MASK
}
}

__device__ __forceinline__ void attn_phase(Frame& F, int li, bool need_ctx) {
    const bf16* Q = F.BIG; const bf16* Kb = (const bf16*)((const char*)F.BIG + BIG_K); const bf16* Vb = (const bf16*)((const char*)F.BIG + BIG_V);
    const float* sinkp = F.sink + li * 8;
    const int NU = 1024 + (need_ctx ? 64 : 0);
    for (int u = F.vcu; u < NU; u += F.G) {
        if (u < 1024) { const int pair = u & 1, kvh = (u >> 1) & 1, n = (u >> 2) & 31, b = u >> 7;
            const int add0 = (n == 0) ? 2 : 0, skipnext = (n == 31) ? 1 : 0, NT = 10 - ((n == 0 || n == 31) ? 2 : 0);
            att::attn_unit(Q, Kb, Vb, F.MIX, sinkp, b * SEQ + n * 128, kvh * 4 + pair * 2, kvh, b * SEQ + (n - 1) * 128, RL + b * LC, add0, skipnext, NT, F.ldsg, F.tid);
        } else { const int v = u - 1024, pair = v & 1, kvh = (v >> 1) & 1, cb = (v >> 2) & 1, b = v >> 3;
            att::attn_unit(Q, Kb, Vb, F.MIX, sinkp, RL + b * LC + cb * 128, kvh * 4 + pair * 2, kvh, 0, RL + b * LC, 6, 0, 4, F.ldsg, F.tid);
        }
    }
}

#ifndef MK_SINGLE
#define MK_SINGLE 1
#endif
#ifndef REP_SET
#define REP_SET 0
#endif
#define RP(n) ((REP_SET == 200 + (n)) ? 2 : 1)
constexpr int REPS[14] = {RP(0), RP(1), RP(2), RP(3), RP(4), RP(5), RP(6), RP(7), RP(8), RP(9), RP(10), RP(11), RP(12), RP(13)};
#ifdef ONLY
#define ONLYX(n, stmt) do { if constexpr (ONLY == (n)) { stmt; } } while (0)
#else
#define ONLYX(n, stmt) do { for (int rep_ = 0; rep_ < REPS[n]; ++rep_) { stmt; if (rep_ + 1 < REPS[n]) xcd_barrier(bar); } } while (0)
#endif
constexpr int PPL = 9;
constexpr int NPHASE = 1 + DEPTH * PPL + 1;

#define CAS __attribute__((address_space(4)))
__device__ __forceinline__ void fill_ptrs(Frame& F, LAS unsigned char* ldsbase, int wv) {
    const CAS char* ka = (const CAS char*)__builtin_amdgcn_kernarg_segment_ptr(); asm volatile("" : "+s"(ka));
    { F.lds = ldsbase; F.ldsg = (char*)ldsbase; F.MISC = (volatile LAS unsigned*)(ldsbase + MISC_OFF); }
    { asm volatile("" : "+s"(wv)); unsigned am = ~0u; asm volatile("" : "+s"(am)); int ln = (int)__builtin_amdgcn_mbcnt_hi(am, __builtin_amdgcn_mbcnt_lo(am, 0u)); asm volatile("" : "+v"(ln)); F.lane = ln; F.wave = wv; F.tid = wv * 64 + ln; }
    { int g = gridDim.x, bx = blockIdx.x; asm volatile("" : "+s"(g), "+s"(bx)); F.G = g; F.vcu = (g % 8 == 0) ? (bx % 8) * (g / 8) + bx / 8 : bx; F.bx = bx; }
#define KIN(k) (*(const float* const CAS*)(ka + 8 * (k)))
    F.x_in = KIN(0); F.c_in = KIN(1); F.ctx_in = KIN(2); F.cctx_in = KIN(3); F.w_mod = KIN(4); F.b_mod = KIN(5); F.norm_g = KIN(6);
    F.w_in_even = KIN(7); F.w_out_even = KIN(8); F.ret_ld = KIN(9); F.ret_gn = KIN(10); F.sg_ln_g = KIN(11); F.sg_ln_b = KIN(12); F.sg_w = KIN(13); F.sg_b = KIN(14);
    F.w_qkv = KIN(15); F.w_o = KIN(16); F.sink = KIN(17); F.w_router = KIN(18); F.b_router = KIN(19); F.w_eg = KIN(20); F.w_eu = KIN(21); F.w_ed = KIN(22); F.final_g = KIN(23);
    F.out = *(float* const CAS*)(ka + 8 * 24);
    unsigned char* ws = *(unsigned char* const CAS*)(ka + 8 * 25);
#undef KIN
    F.ctl = (unsigned*)(ws + WS_CTL);
    F.MOD = (float*)(ws + WS_MOD); F.ROPE = (float*)(ws + WS_ROPE); F.X = (bf16*)(ws + WS_X); F.KV = (float*)(ws + WS_C);
    F.SGW = (bf16*)(ws + WS_SGW); F.W1T = (bf16*)(ws + WS_W1T); F.W2T = (bf16*)(ws + WS_W2T); F.WIN = (bf16*)(ws + WS_WIN); F.WOUT = (bf16*)(ws + WS_WOUT); F.WQKV = (bf16*)(ws + WS_WQKV); F.WO = (bf16*)(ws + WS_WO);
    F.H = (bf16*)(ws + WS_H); F.BIG = (bf16*)(ws + WS_BIG); F.MIX = (bf16*)(ws + WS_MIX); F.CS = (bf16*)(ws + WS_C); F.ST = (bf16*)(ws + WS_C + C_ST);
    F.TOK = (v4u*)(ws + WS_TOK); F.LIST = (int*)(ws + WS_LIST);
}
struct Args { const float* in[24]; float* out; unsigned char* ws; int ph_lo, ph_hi; };

__global__ void __launch_bounds__(NWAVES * 64, 2) fwd_kernel(Args args) {
    extern __shared__ __attribute__((aligned(16))) unsigned char lds[];
    Frame F; const int wv0 = __builtin_amdgcn_readfirstlane((int)threadIdx.x >> 6);
    fill_ptrs(F, (LAS unsigned char*)lds, wv0);
    for (int u = F.tid; u < (LDS_BYTES - MISC_OFF) / 4; u += NWAVES * 64) ((LAS unsigned*)(F.lds + MISC_OFF))[u] = 0u;
    __syncthreads();
    XcdBarrier bar; bar.bar = F.ctl + CW_BAR; bar.x = 0; bar.st = nullptr;
    if (MK_SINGLE) bar = xcd_barrier_post(F.ctl + CW_BAR, F.MISC);
    const int lo = args.ph_lo, hi = args.ph_hi;
#define IN(k) (lo <= (k) && (k) < hi)
#define SEAM(k) do { if (IN((k) + 1)) xcd_barrier(bar); } while (0)

    if (IN(0)) { fill_ptrs(F, (LAS unsigned char*)lds, wv0); ONLYX(0, p0_prologue(F)); SEAM(0); }

#pragma unroll 1
    for (int l = 0; l < DEPTH; ++l) {
        const int pb = 1 + l * PPL, li = l >> 1; const bool even = !(l & 1), need_ctx = l < DEPTH - 1;
        const int nrows = need_ctx ? RT : RL;
        if (IN(pb + 0)) { fill_ptrs(F, (LAS unsigned char*)lds, wv0); if (l == 0) { ONLYX(1, (norm_phase<false, false, false, true>(F, l, RT, 0, even ? IN8 : QKV8))); } else { ONLYX(2, (norm_phase<true, false, false, false>(F, l, RT, 0, even ? IN8 : QKV8))); } SEAM(pb + 0); }
        if (IN(pb + 1)) {
            fill_ptrs(F, (LAS unsigned char*)lds, wv0);
            if (even) { pg8::Gemm g{F.H, (const bf16*)((const unsigned char*)F.WIN + (size_t)li * EVEN_IN * 1024 * (IN8 ? 1 : 2)), 0}; pg8::StaticOrder S; S.init(RT, EVEN_IN, F.G, F.bx); EpiIn E{F.BIG};
                ONLYX(3, (pg8::gemm_phase<EpiIn, pg8::StaticOrder, true, false, IN8>(F.lds, g, S, E, F.tid))); }
            else { pg8::Gemm g{F.H, (const bf16*)((const unsigned char*)F.WQKV + (size_t)li * ODD_IN * 1024 * (QKV8 ? 1 : 2)), 0}; pg8::StaticOrder S; S.init(RT, ODD_IN, F.G, F.bx);
                EpiQKV E{F.BIG, (bf16*)((char*)F.BIG + BIG_K), (bf16*)((char*)F.BIG + BIG_V), F.ROPE};
                ONLYX(4, (pg8::gemm_phase<EpiQKV, pg8::StaticOrder, true, false, QKV8>(F.lds, g, S, E, F.tid))); }
            SEAM(pb + 1);
        }
        if (even) {
            if (IN(pb + 2)) { fill_ptrs(F, (LAS unsigned char*)lds, wv0); ONLYX(5, ret_kv_phase(F, li)); SEAM(pb + 2); }
            if (IN(pb + 3)) { fill_ptrs(F, (LAS unsigned char*)lds, wv0); ONLYX(6, ret_scan_phase(F, li)); SEAM(pb + 3); }
            if (IN(pb + 4)) { fill_ptrs(F, (LAS unsigned char*)lds, wv0); ONLYX(7, mixer_phase(F, li)); SEAM(pb + 4); }
        } else {
            if (IN(pb + 4)) { fill_ptrs(F, (LAS unsigned char*)lds, wv0); ONLYX(8, attn_phase(F, li, need_ctx)); SEAM(pb + 4); }
        }
        if (IN(pb + 5)) {
            fill_ptrs(F, (LAS unsigned char*)lds, wv0);
            pg8::Gemm g{F.MIX, (even ? F.WOUT : F.WO) + (size_t)li * 1048576, 0}; pg8::StaticOrder S; S.init(nrows, D, F.G, F.bx);
            EpiRes E{l == 0 ? F.x_in : nullptr, l == 0 ? F.ctx_in : nullptr, F.X, F.MOD + (size_t)l * 9 * 6144};
            ONLYX(9, (pg8::gemm_phase<EpiRes, pg8::StaticOrder, true, false, false>(F.lds, g, S, E, F.tid)));
            SEAM(pb + 5);
        }
        if (IN(pb + 6)) { fill_ptrs(F, (LAS unsigned char*)lds, wv0); ONLYX(10, (norm_phase<false, true, false, false>(F, l, nrows, 1, true))); SEAM(pb + 6); }
        if (IN(pb + 7)) {
            fill_ptrs(F, (LAS unsigned char*)lds, wv0);
            const LAS int* tab = moe_table(F, l);
            pg8::Gemm g{F.H, (const bf16*)((const unsigned char*)F.W1T + (size_t)l * 16 * 2048 * 1024), (size_t)2048 * 1024}; pg8::MoeOrder S; S.init(tab, F.LIST, 8, F.G, F.bx); EpiMoe1 E{(unsigned char*)F.BIG};
            ONLYX(11, (pg8::gemm_phase<EpiMoe1, pg8::MoeOrder, true, true, true>(F.lds, g, S, E, F.tid)));
            SEAM(pb + 7);
        }
        if (IN(pb + 8)) {
            fill_ptrs(F, (LAS unsigned char*)lds, wv0);
            const LAS int* tab = moe_table(F, l);
            pg8::Gemm g{F.BIG, (const bf16*)((const unsigned char*)F.W2T + (size_t)l * 16 * 1048576), (size_t)1048576}; pg8::MoeOrder S; S.init(tab, F.LIST, 4, F.G, F.bx); EpiBf8 E{F.CS};
            ONLYX(12, (pg8::gemm_phase<EpiBf8, pg8::MoeOrder, true, false, true>(F.lds, g, S, E, F.tid)));
            SEAM(pb + 8);
        }
    }
    if (IN(NPHASE - 1)) { fill_ptrs(F, (LAS unsigned char*)lds, wv0); ONLYX(13, (norm_phase<true, false, true, false>(F, DEPTH, RL, 0, true))); }
#undef IN
#undef SEAM
}

extern "C" void kernel_launch(void* const* d_in, const int* in_sizes, int n_in, void* d_out, int out_size, void* d_ws, size_t ws_size, hipStream_t stream) {
    static int grid = 0;
    if (grid == 0) {
        if (n_in != 24 || in_sizes[0] != RL * D || out_size != RL * D || ws_size < WS_END) { fprintf(stderr, "kernel_launch: shape mismatch: n_in %d in0 %d out %d ws %zu (need %zu)\n", n_in, n_in > 0 ? in_sizes[0] : -1, out_size, ws_size, (size_t)WS_END); grid = -1; return; }
        int dev = 0, cus = 0, per_cu = 0;
        if (hipGetDevice(&dev) != hipSuccess || hipDeviceGetAttribute(&cus, hipDeviceAttributeMultiprocessorCount, dev) != hipSuccess) { fprintf(stderr, "kernel_launch: device query failed\n"); grid = -1; return; }
        if (hipFuncSetAttribute((const void*)fwd_kernel, hipFuncAttributeMaxDynamicSharedMemorySize, LDS_BYTES) != hipSuccess) { fprintf(stderr, "kernel_launch: hipFuncSetAttribute failed\n"); grid = -1; return; }
        if (hipOccupancyMaxActiveBlocksPerMultiprocessor(&per_cu, (const void*)fwd_kernel, NWAVES * 64, LDS_BYTES) != hipSuccess || per_cu < 1) { fprintf(stderr, "kernel_launch: occupancy query reports %d workgroups per CU\n", per_cu); }
        (void)hipGetLastError();
        grid = cus;
    }
    if (grid < 0) return;
    if (hipMemsetAsync((char*)d_ws + WS_CTL, 0, CTL_ZERO_BYTES, stream) != hipSuccess) { fprintf(stderr, "kernel_launch: memset failed\n"); return; }
    Args a{};
    for (int i = 0; i < 24; ++i) a.in[i] = (const float*)d_in[i];
    a.out = (float*)d_out; a.ws = (unsigned char*)d_ws;
#if MK_SINGLE
    a.ph_lo = 0; a.ph_hi = NPHASE;
    hipLaunchKernelGGL(fwd_kernel, dim3(grid), dim3(NWAVES * 64), LDS_BYTES, stream, a);
#else
    for (int p = 0; p < NPHASE; ++p) {
        if (p >= 1 && p < NPHASE - 1) { const int l = (p - 1) / PPL, k = (p - 1) % PPL; if ((l & 1) && (k == 2 || k == 3)) continue; }
        a.ph_lo = p; a.ph_hi = p + 1;
        hipLaunchKernelGGL(fwd_kernel, dim3(grid), dim3(NWAVES * 64), LDS_BYTES, stream, a);
    }
#endif
    const hipError_t le = hipPeekAtLastError();
    if (le != hipSuccess) fprintf(stderr, "kernel_launch: launch failed: %s\n", hipGetErrorName(le));
}
```

```cpp
#include <hip/hip_runtime.h>
#include <cstdio>
#include <cstdint>
#include <type_traits>

#define GAS __attribute__((address_space(1)))
#define LAS __attribute__((address_space(3)))
typedef unsigned short bf16;
typedef unsigned v4u __attribute__((ext_vector_type(4)));
typedef unsigned u32x2 __attribute__((ext_vector_type(2)));
typedef float f32x2 __attribute__((ext_vector_type(2)));
typedef float f32x4 __attribute__((ext_vector_type(4)));
typedef float f32x16 __attribute__((ext_vector_type(16)));
typedef short bf16x8 __attribute__((ext_vector_type(8)));
typedef short s16x4 __attribute__((ext_vector_type(4)));
typedef GAS unsigned gu32;
#define RLX_AGENT __ATOMIC_RELAXED, __HIP_MEMORY_SCOPE_AGENT
#define LDS_WAIT() asm volatile("s_waitcnt lgkmcnt(0)" ::: "memory")
#define VM_WAIT() asm volatile("s_waitcnt vmcnt(0)" ::: "memory")

constexpr int D = 1024, NB = 8, SEQ = 4096, LC = 256, DEPTH = 4;
constexpr int RL = NB * SEQ;
constexpr int RC = NB * LC;
constexpr int RT = RL + RC;
constexpr int NCH = 34;
constexpr int EVEN_IN = 2560, ODD_IN = 1536;
constexpr int NE = 16;
constexpr float EPS = 1e-6f;
constexpr int MAXSLOT = 73728;

__device__ __forceinline__ unsigned cvt_pk_bf16(float lo, float hi) { unsigned r; asm volatile("v_cvt_pk_bf16_f32 %0, %1, %2" : "=v"(r) : "v"(lo), "v"(hi)); return r; }
__device__ __forceinline__ float bf_lo(unsigned w) { return __uint_as_float(w << 16); }
__device__ __forceinline__ float bf_hi(unsigned w) { return __uint_as_float(w & 0xffff0000u); }
__device__ __forceinline__ float bf2f(unsigned short h) { return __uint_as_float(((unsigned)h) << 16); }
__device__ __forceinline__ unsigned short f2bf(float f) { return (unsigned short)(cvt_pk_bf16(f, 0.f) & 0xffffu); }
__device__ __forceinline__ float gelu_tanh(float x) { const float u = x + 0.044715f * x * x * x; return x * __builtin_amdgcn_rcpf(1.0f + __builtin_amdgcn_exp2f(-2.302208198f * u)); }
__device__ __forceinline__ float silu_f(float x) { return x * __builtin_amdgcn_rcpf(1.0f + __builtin_amdgcn_exp2f(-1.4426950409f * x)); }
__device__ __forceinline__ float fexp2(float x) { return __builtin_amdgcn_exp2f(x); }
__device__ __forceinline__ float fexp(float x) { return __builtin_amdgcn_exp2f(x * 1.4426950409f); }
__device__ __forceinline__ float frsq(float x) { return __builtin_amdgcn_rsqf(x); }
__device__ __forceinline__ float dpp_f(float v, const int ctrl_b1, const int sel) {
    const int x = __float_as_int(v);
    const int y = sel == 0 ? __builtin_amdgcn_mov_dpp(x, 0xB1, 0xf, 0xf, true) : sel == 1 ? __builtin_amdgcn_mov_dpp(x, 0x4E, 0xf, 0xf, true) : sel == 2 ? __builtin_amdgcn_mov_dpp(x, 0x141, 0xf, 0xf, true) : __builtin_amdgcn_mov_dpp(x, 0x140, 0xf, 0xf, true);
    return __int_as_float(y);
}
__device__ __forceinline__ float row_sum16(float v) { v += dpp_f(v, 0, 0); v += dpp_f(v, 0, 1); v += dpp_f(v, 0, 2); v += dpp_f(v, 0, 3); return v; }
__device__ __forceinline__ float wave_sum(float v, int) {
    v = row_sum16(v);
    const int x = __float_as_int(v);
    return (__int_as_float(__builtin_amdgcn_readlane(x, 0)) + __int_as_float(__builtin_amdgcn_readlane(x, 16))) + (__int_as_float(__builtin_amdgcn_readlane(x, 32)) + __int_as_float(__builtin_amdgcn_readlane(x, 48)));
}
__device__ __forceinline__ float col_sum4(float v) {
    { auto r = __builtin_amdgcn_permlane16_swap(__float_as_uint(v), __float_as_uint(v), false, false); v = __uint_as_float(r[0]) + __uint_as_float(r[1]); }
    { auto r = __builtin_amdgcn_permlane32_swap(__float_as_uint(v), __float_as_uint(v), false, false); v = __uint_as_float(r[0]) + __uint_as_float(r[1]); }
    return v;
}

namespace pg8 {
typedef unsigned short bf16_t;
constexpr int BM = 256, BK = 64, HALF = 128, HTB = HALF * BK * 2, STAGE_BYTES = 8 * HTB, NXCD = 8, WGM = 8, KD = 1024;

__host__ __device__ __forceinline__ int lds_byte(int r, int c) { const int st = (r >> 4) * 2 + (c >> 5), rr = r & 15, cc = c & 31, ob = rr * 64 + cc * 2; return st * 1024 + (ob ^ (((ob >> 9) & 1) << 5)); }
__host__ __device__ __forceinline__ void stage_rc(int b, int& R, int& C) { const int st = b / 1024, sb = b % 1024, swz = sb ^ (((sb >> 9) & 1) << 5); R = (st >> 1) * 16 + swz / 64; C = (st & 1) * 32 + (swz % 64) / 2; }
__host__ __device__ __forceinline__ int perm32(int rho) { const int n = rho >> 4, i = rho & 15; return 8 * (i >> 2) + 4 * n + (i & 3); }

struct Unit { int pm, pn, e, nvalid; const int* gidx; };
typedef int i32x8 __attribute__((ext_vector_type(8)));
typedef int i32x4 __attribute__((ext_vector_type(4)));
typedef i32x8 Frag;
__device__ __forceinline__ bf16x8 frag_half(const Frag& f, int k) { const i32x4 q = k ? __builtin_shufflevector(f, f, 4, 5, 6, 7) : __builtin_shufflevector(f, f, 0, 1, 2, 3); return __builtin_bit_cast(bf16x8, q); }
struct Gemm { const bf16_t* A; const bf16_t* Bt; size_t bstride; };

struct StaticOrder {
    int nM, nN, nwg, G, c;
    __device__ void init(int M, int N, int G_, int c_) { nM = M / BM; nN = N / BM; nwg = nM * nN; G = G_; c = c_; }
    __device__ bool next(int i, Unit& u) const {
        const long L = (long)i * G + c; if (L >= nwg) return false;
        int wgid = (int)L; { const int q = nwg / NXCD, r = nwg % NXCD, xcd = wgid % NXCD, off = wgid / NXCD; wgid = (xcd < r ? xcd * (q + 1) : r * (q + 1) + (xcd - r) * q) + off; }
        const int nig = WGM * nN, gid = wgid / nig, fm = gid * WGM, gsz = (nM - fm) < WGM ? (nM - fm) : WGM;
        u.pm = fm + ((wgid % nig) % gsz); u.pn = (wgid % nig) / gsz; u.e = 0; u.nvalid = 256; u.gidx = nullptr; return true;
    }
};
struct MoeOrder {
    const LAS int* tab; const int* lists; int npn, G, c, nwg;
    __device__ void init(const LAS int* tab_, const int* lists_, int npn_, int G_, int c_) { tab = tab_; lists = lists_; npn = npn_; G = G_; c = c_; nwg = tab_[16] * npn_; }
    __device__ bool next(int i, Unit& u) const {
        const long L = (long)i * G + c; if (L >= nwg) return false;
        int wgid = (int)L; { const int q = nwg / NXCD, r = nwg % NXCD, xcd = wgid % NXCD, off = wgid / NXCD; wgid = (xcd < r ? xcd * (q + 1) : r * (q + 1) + (xcd - r) * q) + off; }
        int e = 0;
#pragma unroll 1
        for (int k = 1; k < 16; ++k) if (wgid >= tab[k] * npn) e = k;
        const int t0 = tab[e], loc = wgid - t0 * npn, mt = loc / npn;
        u.pm = t0 + mt; u.pn = loc - mt * npn; u.e = e; u.nvalid = tab[32 + e] - mt * 256; u.gidx = lists + (size_t)e * RT + mt * 256; return true;
    }
};

template <class Epi, class Sched, bool ALIGN_EPI, bool GATHER, bool FP8, bool ATILED = false>
__device__ __forceinline__ void gemm_phase(LAS unsigned char* lds, const Gemm g, const Sched& S, const Epi& E, const int tid) {
    const int wid = __builtin_amdgcn_readfirstlane(tid >> 6), lane = tid & 63, wr = wid >> 2, wc = wid & 3, fr = lane & 15, fq = lane >> 4;
    constexpr int ROWB = FP8 ? 1024 : 2048, nt = ROWB / 128;
    unsigned voffA[2], voffB[2]; int RA[2]; unsigned CA2[2];
#pragma unroll
    for (int i = 0; i < 2; ++i) { int R, C; stage_rc(tid * 16 + i * 8192, R, C); const int Rb = Epi::PERM ? ((R & ~31) + perm32(R & 31)) : R;
        voffA[i] = (unsigned)(R * (ATILED ? 128 : ROWB) + C * 2); voffB[i] = (unsigned)(Rb * ROWB + C * 2); RA[i] = R; CA2[i] = (unsigned)C * 2u; }
    const size_t kstep = (size_t)(BK * 2);
    const size_t hstep = (size_t)HALF * ROWB;
    const size_t kstepA = ATILED ? (size_t)32768 : kstep, hstepA = ATILED ? (size_t)16384 : hstep;
    const size_t tstep = 2 * hstep;
    const unsigned ldsw = (unsigned)wid * 1024u;
    const int aoff = lds_byte(wr * 64 + fr, fq * 8), boff = lds_byte(wc * 32 + fr, fq * 8);
#define PG8_SA(b, h) (((b) * 2 + (h)) * HTB)
#define PG8_SB(b, h) ((4 + (b) * 2 + (h)) * HTB)
#define PG8_STAGE(bufoff, gbase, voff) do { _Pragma("unroll") for (int _i = 0; _i < 2; ++_i) \
        __builtin_amdgcn_global_load_lds((const unsigned*)((const char*)(gbase) + (voff)[_i]), (LAS unsigned*)(lds + (bufoff) + ldsw + _i * 8192), 16, 0, 0); } while (0)
#define PG8_STA(bufoff, kptr, H, VG) do { if constexpr (GATHER) { PG8_STAGE(bufoff, kptr, VG[H]); } else { PG8_STAGE(bufoff, (kptr) + (H) * hstepA, voffA); } } while (0)
#define PG8_LDA(dst, b, h) do { _Pragma("unroll") for (int m = 0; m < 4; ++m) dst[m] = __builtin_shufflevector(*(const LAS i32x4*)(lds + PG8_SA(b, h) + aoff + m * 2048), *(const LAS i32x4*)(lds + PG8_SA(b, h) + aoff + m * 2048 + 1024), 0, 1, 2, 3, 4, 5, 6, 7); } while (0)
#define PG8_LDB(dst, b, h) do { _Pragma("unroll") for (int n = 0; n < 2; ++n) dst[n] = __builtin_shufflevector(*(const LAS i32x4*)(lds + PG8_SB(b, h) + boff + n * 2048), *(const LAS i32x4*)(lds + PG8_SB(b, h) + boff + n * 2048 + 1024), 0, 1, 2, 3, 4, 5, 6, 7); } while (0)
#define PG8_MMA(ai, bj, At, Bt) do { __builtin_amdgcn_s_setprio(1); _Pragma("unroll") for (int m = 0; m < 4; ++m) _Pragma("unroll") for (int n = 0; n < 2; ++n) { \
        if constexpr (FP8) asm volatile("v_mfma_scale_f32_16x16x128_f8f6f4 %0, %1, %2, %0, %3, %3 op_sel_hi:[0,0,0]" : "+v"(acc[ai][bj][m][n]) : "v"(Bt[n]), "v"(At[m]), "v"(sc1)); \
        else { _Pragma("unroll") for (int k = 0; k < 2; ++k) acc[ai][bj][m][n] = __builtin_amdgcn_mfma_f32_16x16x32_bf16(frag_half(Bt[n], k), frag_half(At[m], k), acc[ai][bj][m][n], 0, 0, 0); } } \
        __builtin_amdgcn_s_setprio(0); } while (0)
#define PG8_WAIT_V(n) asm volatile("s_waitcnt vmcnt(" #n ")" ::: "memory")
#define PG8_WAIT_L(n) asm volatile("s_waitcnt lgkmcnt(" #n ")" ::: "memory")
#define PG8_BAR __builtin_amdgcn_s_barrier()
#define PG8_SCHED __builtin_amdgcn_sched_barrier(0)
#define PG8_GLOAD(U, TK) do { _Pragma("unroll") for (int _h = 0; _h < 2; ++_h) _Pragma("unroll") for (int _i = 0; _i < 2; ++_i) { const int _r = _h * HALF + RA[_i]; \
        const int _rc = _r < (U).nvalid ? _r : (U).nvalid - 1; TK[_h][_i] = (U).gidx[_rc]; } } while (0)
#define PG8_GADDR(TK, VG) do { _Pragma("unroll") for (int _h = 0; _h < 2; ++_h) _Pragma("unroll") for (int _i = 0; _i < 2; ++_i) VG[_h][_i] = (unsigned)TK[_h][_i] * (unsigned)ROWB + CA2[_i]; } while (0)
    Unit cur, nxt; int ui = 0;
    if (!S.next(0, cur)) return;
    f32x4 acc[2][2][4][2];
#pragma unroll
    for (int a = 0; a < 2; ++a)
#pragma unroll
        for (int b = 0; b < 2; ++b)
#pragma unroll
            for (int m = 0; m < 4; ++m)
#pragma unroll
                for (int n = 0; n < 2; ++n) acc[a][b][m][n] = (f32x4){0.f, 0.f, 0.f, 0.f};
    Frag At[4], B0[2], B1[2];
    const int sc1 = 0x7f7f7f7f;
    unsigned vgc[2][2] = {{0u, 0u}, {0u, 0u}}, vgn[2][2] = {{0u, 0u}, {0u, 0u}};
    int tkn[2][2] = {{0, 0}, {0, 0}};
    if constexpr (GATHER) { PG8_GLOAD(cur, tkn); PG8_GADDR(tkn, vgc); }
    const char* cA = GATHER ? (const char*)g.A : (const char*)g.A + (size_t)cur.pm * tstep;
    const char* cB = (const char*)g.Bt + (size_t)cur.e * g.bstride + (size_t)cur.pn * tstep;
    PG8_STAGE(PG8_SB(0, 0), cB, voffB); PG8_STAGE(PG8_SB(0, 1), cB + hstep, voffB); PG8_STA(PG8_SA(0, 0), cA, 0, vgc); PG8_STA(PG8_SA(0, 1), cA, 1, vgc);
    if (wr == 1) PG8_BAR;
    PG8_WAIT_V(2); PG8_BAR;
    PG8_STAGE(PG8_SB(1, 0), cB + kstep, voffB); PG8_STA(PG8_SA(1, 0), cA + kstepA, 0, vgc); PG8_STAGE(PG8_SB(1, 1), cB + hstep + kstep, voffB);
    PG8_WAIT_V(6); PG8_BAR;
    for (;;) {
        const bool has_next = S.next(ui + 1, nxt);
        if constexpr (GATHER) { if (has_next) { PG8_GLOAD(nxt, tkn); } }
        const char* nA = GATHER ? (const char*)g.A : (has_next ? (const char*)g.A + (size_t)nxt.pm * tstep : cA);
        const char* nB = has_next ? (const char*)g.Bt + (size_t)nxt.e * g.bstride + (size_t)nxt.pn * tstep : cB;
#pragma unroll 1
        for (int t = 0; t < nt; t += 2) {
            const bool last = (t == nt - 2);
            const char* a1 = cA + (size_t)(t + 1) * kstepA;
            const char* a2 = last ? nA : cA + (size_t)(t + 2) * kstepA; const char* b2 = last ? nB : cB + (size_t)(t + 2) * kstep;
            const char* a3 = a2 + kstepA; const char* b3 = b2 + kstep;
            unsigned va2[2][2] = {{vgc[0][0], vgc[0][1]}, {vgc[1][0], vgc[1][1]}};
            if constexpr (GATHER) { if (last && has_next) { asm volatile("" : "+v"(tkn[0][0]), "+v"(tkn[0][1]), "+v"(tkn[1][0]), "+v"(tkn[1][1])); PG8_GADDR(tkn, vgn);
                va2[0][0] = vgn[0][0]; va2[0][1] = vgn[0][1]; va2[1][0] = vgn[1][0]; va2[1][1] = vgn[1][1]; } }
            PG8_LDB(B0, 0, 0); PG8_LDB(B1, 0, 1); PG8_SCHED; PG8_LDA(At, 0, 0); PG8_STA(PG8_SA(1, 1), a1, 1, vgc);
            PG8_WAIT_V(8); PG8_WAIT_L(0); PG8_BAR; PG8_MMA(0, 0, At, B0); PG8_MMA(0, 1, At, B1); PG8_BAR; PG8_SCHED;
            PG8_LDA(At, 0, 1); PG8_STAGE(PG8_SB(0, 0), b2, voffB); PG8_STAGE(PG8_SB(0, 1), b2 + hstep, voffB); PG8_STA(PG8_SA(0, 0), a2, 0, va2);
            PG8_WAIT_V(8); PG8_WAIT_L(0); PG8_BAR; PG8_MMA(1, 0, At, B0); PG8_MMA(1, 1, At, B1); PG8_BAR; PG8_SCHED;
            PG8_LDB(B0, 1, 0); PG8_LDB(B1, 1, 1); PG8_SCHED; PG8_LDA(At, 1, 0); PG8_STA(PG8_SA(0, 1), a2, 1, va2);
            PG8_WAIT_V(8); PG8_WAIT_L(0); PG8_BAR; PG8_MMA(0, 0, At, B0); PG8_MMA(0, 1, At, B1); PG8_BAR; PG8_SCHED;
            PG8_LDA(At, 1, 1); PG8_STAGE(PG8_SB(1, 0), b3, voffB); PG8_STAGE(PG8_SB(1, 1), b3 + hstep, voffB); PG8_STA(PG8_SA(1, 0), a3, 0, va2);
            PG8_WAIT_V(8); PG8_WAIT_L(0); PG8_BAR; PG8_MMA(1, 0, At, B0); PG8_MMA(1, 1, At, B1); PG8_BAR; PG8_SCHED;
        }
        if constexpr (ALIGN_EPI) { if (wr == 0) PG8_BAR; }
        if constexpr (FP8) asm volatile("s_nop 15\n\ts_nop 15" ::: "memory");
        E(acc, cur, wr, wc, fr, fq);
        if (!has_next) break;
#pragma unroll
        for (int a = 0; a < 2; ++a)
#pragma unroll
            for (int b = 0; b < 2; ++b)
#pragma unroll
                for (int m = 0; m < 4; ++m)
#pragma unroll
                    for (int n = 0; n < 2; ++n) acc[a][b][m][n] = (f32x4){0.f, 0.f, 0.f, 0.f};
        cur = nxt; cA = nA; cB = nB; ++ui;
        if constexpr (GATHER) {
#pragma unroll
            for (int h = 0; h < 2; ++h)
#pragma unroll
                for (int i = 0; i < 2; ++i) vgc[h][i] = vgn[h][i]; }
        if constexpr (ALIGN_EPI) { if (wr == 1) PG8_BAR; }
    }
    PG8_WAIT_V(0);
    if constexpr (!ALIGN_EPI) { if (wr == 0) PG8_BAR; }
    PG8_BAR;
#undef PG8_SA
#undef PG8_SB
#undef PG8_STAGE
#undef PG8_STA
#undef PG8_LDA
#undef PG8_LDB
#undef PG8_MMA
#undef PG8_WAIT_V
#undef PG8_WAIT_L
#undef PG8_BAR
#undef PG8_SCHED
#undef PG8_GLOAD
#undef PG8_GADDR
}
}
#define XB_TMO      128
#define XB_XCNT(j)  (256  + 64 * (j))
#define XB_XSUB(j)  (1280 + 64 * (j))
#define XB_XGEN(j)  (2304 + 64 * (j))
#define XB_TOP      3328
#define XB_TOPGEN   3392
#define XCD_BAR_WORDS 3456
#define XB_SPIN_CAP (1u << 22)

__device__ __forceinline__ unsigned xb_ld(unsigned* p)              { return __hip_atomic_load(p, __ATOMIC_RELAXED, __HIP_MEMORY_SCOPE_AGENT); }
__device__ __forceinline__ unsigned xb_add(unsigned* p, unsigned v) { return __hip_atomic_fetch_add(p, v, __ATOMIC_RELAXED, __HIP_MEMORY_SCOPE_AGENT); }
__device__ __forceinline__ unsigned xb_xcc_id() { return (unsigned)__builtin_amdgcn_s_getreg((3 << 11) | 20) & 0xFu; }
#define XB_SPIN(cond, bar) do { unsigned _sp = 0; while (cond) { __builtin_amdgcn_s_sleep(1); \
    if ((++_sp & 255u) == 0u) { if (xb_ld(&(bar)[XB_TMO])) break; if (_sp > XB_SPIN_CAP) { atomicAdd(&(bar)[XB_TMO], 1u); break; } } } } while (0)

struct XcdBarrier {
    unsigned* bar; unsigned x;
    volatile LAS unsigned* st;
};

__device__ __forceinline__ XcdBarrier xcd_barrier_post(unsigned* bar, volatile LAS unsigned* st) {
    XcdBarrier b; b.bar = bar; b.x = xb_xcc_id(); b.st = st;
    if (threadIdx.x == 0) (void)xb_add(&bar[XB_XCNT(b.x)], 1u);
    return b;
}
__device__ __forceinline__ void xcd_barrier_complete(unsigned* bar, unsigned x, unsigned& nloc, unsigned& nx) {
    const unsigned G = gridDim.x * gridDim.y * gridDim.z;
    unsigned sum, cnt, mine, sp = 0u;
    for (;;) {
        sum = 0u; cnt = 0u; mine = 0u;
#pragma unroll
        for (unsigned j = 0; j < 16; ++j) { const unsigned c = xb_ld(&bar[XB_XCNT(j)]); sum += c; cnt += (c > 0u) ? 1u : 0u; mine = (j == x) ? c : mine; }
        if (sum == G) break;
        __builtin_amdgcn_s_sleep(1);
        if ((++sp & 255u) == 0u) { if (xb_ld(&bar[XB_TMO])) break; if (sp > XB_SPIN_CAP) { atomicAdd(&bar[XB_TMO], 1u); break; } }
    }
    nloc = mine > 0u ? mine : 1u; nx = cnt > 0u ? cnt : 1u;
}

__device__ __forceinline__ void xcd_barrier(const XcdBarrier& b) {
    asm volatile("s_waitcnt vmcnt(0)" ::: "memory");
    __syncthreads();
    if (threadIdx.x == 0) {
        unsigned* bar = b.bar; unsigned bxx = b.x; asm volatile("" : "+s"(bxx), "+s"(bar));
        __builtin_amdgcn_s_waitcnt(0);
        unsigned nloc = b.st[0], nx = b.st[1];
        if (nloc == 0u) { xcd_barrier_complete(bar, bxx, nloc, nx); b.st[0] = nloc; b.st[1] = nx; }
        const unsigned old = xb_add(&bar[XB_XSUB(bxx)], 1u);
        const unsigned gen = old / nloc;
        if (old + 1u == (gen + 1u) * nloc) {
            __builtin_amdgcn_fence(__ATOMIC_RELEASE, "agent");
            asm volatile("s_waitcnt vmcnt(0)" ::: "memory");
            const unsigned og = xb_add(&bar[XB_TOP], 1u);
            const unsigned tg = og / nx;
            if (og + 1u == (tg + 1u) * nx) xb_add(&bar[XB_TOPGEN], 1u);
            else XB_SPIN(xb_ld(&bar[XB_TOPGEN]) == tg, bar);
            __builtin_amdgcn_fence(__ATOMIC_ACQUIRE, "agent");
            xb_add(&bar[XB_XGEN(bxx)], 1u);
            asm volatile("s_waitcnt vmcnt(0)" ::: "memory");
        } else {
            XB_SPIN(xb_ld(&bar[XB_XGEN(bxx)]) == gen, bar);
            __builtin_amdgcn_fence(__ATOMIC_ACQUIRE, "agent");
            asm volatile("s_waitcnt vmcnt(0)" ::: "memory");
        }
    }
    __syncthreads();
}

constexpr size_t MiB = 1u << 20;
constexpr size_t WS_CTL = 0, CTL_ZERO_BYTES = 1 * MiB;
constexpr size_t WS_MOD = 1 * MiB;
constexpr size_t WS_ROPE = 2 * MiB;
constexpr size_t WS_SGW = 2 * MiB + 65536;
constexpr size_t WS_TOK = 3 * MiB;
constexpr size_t WS_STATS = 3 * MiB + 655360;
constexpr size_t WS_LIST = 4 * MiB;
constexpr size_t WS_W1T = 8 * MiB;
constexpr size_t WS_W2T = 264 * MiB;
constexpr size_t WS_WIN = 392 * MiB;
constexpr size_t WS_WOUT = 402 * MiB;
constexpr size_t WS_WQKV = 406 * MiB;
constexpr size_t WS_WO = 412 * MiB;
constexpr size_t WS_X = 416 * MiB;
constexpr size_t WS_H = 552 * MiB;
constexpr size_t WS_BIG = 620 * MiB;
constexpr size_t WS_MIX = 790 * MiB;
constexpr size_t WS_C = 858 * MiB;
constexpr size_t WS_END = 1002 * MiB;
constexpr size_t BIG_K = 68 * MiB, BIG_V = 85 * MiB, C_ST = 68 * MiB;
constexpr int CW_TMO = 0, CW_BAR = 4096, CW_CNT = 8192;

constexpr int RING_BYTES = 131072, MISC_OFF = RING_BYTES, LDS_BYTES = 147456;
constexpr int NWAVES = 8;

struct Frame {
    LAS unsigned char* lds; char* ldsg;
    volatile LAS unsigned* MISC;
    unsigned* ctl;
    int tid, lane, wave, vcu, G, bx;
    const float *x_in, *c_in, *ctx_in, *cctx_in, *w_mod, *b_mod, *norm_g, *w_in_even, *w_out_even, *ret_ld, *ret_gn, *sg_ln_g, *sg_ln_b, *sg_w, *sg_b,
                *w_qkv, *w_o, *sink, *w_router, *b_router, *w_eg, *w_eu, *w_ed, *final_g;
    float* out;
    float *MOD, *ROPE, *KV; f32x2* STATS;
    bf16 *X, *SGW, *W1T, *W2T, *WIN, *WOUT, *WQKV, *WO, *H, *BIG, *MIX, *CS, *ST;
    v4u* TOK; int* LIST;
};

using pg8::Unit;
__device__ __forceinline__ unsigned cvt4_fp8(float a, float b, float c, float d) { int w = 0; w = __builtin_amdgcn_cvt_pk_fp8_f32(a, b, w, false); w = __builtin_amdgcn_cvt_pk_fp8_f32(c, d, w, true); return (unsigned)w; }
__device__ __forceinline__ float clamp448(float x) { return __builtin_amdgcn_fmed3f(x, -448.f, 448.f); }
constexpr bool IN8 = true, QKV8 = true;
constexpr float W8_SCALE = 32.f, W8_INV = 1.f / 32.f;
constexpr float ACT8_SCALE = 4.f, ACT8_INV = 0.25f;
struct EpiIn {
    static constexpr bool PERM = true;
    bf16* O;
    __device__ __forceinline__ void operator()(const f32x4 (&acc)[2][2][4][2], const Unit& u, int wr, int wc, int fr, int fq) const {
        const int row0 = u.pm * 256 + wr * 64 + fr, col0 = u.pn * 256 + wc * 32 + 8 * fq;
        const int mode = (u.pn == 1) ? 1 : (u.pn >= 6 ? 2 : 0);
#pragma unroll
        for (int ai = 0; ai < 2; ++ai)
#pragma unroll
            for (int m = 0; m < 4; ++m) { bf16* rowp = O + (size_t)(row0 + ai * 128 + m * 16) * EVEN_IN + col0;
#pragma unroll
                for (int bj = 0; bj < 2; ++bj) { f32x4 v0 = acc[ai][bj][m][0] * (IN8 ? W8_INV : 1.f), v1 = acc[ai][bj][m][1] * (IN8 ? W8_INV : 1.f);
                    if (mode == 1) { v0 = v0 * 0.125f; v1 = v1 * 0.125f; }
                    if (mode == 2) {
#pragma unroll
                        for (int j = 0; j < 4; ++j) { v0[j] = gelu_tanh(v0[j]); v1[j] = gelu_tanh(v1[j]); } }
                    v4u w; w.x = cvt_pk_bf16(v0[0], v0[1]); w.y = cvt_pk_bf16(v0[2], v0[3]); w.z = cvt_pk_bf16(v1[0], v1[1]); w.w = cvt_pk_bf16(v1[2], v1[3]);
                    *(v4u*)(rowp + bj * 128) = w; } }
    }
};
struct EpiRes {
    static constexpr bool PERM = true;
    const float* xlat; const float* xctx; bf16* X; const float* modl;
    __device__ __forceinline__ void operator()(const f32x4 (&acc)[2][2][4][2], const Unit& u, int wr, int wc, int fr, int fq) const {
        const int row0 = u.pm * 256 + wr * 64 + fr, col0 = u.pn * 256 + wc * 32 + 8 * fq;
        const bool lat = u.pm < (RL / 256); const int bb = lat ? (u.pm >> 4) : 8;
        const float* gp = modl + bb * 6144 + 2 * 1024 + col0;
        f32x4 gv[2][2];
#pragma unroll
        for (int bj = 0; bj < 2; ++bj)
#pragma unroll
            for (int n = 0; n < 2; ++n) gv[bj][n] = *(const f32x4*)(gp + bj * 128 + n * 4);
#pragma unroll
        for (int ai = 0; ai < 2; ++ai) {
            f32x4 x0[4][2], x1[4][2];
#pragma unroll
            for (int m = 0; m < 4; ++m) { const int r = row0 + ai * 128 + m * 16; const bf16* xo = X + (size_t)r * D + col0;
#pragma unroll
                for (int bj = 0; bj < 2; ++bj) {
                    if (xlat) { const float* xi = (lat ? xlat + (size_t)r * D : xctx + (size_t)(r - RL) * D) + col0 + bj * 128; x0[m][bj] = *(const f32x4*)xi; x1[m][bj] = *(const f32x4*)(xi + 4); }
                    else { const v4u xw = *(const v4u*)(xo + bj * 128); x0[m][bj] = (f32x4){bf_lo(xw.x), bf_hi(xw.x), bf_lo(xw.y), bf_hi(xw.y)}; x1[m][bj] = (f32x4){bf_lo(xw.z), bf_hi(xw.z), bf_lo(xw.w), bf_hi(xw.w)}; } } }
#pragma unroll
            for (int m = 0; m < 4; ++m) { const int r = row0 + ai * 128 + m * 16; bf16* xo = X + (size_t)r * D + col0;
#pragma unroll
                for (int bj = 0; bj < 2; ++bj) {
                    const f32x4 v0 = x0[m][bj] + gv[bj][0] * acc[ai][bj][m][0], v1 = x1[m][bj] + gv[bj][1] * acc[ai][bj][m][1];
                    v4u w; w.x = cvt_pk_bf16(v0[0], v0[1]); w.y = cvt_pk_bf16(v0[2], v0[3]); w.z = cvt_pk_bf16(v1[0], v1[1]); w.w = cvt_pk_bf16(v1[2], v1[3]);
                    *(v4u*)(xo + bj * 128) = w; } }
        }
    }
};
struct EpiQKV {
    static constexpr bool PERM = true;
    bf16 *Q, *K, *V; const float* rope;
    __device__ __forceinline__ void operator()(const f32x4 (&acc)[2][2][4][2], const Unit& u, int wr, int wc, int fr, int fq) const {
        const int row0 = u.pm * 256 + wr * 64 + fr; const int cin = wc * 32 + 8 * fq;
        const bool lat = u.pm < (RL / 256); const bool dorope = lat && (u.pn < 5);
        bf16* base; int ld;
        if (u.pn < 4) { base = Q + u.pn * 256; ld = 1024; } else if (u.pn == 4) { base = K; ld = 256; } else { base = V; ld = 256; }
        const int half = (cin >> 6) & 1, i0 = (cin & 63) >> 1;
#pragma unroll
        for (int ai = 0; ai < 2; ++ai)
#pragma unroll
            for (int m = 0; m < 4; ++m) { const int r = row0 + ai * 128 + m * 16; bf16* rowp = base + (size_t)r * ld + cin;
                f32x4 cs0 = {1.f, 0.f, 1.f, 0.f}, cs1 = {1.f, 0.f, 1.f, 0.f};
                if (dorope) { const int t = r & (SEQ - 1); const int pos = half ? (t & 63) : (t >> 6); const float* tp = rope + (size_t)(pos * 32 + i0) * 2; cs0 = *(const f32x4*)tp; cs1 = *(const f32x4*)(tp + 4); }
#pragma unroll
                for (int bj = 0; bj < 2; ++bj) { const f32x4 v0 = acc[ai][bj][m][0] * (QKV8 ? W8_INV : 1.f), v1 = acc[ai][bj][m][1] * (QKV8 ? W8_INV : 1.f);
                    const float a0 = v0[0] * cs0[0] - v0[1] * cs0[1], a1 = v0[1] * cs0[0] + v0[0] * cs0[1];
                    const float a2 = v0[2] * cs0[2] - v0[3] * cs0[3], a3 = v0[3] * cs0[2] + v0[2] * cs0[3];
                    const float a4 = v1[0] * cs1[0] - v1[1] * cs1[1], a5 = v1[1] * cs1[0] + v1[0] * cs1[1];
                    const float a6 = v1[2] * cs1[2] - v1[3] * cs1[3], a7 = v1[3] * cs1[2] + v1[2] * cs1[3];
                    v4u w; w.x = cvt_pk_bf16(a0, a1); w.y = cvt_pk_bf16(a2, a3); w.z = cvt_pk_bf16(a4, a5); w.w = cvt_pk_bf16(a6, a7);
                    *(v4u*)(rowp + bj * 128) = w; } }
    }
};
struct EpiMoe1 {
    static constexpr bool PERM = true;
    unsigned char* O;
    __device__ __forceinline__ void operator()(const f32x4 (&acc)[2][2][4][2], const Unit& u, int wr, int wc, int fr, int fq) const {
        unsigned char* const tb = O + (size_t)u.pm * 262144 + (size_t)u.pn * 32768 + (wr * 64 + fr) * 128 + wc * 32 + 8 * fq;
#pragma unroll
        for (int ai = 0; ai < 2; ++ai)
#pragma unroll
            for (int m = 0; m < 4; ++m) { unsigned char* rowp = tb + (ai * 128 + m * 16) * 128;
                const f32x4 g0 = acc[ai][0][m][0] * W8_INV, g1 = acc[ai][0][m][1] * W8_INV, u0 = acc[ai][1][m][0] * (W8_INV * ACT8_SCALE), u1 = acc[ai][1][m][1] * (W8_INV * ACT8_SCALE);
                f32x4 v0, v1;
#pragma unroll
                for (int j = 0; j < 4; ++j) { v0[j] = clamp448(silu_f(g0[j]) * u0[j]); v1[j] = clamp448(silu_f(g1[j]) * u1[j]); }
                u32x2 w; w.x = cvt4_fp8(v0[0], v0[1], v0[2], v0[3]); w.y = cvt4_fp8(v1[0], v1[1], v1[2], v1[3]);
                *(u32x2*)rowp = w; }
    }
};
struct EpiBf8 {
    static constexpr bool PERM = true;
    bf16* O;
    __device__ __forceinline__ void operator()(const f32x4 (&acc)[2][2][4][2], const Unit& u, int wr, int wc, int fr, int fq) const {
        const int row0 = u.pm * 256 + wr * 64 + fr, col0 = u.pn * 256 + wc * 32 + 8 * fq;
#pragma unroll
        for (int ai = 0; ai < 2; ++ai)
#pragma unroll
            for (int m = 0; m < 4; ++m) { bf16* rowp = O + (size_t)(row0 + ai * 128 + m * 16) * 1024 + col0;
#pragma unroll
                for (int bj = 0; bj < 2; ++bj) { const f32x4 v0 = acc[ai][bj][m][0] * (W8_INV * ACT8_INV), v1 = acc[ai][bj][m][1] * (W8_INV * ACT8_INV);
                    v4u w; w.x = cvt_pk_bf16(v0[0], v0[1]); w.y = cvt_pk_bf16(v0[2], v0[3]); w.z = cvt_pk_bf16(v1[0], v1[1]); w.w = cvt_pk_bf16(v1[2], v1[3]);
                    *(v4u*)(rowp + bj * 128) = w; } }
    }
};

template <class RowMap>
__device__ __forceinline__ void p0_transpose_item(const float* W, int N, bf16* WT, const RowMap& rm, LAS float* scr, int item, int lane) {
    const int nblk = N / 32, kb = item / nblk, nb = item % nblk, k0 = 64 * kb, n0 = 32 * nb;
#pragma unroll 8
    for (int i = 0; i < 32; ++i) { const int kk = 2 * i + (lane >> 5); scr[kk * 33 + (lane & 31)] = W[(size_t)(k0 + kk) * N + n0 + (lane & 31)]; }
    LDS_WAIT(); asm volatile("" ::: "memory");
    const int c = lane & 7;
#pragma unroll
    for (int j = 0; j < 4; ++j) { const int n = (lane >> 3) + 8 * j; const LAS float* s = scr + (8 * c) * 33 + n;
        v4u o; o.x = cvt_pk_bf16(s[0 * 33], s[1 * 33]); o.y = cvt_pk_bf16(s[2 * 33], s[3 * 33]); o.z = cvt_pk_bf16(s[4 * 33], s[5 * 33]); o.w = cvt_pk_bf16(s[6 * 33], s[7 * 33]);
        *(v4u*)(WT + (size_t)rm(n0 + n) * 1024 + k0 + 8 * c) = o; }
    LDS_WAIT(); asm volatile("" ::: "memory");
}
template <class RowMap>
__device__ __forceinline__ void p0_transpose_item8(const float* W, int N, unsigned char* WT, const RowMap& rm, LAS float* scr, int item, int lane) {
    const int nblk = N / 32, kb = item / nblk, nb = item % nblk, k0 = 64 * kb, n0 = 32 * nb;
#pragma unroll 16
    for (int i = 0; i < 32; ++i) { const int kk = 2 * i + (lane >> 5); scr[kk * 33 + (lane & 31)] = W[(size_t)(k0 + kk) * N + n0 + (lane & 31)] * W8_SCALE; }
    LDS_WAIT(); asm volatile("" ::: "memory");
    const int c = lane & 7;
#pragma unroll
    for (int j = 0; j < 4; ++j) { const int n = (lane >> 3) + 8 * j; const LAS float* s = scr + (8 * c) * 33 + n;
        u32x2 o; o.x = cvt4_fp8(s[0 * 33], s[1 * 33], s[2 * 33], s[3 * 33]); o.y = cvt4_fp8(s[4 * 33], s[5 * 33], s[6 * 33], s[7 * 33]);
        *(u32x2*)(WT + (size_t)rm(n0 + n) * 1024 + k0 + 8 * c) = o; }
    LDS_WAIT(); asm volatile("" ::: "memory");
}
struct RmId { __device__ __forceinline__ int operator()(int n) const { return n; } };
struct RmGU { int type; __device__ __forceinline__ int operator()(int n) const { return ((n >> 7) << 8) + type * 128 + (n & 127); } };
struct RmQKV { __device__ __forceinline__ int operator()(int n) const { if (n >= 1280) return n; const int ps = n & 63; return (n & ~63) + (ps < 32 ? 2 * ps : 2 * (ps - 32) + 1); } };

__device__ __forceinline__ void p0_prologue(Frame& F) {
    LAS float* scr = (LAS float*)(F.lds + F.wave * 16384);
    const int gw = F.vcu * NWAVES + F.wave, NGW = F.G * NWAVES;
    constexpr int I_E = 512, N_EXP = 4 * 3 * 16 * I_E;
    constexpr int I_IN = 16 * 80, I_SQ = 512, I_QKV = 16 * 48;
    constexpr int NITEMS = N_EXP + 2 * I_IN + 2 * I_SQ + 2 * I_QKV + 2 * I_SQ;
    for (int it = gw; it < NITEMS; it += NGW) {
        int r = it;
        if (r < N_EXP) { const int mtx = r / I_E, item = r % I_E, layer = mtx / 48, rem = mtx % 48, type = rem / 16, e = rem % 16; const size_t mo = (size_t)(layer * 16 + e) * 1048576;
            if (type == 2) p0_transpose_item8(F.w_ed + mo, 1024, (unsigned char*)F.W2T + mo, RmId{}, scr, item, F.lane);
            else p0_transpose_item8((type ? F.w_eu : F.w_eg) + mo, 1024, (unsigned char*)F.W1T + 2 * mo, RmGU{type}, scr, item, F.lane);
            continue; }
        r -= N_EXP;
        if (r < 2 * I_IN) { const int i = r / I_IN; if (IN8) p0_transpose_item8(F.w_in_even + (size_t)i * 1024 * EVEN_IN, EVEN_IN, (unsigned char*)F.WIN + (size_t)i * EVEN_IN * 1024, RmId{}, scr, r % I_IN, F.lane); else p0_transpose_item(F.w_in_even + (size_t)i * 1024 * EVEN_IN, EVEN_IN, F.WIN + (size_t)i * EVEN_IN * 1024, RmId{}, scr, r % I_IN, F.lane); continue; } r -= 2 * I_IN;
        if (r < 2 * I_SQ) { const int i = r / I_SQ; p0_transpose_item(F.w_out_even + (size_t)i * 1048576, 1024, F.WOUT + (size_t)i * 1048576, RmId{}, scr, r % I_SQ, F.lane); continue; } r -= 2 * I_SQ;
        if (r < 2 * I_QKV) { const int i = r / I_QKV; if (QKV8) p0_transpose_item8(F.w_qkv + (size_t)i * 1024 * ODD_IN, ODD_IN, (unsigned char*)F.WQKV + (size_t)i * ODD_IN * 1024, RmQKV{}, scr, r % I_QKV, F.lane); else p0_transpose_item(F.w_qkv + (size_t)i * 1024 * ODD_IN, ODD_IN, F.WQKV + (size_t)i * ODD_IN * 1024, RmQKV{}, scr, r % I_QKV, F.lane); continue; } r -= 2 * I_QKV;
        { const int i = r / I_SQ; p0_transpose_item(F.w_o + (size_t)i * 1048576, 1024, F.WO + (size_t)i * 1048576, RmId{}, scr, r % I_SQ, F.lane); }
    }
    { const int gt = F.vcu * 512 + F.tid, GT = F.G * 512;
      for (int i = gt; i < 2 * 4 * 128 * 128 / 4; i += GT) { const f32x4 v = ((const f32x4*)F.sg_w)[i]; u32x2 w; w.x = cvt_pk_bf16(v[0], v[1]); w.y = cvt_pk_bf16(v[2], v[3]); ((u32x2*)F.SGW)[i] = w; }
      for (int i = gt; i < 64 * 32; i += GT) { const int pos = i >> 5, fi = i & 31; const float inv = fexp2(-(float)fi * (13.287712379549449f / 32.0f)); const float rev = __builtin_amdgcn_fractf((float)pos * inv * 0.15915494309189535f);
          F.ROPE[2 * i] = __builtin_amdgcn_cosf(rev); F.ROPE[2 * i + 1] = __builtin_amdgcn_sinf(rev); } }
    __syncthreads();
    LAS float* sc = (LAS float*)F.lds;
    LAS float* part = (LAS float*)(F.lds + 49152);
    for (int i = F.tid; i < 9 * 1024; i += 512) { const int bb = i >> 10, k = i & 1023; const float cv = bb < 8 ? F.c_in[bb * 1024 + k] : F.cctx_in[k]; sc[k * 12 + bb] = silu_f(cv); }
    __syncthreads();
    for (int it = F.vcu; it < 4 * 96; it += F.G) {
        const int l = it / 96, n = (it % 96) * 64 + F.lane;
        float a[9];
#pragma unroll
        for (int bb = 0; bb < 9; ++bb) a[bb] = 0.f;
        const float* wp = F.w_mod + ((size_t)l * 1024 + F.wave * 128) * 6144 + n;
#pragma unroll 8
        for (int k = 0; k < 128; ++k) { const float wv = wp[(size_t)k * 6144]; const LAS float* sp = sc + (F.wave * 128 + k) * 12;
            const f32x4 s0 = *(const LAS f32x4*)sp, s1 = *(const LAS f32x4*)(sp + 4); const float s8 = sp[8];
            a[0] += s0[0] * wv; a[1] += s0[1] * wv; a[2] += s0[2] * wv; a[3] += s0[3] * wv; a[4] += s1[0] * wv; a[5] += s1[1] * wv; a[6] += s1[2] * wv; a[7] += s1[3] * wv; a[8] += s8 * wv; }
#pragma unroll
        for (int bb = 0; bb < 9; ++bb) part[(F.wave * 9 + bb) * 64 + F.lane] = a[bb];
        __syncthreads();
        for (int i = F.tid; i < 9 * 64; i += 512) { const int bb = i >> 6, ln = i & 63; float s = 0.f;
#pragma unroll
            for (int w = 0; w < 8; ++w) s += part[(w * 9 + bb) * 64 + ln];
            const int nn = (it % 96) * 64 + ln; F.MOD[((size_t)l * 9 + bb) * 6144 + nn] = s + F.b_mod[l * 6144 + nn]; }
        __syncthreads();
    }
}

template <bool COMBINE, bool ROUTE, bool FINAL, bool FIN>
__device__ __forceinline__ void norm_phase(Frame& F, int l, int nrows, int sel, bool h8) {
    const int rpb = (nrows + F.G - 1) / F.G, r0 = F.vcu * rpb, r1 = (r0 + rpb < nrows) ? r0 + rpb : nrows;
    LAS float* wrl = (LAS float*)F.lds;
    LAS int* rinfo = (LAS int*)(F.lds + 81920);
    LAS int* lcnt = (LAS int*)(F.lds + 81920 + 12288);
    if (ROUTE) {
        for (int i = F.tid; i < 1024 * 4; i += 512) { const int k = i >> 2, q4 = i & 3; const f32x4 v = *(const f32x4*)(F.w_router + k * 16 + q4 * 4);
            *(LAS f32x4*)(wrl + (((k >> 8) * 4 + (k & 3)) * 64 + ((k >> 2) & 63)) * 20 + q4 * 4) = v; }
        if (F.tid < 16) lcnt[F.tid] = 0;
    }
    if (COMBINE) { if (F.tid == 0) { int s = 0;
#pragma unroll 1
        for (int e = 0; e < 16; ++e) { lcnt[32 + e] = s; const int cn = (int)__hip_atomic_load(F.ctl + CW_CNT + 64 * (l - 1) + e, RLX_AGENT); s += ((cn + 255) >> 8) << 8; } } }
    __syncthreads();
    const int cnt = (r1 - r0 - F.wave + 7) >> 3;
    typedef typename std::conditional<FIN, f32x4, u32x2>::type XR;
#define NP_ROW(i) ({ int _r = r0 + F.wave + 8 * (i); _r < r1 ? _r : r1 - 1; })
#define NP_LOAD_TK(dst, i) do { if constexpr (COMBINE) dst = F.TOK[NP_ROW(i)]; } while (0)
#define NP_LOAD_ROW(XQ_, O0, O1, TK, i) do { const int _rr = NP_ROW(i); \
        if constexpr (FIN) { const float* _xr = _rr < RL ? F.x_in + (size_t)_rr * D : F.ctx_in + (size_t)(_rr - RL) * D; \
            _Pragma("unroll") for (int j = 0; j < 4; ++j) XQ_[j] = ((const XR*)_xr)[F.lane + 64 * j]; } \
        else { _Pragma("unroll") for (int j = 0; j < 4; ++j) XQ_[j] = ((const XR*)(F.X + (size_t)_rr * D))[F.lane + 64 * j]; } \
        if constexpr (COMBINE) { const int _s0 = lcnt[32 + (TK.x & 15)] + (int)(TK.x >> 4), _s1 = lcnt[32 + (TK.y & 15)] + (int)(TK.y >> 4); \
            const u32x2* _o0 = (const u32x2*)(F.CS + (size_t)_s0 * 1024); const u32x2* _o1 = (const u32x2*)(F.CS + (size_t)_s1 * 1024); \
            _Pragma("unroll") for (int j = 0; j < 4; ++j) { O0[j] = _o0[F.lane + 64 * j]; O1[j] = _o1[F.lane + 64 * j]; } } } while (0)
    if (cnt > 0) {
        v4u tkA = {0u, 0u, 0u, 0u}, tkB = tkA; XR xa[4], xn[4]; u32x2 oa0[4], oa1[4], on0[4], on1[4];
#pragma unroll
        for (int j = 0; j < 4; ++j) { oa0[j] = (u32x2){0u, 0u}; oa1[j] = oa0[j]; on0[j] = oa0[j]; on1[j] = oa0[j]; }
        NP_LOAD_TK(tkA, 0); NP_LOAD_TK(tkB, 1);
        NP_LOAD_ROW(xa, oa0, oa1, tkA, 0);
#pragma unroll 1
        for (int i = 0; i < cnt; ++i) {
            const int r = r0 + F.wave + 8 * i;
            v4u tkC = tkB; NP_LOAD_TK(tkC, i + 2);
            NP_LOAD_ROW(xn, on0, on1, tkB, i + 1);
            const int bb = r < RL ? (r >> 12) : 8;
            f32x4 v[4];
#pragma unroll
            for (int j = 0; j < 4; ++j) { if constexpr (FIN) v[j] = xa[j]; else v[j] = (f32x4){bf_lo(xa[j].x), bf_hi(xa[j].x), bf_lo(xa[j].y), bf_hi(xa[j].y)}; }
            if (COMBINE) {
                const float w0 = __uint_as_float(tkA.z), w1 = __uint_as_float(tkA.w);
                const float* g2 = F.MOD + ((size_t)(l - 1) * 9 + bb) * 6144 + 5 * 1024;
#pragma unroll
                for (int j = 0; j < 4; ++j) { const u32x2 a = oa0[j], b = oa1[j]; const f32x4 gg = ((const f32x4*)g2)[F.lane + 64 * j];
                    v[j][0] += gg[0] * (w0 * bf_lo(a.x) + w1 * bf_lo(b.x)); v[j][1] += gg[1] * (w0 * bf_hi(a.x) + w1 * bf_hi(b.x));
                    v[j][2] += gg[2] * (w0 * bf_lo(a.y) + w1 * bf_lo(b.y)); v[j][3] += gg[3] * (w0 * bf_hi(a.y) + w1 * bf_hi(b.y)); }
                if (!FINAL) {
#pragma unroll
                    for (int j = 0; j < 4; ++j) { u32x2 w; w.x = cvt_pk_bf16(v[j][0], v[j][1]); w.y = cvt_pk_bf16(v[j][2], v[j][3]); ((u32x2*)(F.X + (size_t)r * D))[F.lane + 64 * j] = w; } }
            }
            float ss = 0.f;
#pragma unroll
            for (int j = 0; j < 4; ++j) ss += (v[j][0] * v[j][0] + v[j][1] * v[j][1]) + (v[j][2] * v[j][2] + v[j][3] * v[j][3]);
            const float rstd = frsq(wave_sum(ss, F.lane) * (1.0f / D) + EPS);
            if (FINAL) {
#pragma unroll
                for (int j = 0; j < 4; ++j) { const f32x4 fg = ((const f32x4*)F.final_g)[F.lane + 64 * j]; ((f32x4*)(F.out + (size_t)r * D))[F.lane + 64 * j] = v[j] * rstd * fg; }
            } else {
                const float* ng = F.norm_g + (size_t)(l * 2 + sel) * D; const float* md = F.MOD + ((size_t)l * 9 + bb) * 6144;
                const float* shp = md + (sel ? 3 : 0) * 1024; const float* scp = md + (sel ? 4 : 1) * 1024;
                f32x4 h[4];
#pragma unroll
                for (int j = 0; j < 4; ++j) { const f32x4 g = ((const f32x4*)ng)[F.lane + 64 * j], sc = ((const f32x4*)scp)[F.lane + 64 * j], sh = ((const f32x4*)shp)[F.lane + 64 * j];
                    h[j] = v[j] * rstd * g * (sc + 1.0f) + sh;
                    if (h8) ((unsigned*)((unsigned char*)F.H + (size_t)r * D))[F.lane + 64 * j] = cvt4_fp8(h[j][0], h[j][1], h[j][2], h[j][3]);
                    else { u32x2 w; w.x = cvt_pk_bf16(h[j][0], h[j][1]); w.y = cvt_pk_bf16(h[j][2], h[j][3]); ((u32x2*)(F.H + (size_t)r * D))[F.lane + 64 * j] = w; } }
                if (ROUTE) {
                    float a[16];
#pragma unroll
                    for (int e = 0; e < 16; ++e) a[e] = 0.f;
#pragma unroll
                    for (int j = 0; j < 4; ++j)
#pragma unroll
                        for (int q = 0; q < 4; ++q) { const LAS float* wp = wrl + ((j * 4 + q) * 64 + F.lane) * 20; const float hk = h[j][q];
                            const f32x4 w0 = *(const LAS f32x4*)wp, w1 = *(const LAS f32x4*)(wp + 4), w2 = *(const LAS f32x4*)(wp + 8), w3 = *(const LAS f32x4*)(wp + 12);
                            a[0] += hk * w0[0]; a[1] += hk * w0[1]; a[2] += hk * w0[2]; a[3] += hk * w0[3]; a[4] += hk * w1[0]; a[5] += hk * w1[1]; a[6] += hk * w1[2]; a[7] += hk * w1[3];
                            a[8] += hk * w2[0]; a[9] += hk * w2[1]; a[10] += hk * w2[2]; a[11] += hk * w2[3]; a[12] += hk * w3[0]; a[13] += hk * w3[1]; a[14] += hk * w3[2]; a[15] += hk * w3[3]; }
                    float mx = -3.0e38f;
#pragma unroll
                    for (int e = 0; e < 16; ++e) { a[e] = wave_sum(a[e], F.lane) + F.b_router[e]; mx = fmaxf(mx, a[e]); }
#pragma unroll
                    for (int e = 0; e < 16; ++e) a[e] = fexp(a[e] - mx);
                    float bs = -1.f, ba = 0.f, bbv = 0.f; int bi0 = 0, bi1 = 1;
#pragma unroll
                    for (int g = 0; g < 4; ++g) {
                        float p0 = a[4 * g]; int i0 = 0;
#pragma unroll
                        for (int k = 1; k < 4; ++k) if (a[4 * g + k] > p0) { p0 = a[4 * g + k]; i0 = k; }
                        float p1 = -1.f; int i1 = 0;
#pragma unroll
                        for (int k = 0; k < 4; ++k) if (k != i0 && a[4 * g + k] > p1) { p1 = a[4 * g + k]; i1 = k; }
                        const float gs = p0 + p1;
                        if (gs > bs) { bs = gs; ba = p0; bbv = p1; bi0 = 4 * g + i0; bi1 = 4 * g + i1; }
                    }
                    if (F.lane == 0) { const float inv = 1.0f / (ba + bbv);
                        const int lp0 = atomicAdd((int*)(lcnt + bi0), 1), lp1 = atomicAdd((int*)(lcnt + bi1), 1);
                        LAS int* ri = rinfo + (r - r0) * 6; ri[0] = bi0; ri[1] = lp0; ri[2] = bi1; ri[3] = lp1; ri[4] = (int)__float_as_uint(ba * inv); ri[5] = (int)__float_as_uint(bbv * inv); }
                }
            }
#pragma unroll
            for (int j = 0; j < 4; ++j) { xa[j] = xn[j]; oa0[j] = on0[j]; oa1[j] = on1[j]; }
            tkA = tkB; tkB = tkC;
        }
    }
#undef NP_ROW
#undef NP_LOAD_TK
#undef NP_LOAD_ROW
    if (ROUTE) {
        __syncthreads();
        if (F.tid < 16) lcnt[16 + F.tid] = (int)__hip_atomic_fetch_add(F.ctl + CW_CNT + 64 * l + F.tid, (unsigned)lcnt[F.tid], RLX_AGENT);
        __syncthreads();
        for (int i = F.tid; i < r1 - r0; i += 512) { const LAS int* ri = rinfo + i * 6; const int e0 = ri[0], e1 = ri[2], p0 = lcnt[16 + e0] + ri[1], p1 = lcnt[16 + e1] + ri[3];
            v4u tk; tk.x = (unsigned)e0 | ((unsigned)p0 << 4); tk.y = (unsigned)e1 | ((unsigned)p1 << 4); tk.z = (unsigned)ri[4]; tk.w = (unsigned)ri[5]; F.TOK[r0 + i] = tk;
            F.LIST[(size_t)e0 * RT + p0] = r0 + i; F.LIST[(size_t)e1 * RT + p1] = r0 + i; }
    }
    __syncthreads();
}

__device__ __forceinline__ const LAS int* moe_table(Frame& F, int l) {
    LAS int* tab = (LAS int*)(F.MISC + 16);
    __syncthreads();
    if (F.tid == 0) { int s = 0;
#pragma unroll 1
        for (int e = 0; e < 16; ++e) { const int cn = (int)__hip_atomic_load(F.ctl + CW_CNT + 64 * l + e, RLX_AGENT); tab[e] = s; tab[32 + e] = cn; s += (cn + 255) >> 8; } tab[16] = s; }
    __syncthreads();
    return tab;
}

#define MMA16(acc, afrag, bfrag) acc = __builtin_amdgcn_mfma_f32_16x16x32_bf16(bfrag, afrag, acc, 0, 0, 0)
constexpr int TP = 136;
__device__ __forceinline__ int chunk_row0(int b, int c) { return c < 2 ? RL + b * LC + c * 128 : b * SEQ + (c - 2) * 128; }

__device__ __forceinline__ void stage_vt(Frame& F, LAS bf16* VT, const bf16* src  , int ld) {
    const int j = F.tid >> 2, e0 = (F.tid & 3) * 32;
    const v4u* p = (const v4u*)(src + (size_t)j * ld + e0);
    v4u q[4];
#pragma unroll
    for (int t = 0; t < 4; ++t) q[t] = p[t];
#pragma unroll
    for (int t = 0; t < 4; ++t) { const unsigned w[4] = {q[t].x, q[t].y, q[t].z, q[t].w};
#pragma unroll
        for (int k = 0; k < 4; ++k) { VT[(e0 + t * 8 + 2 * k) * TP + j] = (bf16)(w[k] & 0xffffu); VT[(e0 + t * 8 + 2 * k + 1) * TP + j] = (bf16)(w[k] >> 16); } }
}

__device__ __forceinline__ void ret_kv_phase(Frame& F, int li) {
    LAS bf16* KTf = (LAS bf16*)F.lds; LAS bf16* KTb = KTf + 64 * TP; LAS bf16* VT = KTb + 64 * TP;
    const int fr = F.lane & 15, fq = F.lane >> 4;
    for (int u = F.vcu; u < NB * NCH * 4; u += F.G) {
        const int h = u & 3, c = (u >> 2) % NCH, b = u / (NCH * 4); const int row0 = chunk_row0(b, c);
        const float l2f = -fexp(F.ret_ld[(li * 2 + 0) * 4 + h]) * 1.4426950409f, l2b = -fexp(F.ret_ld[(li * 2 + 1) * 4 + h]) * 1.4426950409f;
        { const int j = F.tid >> 2, d0 = (F.tid & 3) * 16; const v4u* kp = (const v4u*)(F.BIG + (size_t)(row0 + j) * EVEN_IN + 256 + h * 64 + d0);
          const v4u k0 = kp[0], k1 = kp[1]; const float wf = fexp2((float)(127 - j) * l2f), wb = fexp2((float)j * l2b);
          const unsigned w[8] = {k0.x, k0.y, k0.z, k0.w, k1.x, k1.y, k1.z, k1.w};
#pragma unroll
          for (int k = 0; k < 8; ++k) { const float lo = bf_lo(w[k]), hi = bf_hi(w[k]);
              KTf[(d0 + 2 * k) * TP + j] = f2bf(lo * wf); KTf[(d0 + 2 * k + 1) * TP + j] = f2bf(hi * wf);
              KTb[(d0 + 2 * k) * TP + j] = f2bf(lo * wb); KTb[(d0 + 2 * k + 1) * TP + j] = f2bf(hi * wb); } }
        stage_vt(F, VT, F.BIG + (size_t)row0 * EVEN_IN + 512 + h * 128, EVEN_IN);
        {
            v4u sv[4];
#pragma unroll
            for (int tt = 0; tt < 4; ++tt) sv[tt] = *(const v4u*)(F.BIG + (size_t)(row0 + 32 * h + 4 * F.wave + tt) * EVEN_IN + 2048 + 8 * F.lane);
#pragma unroll
            for (int tt = 0; tt < 4; ++tt) { const float x[8] = {bf_lo(sv[tt].x), bf_hi(sv[tt].x), bf_lo(sv[tt].y), bf_hi(sv[tt].y), bf_lo(sv[tt].z), bf_hi(sv[tt].z), bf_lo(sv[tt].w), bf_hi(sv[tt].w)};
                float s = 0.f;
#pragma unroll
                for (int k = 0; k < 8; ++k) s += x[k];
                const float mean = wave_sum(s, F.lane) * (1.0f / 512.0f); float q = 0.f;
#pragma unroll
                for (int k = 0; k < 8; ++k) q += (x[k] - mean) * (x[k] - mean);
                const float rstd = frsq(wave_sum(q, F.lane) * (1.0f / 512.0f) + EPS);
                if (F.lane == 0) F.STATS[row0 + 32 * h + 4 * F.wave + tt] = (f32x2){mean, rstd}; } }
        __syncthreads();
        const int dir = F.wave >> 2, mp = F.wave & 3; const LAS bf16* KT = dir ? KTb : KTf;
        f32x4 acc[2][4];
#pragma unroll
        for (int mi = 0; mi < 2; ++mi)
#pragma unroll
            for (int n = 0; n < 4; ++n) acc[mi][n] = (f32x4){0.f, 0.f, 0.f, 0.f};
#pragma unroll
        for (int ks = 0; ks < 4; ++ks) { bf16x8 bv[4];
#pragma unroll
            for (int n = 0; n < 4; ++n) bv[n] = *(const LAS bf16x8*)(KT + (16 * n + fr) * TP + 32 * ks + 8 * fq);
#pragma unroll
            for (int mi = 0; mi < 2; ++mi) { const bf16x8 a = *(const LAS bf16x8*)(VT + (32 * mp + 16 * mi + fr) * TP + 32 * ks + 8 * fq);
#pragma unroll
                for (int n = 0; n < 4; ++n) MMA16(acc[mi][n], a, bv[n]); } }
        float* op = F.KV + ((size_t)(((b * NCH + c) * 4 + h) * 2 + dir) * 128 + 32 * mp + fr) * 64 + 4 * fq;
#pragma unroll
        for (int mi = 0; mi < 2; ++mi)
#pragma unroll
            for (int n = 0; n < 4; ++n) *(f32x4*)(op + (size_t)mi * 16 * 64 + 16 * n) = acc[mi][n];
        __syncthreads();
    }
}

__device__ __forceinline__ void ret_scan_phase(Frame& F, int li) {
    const int gt = F.vcu * 512 + F.tid, GT = F.G * 512;
    for (int it = gt; it < 64 * 128 * 16; it += GT) {
        const int dg = it & 15, e = (it >> 4) & 127, chain = it >> 11, dir = chain & 1, h = (chain >> 1) & 3, b = chain >> 3;
        const float l2 = -fexp(F.ret_ld[(li * 2 + dir) * 4 + h]) * 1.4426950409f; const float cd = fexp2(128.f * l2);
        f32x4 s = {0.f, 0.f, 0.f, 0.f};
        const size_t eo = (size_t)e * 64 + 4 * dg;
#define SC_BLK(st) ((size_t)(((b * NCH + (dir ? ((st) == 0 ? 1 : ((st) == 1 ? 0 : 35 - (st))) : (st))) * 4 + h) * 2 + dir) * 8192)
#pragma unroll 1
        for (int s0 = 0; s0 < NCH; s0 += 8) {
            f32x4 kvv[8];
#pragma unroll
            for (int k = 0; k < 8; ++k) { const int st = (s0 + k < NCH) ? s0 + k : NCH - 1; kvv[k] = *(const f32x4*)(F.KV + SC_BLK(st) + eo); }
#pragma unroll
            for (int k = 0; k < 8; ++k) { if (s0 + k < NCH) { u32x2 w; w.x = cvt_pk_bf16(s[0], s[1]); w.y = cvt_pk_bf16(s[2], s[3]);
                *(u32x2*)(F.ST + SC_BLK(s0 + k) + eo) = w; s = s * cd + kvv[k]; } }
        }
#undef SC_BLK
    }
}

__device__ __forceinline__ void mixer_phase(Frame& F, int li) {
    LAS bf16* VT = (LAS bf16*)F.lds; LAS bf16* PB = VT + 128 * TP; LAS bf16* SN = PB + 128 * TP; LAS f32x2* stats = (LAS f32x2*)(F.lds + 3 * 128 * TP * 2);
    const int fr = F.lane & 15, fq = F.lane >> 4, irow = 16 * F.wave + fr;
    LAS float* cvec = (LAS float*)(F.lds + 3 * 128 * TP * 2 + 1024);
    const bool hfix = (F.G & 3) == 0; const int hw = F.vcu & 3;
    if (hfix) { if (F.tid < 128) { cvec[F.tid] = F.ret_gn[li * 512 + hw * 128 + F.tid]; cvec[128 + F.tid] = F.sg_ln_g[li * 512 + hw * 128 + F.tid]; cvec[256 + F.tid] = F.sg_ln_b[li * 512 + hw * 128 + F.tid]; cvec[384 + F.tid] = F.sg_b[(li * 4 + hw) * 128 + F.tid]; } __syncthreads(); }
    for (int u = F.vcu; u < NB * NCH * 4; u += F.G) {
        const int h = u & 3, c = (u >> 2) % NCH, b = u / (NCH * 4), row0 = chunk_row0(b, c); const size_t grow = (size_t)(row0 + irow);
        if (!hfix) { __syncthreads(); if (F.tid < 128) { cvec[F.tid] = F.ret_gn[li * 512 + h * 128 + F.tid]; cvec[128 + F.tid] = F.sg_ln_g[li * 512 + h * 128 + F.tid]; cvec[256 + F.tid] = F.sg_ln_b[li * 512 + h * 128 + F.tid]; cvec[384 + F.tid] = F.sg_b[(li * 4 + h) * 128 + F.tid]; } __syncthreads(); }
        const bf16* Pr = F.BIG + grow * EVEN_IN;
        const float l2f = -fexp(F.ret_ld[(li * 2 + 0) * 4 + h]) * 1.4426950409f, l2b = -fexp(F.ret_ld[(li * 2 + 1) * 4 + h]) * 1.4426950409f;
        v4u vq[4];
        { const v4u* vp = (const v4u*)(F.BIG + (size_t)(row0 + (F.tid >> 2)) * EVEN_IN + 512 + h * 128 + (F.tid & 3) * 32);
#pragma unroll
          for (int t = 0; t < 4; ++t) vq[t] = vp[t]; }
        bf16x8 qf[2], kf[8][2];
#pragma unroll
        for (int ks = 0; ks < 2; ++ks) qf[ks] = *(const bf16x8*)(Pr + h * 64 + 32 * ks + 8 * fq);
#pragma unroll
        for (int n = 0; n < 8; ++n)
#pragma unroll
            for (int ks = 0; ks < 2; ++ks) kf[n][ks] = *(const bf16x8*)(F.BIG + (size_t)(row0 + 16 * n + fr) * EVEN_IN + 256 + h * 64 + 32 * ks + 8 * fq);
        {
            const int qt = F.tid >> 2, c0 = (F.tid & 3) * 32, e0 = c0, j = qt;
#pragma unroll
            for (int t = 0; t < 4; ++t) { const unsigned w[4] = {vq[t].x, vq[t].y, vq[t].z, vq[t].w};
#pragma unroll
                for (int k = 0; k < 4; ++k) { VT[(e0 + t * 8 + 2 * k) * TP + j] = (bf16)(w[k] & 0xffffu); VT[(e0 + t * 8 + 2 * k + 1) * TP + j] = (bf16)(w[k] >> 16); } }
        }
        {
            const int qt = F.tid >> 2, c0 = (F.tid & 3) * 32; const f32x2 st = F.STATS[row0 + qt];
            const v4u* p = (const v4u*)(F.BIG + (size_t)(row0 + qt) * EVEN_IN + 2048 + h * 128 + c0);
            const LAS float* lg = cvec + 128 + c0; const LAS float* lb = cvec + 256 + c0;
#pragma unroll
            for (int t = 0; t < 4; ++t) { const v4u sv = p[t]; const unsigned w[4] = {sv.x, sv.y, sv.z, sv.w}; const f32x4 g0 = *(const LAS f32x4*)(lg + 8 * t), g1 = *(const LAS f32x4*)(lg + 8 * t + 4), b0 = *(const LAS f32x4*)(lb + 8 * t), b1 = *(const LAS f32x4*)(lb + 8 * t + 4);
                const float gg[8] = {g0[0], g0[1], g0[2], g0[3], g1[0], g1[1], g1[2], g1[3]}, bbv[8] = {b0[0], b0[1], b0[2], b0[3], b1[0], b1[1], b1[2], b1[3]};
#pragma unroll
                for (int k = 0; k < 4; ++k) { const float lo = (bf_lo(w[k]) - st.x) * st.y * gg[2 * k] + bbv[2 * k], hi = (bf_hi(w[k]) - st.x) * st.y * gg[2 * k + 1] + bbv[2 * k + 1];
                    SN[(c0 + 8 * t + 2 * k) * TP + qt] = f2bf(lo); SN[(c0 + 8 * t + 2 * k + 1) * TP + qt] = f2bf(hi); } }
        }
        __syncthreads();
        {
            f32x4 acc[8];
#pragma unroll
            for (int n = 0; n < 8; ++n) acc[n] = (f32x4){0.f, 0.f, 0.f, 0.f};
#pragma unroll
            for (int n = 0; n < 8; ++n)
#pragma unroll
                for (int ks = 0; ks < 2; ++ks) MMA16(acc[n], qf[ks], kf[n][ks]);
#pragma unroll
            for (int n = 0; n < 8; ++n) { float pv[4];
#pragma unroll
                for (int r = 0; r < 4; ++r) { const int dl = irow - (16 * n + 4 * fq + r); const float dec = dl > 0 ? fexp2((float)dl * l2f) : (dl < 0 ? fexp2((float)(-dl) * l2b) : 2.0f); pv[r] = acc[n][r] * dec; }
                u32x2 w; w.x = cvt_pk_bf16(pv[0], pv[1]); w.y = cvt_pk_bf16(pv[2], pv[3]); *(LAS u32x2*)(PB + irow * TP + 16 * n + 4 * fq) = w; }
        }
        const bf16* sp = F.ST + (size_t)((((b * NCH + c) * 4 + h) * 2) * 128 + fr) * 64 + 8 * fq;
        bf16x8 sfr[8][2];
#pragma unroll
        for (int n = 0; n < 8; ++n)
#pragma unroll
            for (int ks = 0; ks < 2; ++ks) sfr[n][ks] = *(const bf16x8*)(sp + (16 * n) * 64 + 32 * ks);
        LDS_WAIT();
        f32x4 ao[8];
#pragma unroll
        for (int n = 0; n < 8; ++n) ao[n] = (f32x4){0.f, 0.f, 0.f, 0.f};
#pragma unroll
        for (int ks = 0; ks < 4; ++ks) { const bf16x8 a = *(const LAS bf16x8*)(PB + irow * TP + 32 * ks + 8 * fq);
#pragma unroll
            for (int n = 0; n < 8; ++n) { const bf16x8 bv = *(const LAS bf16x8*)(VT + (16 * n + fr) * TP + 32 * ks + 8 * fq); MMA16(ao[n], a, bv); } }
#pragma unroll
        for (int dir = 0; dir < 2; ++dir) {
            const float xi = dir ? fexp2((float)(128 - irow) * l2b) : fexp2((float)(irow + 1) * l2f);
            f32x4 ax[8];
#pragma unroll
            for (int n = 0; n < 8; ++n) ax[n] = (f32x4){0.f, 0.f, 0.f, 0.f};
#pragma unroll
            for (int n = 0; n < 8; ++n)
#pragma unroll
                for (int ks = 0; ks < 2; ++ks) MMA16(ax[n], qf[ks], sfr[n][ks]);
            if (dir == 0) {
#pragma unroll
                for (int n = 0; n < 8; ++n)
#pragma unroll
                    for (int ks = 0; ks < 2; ++ks) sfr[n][ks] = *(const bf16x8*)(sp + 128 * 64 + (16 * n) * 64 + 32 * ks); }
#pragma unroll
            for (int n = 0; n < 8; ++n) ao[n] = ao[n] + ax[n] * xi;
        }
        float s = 0.f;
#pragma unroll
        for (int n = 0; n < 8; ++n) s += (ao[n][0] + ao[n][1]) + (ao[n][2] + ao[n][3]);
        s = col_sum4(s);
        const float mean = s * (1.0f / 128.0f); float q = 0.f;
#pragma unroll
        for (int n = 0; n < 8; ++n) { const f32x4 d = ao[n] - mean; q += (d[0] * d[0] + d[1] * d[1]) + (d[2] * d[2] + d[3] * d[3]); }
        q = col_sum4(q);
        const float rstd = frsq(q * (1.0f / 128.0f) + EPS);
#pragma unroll
        for (int n = 0; n < 8; ++n) { const int e0 = 16 * n + 4 * fq; const u32x2 gt = *(const u32x2*)(Pr + 1024 + h * 128 + e0); const f32x4 gn = *(const LAS f32x4*)(cvec + e0);
            const float y0 = (ao[n][0] - mean) * rstd * gn[0] * silu_f(bf_lo(gt.x)), y1 = (ao[n][1] - mean) * rstd * gn[1] * silu_f(bf_hi(gt.x));
            const float y2 = (ao[n][2] - mean) * rstd * gn[2] * silu_f(bf_lo(gt.y)), y3 = (ao[n][3] - mean) * rstd * gn[3] * silu_f(bf_hi(gt.y));
            u32x2 w; w.x = cvt_pk_bf16(y0, y1); w.y = cvt_pk_bf16(y2, y3); *(u32x2*)(F.MIX + grow * D + h * 128 + e0) = w; }
        {
            f32x4 acc[8];
#pragma unroll
            for (int n = 0; n < 8; ++n) acc[n] = (f32x4){0.f, 0.f, 0.f, 0.f};
#pragma unroll
            for (int ks = 0; ks < 4; ++ks) { const bf16x8 a = *(const bf16x8*)(F.SGW + ((size_t)(li * 4 + h) * 128 + irow) * 128 + 32 * ks + 8 * fq);
#pragma unroll
                for (int n = 0; n < 8; ++n) { const bf16x8 bv = *(const LAS bf16x8*)(SN + (16 * n + fr) * TP + 32 * ks + 8 * fq); MMA16(acc[n], a, bv); } }
            const float bsv = cvec[384 + irow];
#pragma unroll
            for (int n = 0; n < 8; ++n) { const int c0 = 16 * n + 4 * fq; const u32x2 uu = *(const u32x2*)(Pr + 1536 + h * 128 + c0);
                u32x2 w; w.x = cvt_pk_bf16(bf_lo(uu.x) * (acc[n][0] + bsv), bf_hi(uu.x) * (acc[n][1] + bsv)); w.y = cvt_pk_bf16(bf_lo(uu.y) * (acc[n][2] + bsv), bf_hi(uu.y) * (acc[n][3] + bsv));
                *(u32x2*)(F.MIX + grow * D + 512 + h * 128 + c0) = w; }
        }
        __syncthreads();
    }
}

namespace att {
constexpr int QBLK = 32, KVBLK = 64, DH = 128;
constexpr float SCALE = 0.088388347648318440f;
constexpr float THR = 8.f;
constexpr int LDQ = 1024, LDK = 256, LDO = 1024;
constexpr size_t SHM_V = KVBLK * DH * 2, SHM_K = KVBLK * DH * 2, SHM_ATTN = 2 * SHM_V + 2 * SHM_K + NWAVES * 64 * 4;
#define KSWZ(row, colB) ((row) * 256 + ((colB) ^ (((row) & 7) << 4)))
#define SBAR() __builtin_amdgcn_sched_barrier(0)
__device__ __forceinline__ int crow(int r, int hi) { return (r & 3) + 8 * (r >> 2) + 4 * hi; }
__device__ __forceinline__ void partialSM(f32x16& p0, f32x16& p1, float& m_reg, float& mn, float& alpha) {
  constexpr float C = SCALE * 1.4426950408889634f;
  float pmax = p0[0]; for (int r = 1; r < 16; ++r) pmax = fmaxf(pmax, p0[r]); for (int r = 0; r < 16; ++r) pmax = fmaxf(pmax, p1[r]);
  { auto rr = __builtin_amdgcn_permlane32_swap(__float_as_uint(pmax), __float_as_uint(pmax), false, false);
    pmax = fmaxf(__uint_as_float(rr[0]), __uint_as_float(rr[1])); }
  if (__builtin_expect(__all(pmax - m_reg <= THR / SCALE), 1)) { mn = m_reg; alpha = 1.f; }
  else { mn = fmaxf(m_reg, pmax); alpha = __builtin_amdgcn_exp2f((m_reg - mn) * C); m_reg = mn; }
  float mnC = -mn * C;
  for (int r = 0; r < 16; ++r) p0[r] = fmaf(p0[r], C, mnC); for (int r = 0; r < 16; ++r) p1[r] = fmaf(p1[r], C, mnC);
  for (int r = 0; r < 16; ++r) p0[r] = __builtin_amdgcn_exp2f(p0[r]);
}
__device__ __forceinline__ void finishSM(f32x16& p0, f32x16& p1, float alpha, float& l_reg, bf16x8& pa0, bf16x8& pa1, bf16x8& pa2, bf16x8& pa3) {
  for (int r = 0; r < 16; ++r) p1[r] = __builtin_amdgcn_exp2f(p1[r]);
  float ps = 0; for (int r = 0; r < 16; ++r) ps += p0[r]; for (int r = 0; r < 16; ++r) ps += p1[r];
  { auto rr = __builtin_amdgcn_permlane32_swap(__float_as_uint(ps), __float_as_uint(ps), false, false);
    ps = __uint_as_float(rr[0]) + __uint_as_float(rr[1]); }
  l_reg = l_reg * alpha + ps;
#define PK4(P, BASE, OUT) do { unsigned a0 = cvt_pk_bf16(P[BASE + 0], P[BASE + 1]), a1 = cvt_pk_bf16(P[BASE + 2], P[BASE + 3]);   \
    unsigned b0 = cvt_pk_bf16(P[BASE + 4], P[BASE + 5]), b1 = cvt_pk_bf16(P[BASE + 6], P[BASE + 7]);                              \
    auto r0 = __builtin_amdgcn_permlane32_swap(a0, b0, false, false); auto r1 = __builtin_amdgcn_permlane32_swap(a1, b1, false, false); \
    v4u w = {r0[0], r1[0], r0[1], r1[1]}; OUT = *reinterpret_cast<bf16x8*>(&w); } while (0)
  PK4(p0, 0, pa0); PK4(p0, 8, pa1); PK4(p1, 0, pa2); PK4(p1, 8, pa3);
#undef PK4
}
__device__ __forceinline__ void qkt(f32x16& p0, f32x16& p1, const int (&kb4)[4], int boff, const bf16x8* qr) {
  p0 = f32x16{}; p1 = f32x16{};
#pragma unroll
  for (int d0 = 0; d0 < 8; ++d0) { const LAS char* kp = (const LAS char*)(uintptr_t)(unsigned)(kb4[d0 & 3] + boff);
    bf16x8 b0 = *reinterpret_cast<const LAS bf16x8*>(kp + (d0 >> 2) * 128);
    bf16x8 b1 = *reinterpret_cast<const LAS bf16x8*>(kp + (d0 >> 2) * 128 + 8192);
    p0 = __builtin_amdgcn_mfma_f32_32x32x16_bf16(b0, qr[d0], p0, 0, 0, 0);
    p1 = __builtin_amdgcn_mfma_f32_32x32x16_bf16(b1, qr[d0], p1, 0, 0, 0); }
}
__device__ __forceinline__ void mask_tile(f32x16& p0, f32x16& p1, int mk, int jb, int i, int hi) {
  if (mk == 1) { for (int r = 0; r < 16; ++r) { const int j = jb + crow(r, hi); p0[r] = (j >= i) ? p0[r] : -1e30f; p1[r] = (j + 32 >= i) ? p1[r] : -1e30f; } }
  else if (mk == 2) { for (int r = 0; r < 16; ++r) { const int j = jb + crow(r, hi); p0[r] = (j <= i) ? p0[r] : -1e30f; p1[r] = (j + 32 <= i) ? p1[r] : -1e30f; } }
}
__device__ __forceinline__ int v_st(int k, int c) { const int kk = (k & ~0xC) | ((k & 4) << 1) | ((k & 8) >> 1); return ((kk >> 3) * 4 + (c >> 5)) * 512 + ((kk & 7) * 32 + (c & 31)) * 2; }
__device__ __forceinline__ int v_rd_base(int lane) { return ((lane & 3) << 3) | (((lane >> 2) & 3) << 6) | (((lane >> 4) & 1) << 5) | (((lane >> 5) & 1) << 8); }
constexpr int v_rd_off(int d0, int ks, int half) { return d0 * 512 + ks * 4096 + half * 2048; }
template <int OFF> __device__ __forceinline__ s16x4 tr_read(int vb) {
  s16x4 r; asm volatile("ds_read_b64_tr_b16 %0, %1 offset:%2" : "=&v"(r) : "v"(vb), "i"(OFF) : "memory"); return r;
}
template <int D0> __device__ __forceinline__ void pv_one(f32x16& od, int vb, bf16x8 pa0, bf16x8 pa1, bf16x8 pa2, bf16x8 pa3) {
  const s16x4 l0 = tr_read<v_rd_off(D0, 0, 0)>(vb), h0 = tr_read<v_rd_off(D0, 0, 1)>(vb), l1 = tr_read<v_rd_off(D0, 1, 0)>(vb), h1 = tr_read<v_rd_off(D0, 1, 1)>(vb);
  const s16x4 l2 = tr_read<v_rd_off(D0, 2, 0)>(vb), h2 = tr_read<v_rd_off(D0, 2, 1)>(vb), l3 = tr_read<v_rd_off(D0, 3, 0)>(vb), h3 = tr_read<v_rd_off(D0, 3, 1)>(vb);
  asm volatile("s_waitcnt lgkmcnt(0)" ::: "memory"); SBAR();
#define PK(L, H) (bf16x8){L[0], L[1], L[2], L[3], H[0], H[1], H[2], H[3]}
  od = __builtin_amdgcn_mfma_f32_32x32x16_bf16(pa0, PK(l0, h0), od, 0, 0, 0);
  od = __builtin_amdgcn_mfma_f32_32x32x16_bf16(pa1, PK(l1, h1), od, 0, 0, 0);
  od = __builtin_amdgcn_mfma_f32_32x32x16_bf16(pa2, PK(l2, h2), od, 0, 0, 0);
  od = __builtin_amdgcn_mfma_f32_32x32x16_bf16(pa3, PK(l3, h3), od, 0, 0, 0);
#undef PK
}
__device__ __forceinline__ void pv_d0(f32x16* o, int vb, bf16x8 pa0, bf16x8 pa1, bf16x8 pa2, bf16x8 pa3) {
  pv_one<0>(o[0], vb, pa0, pa1, pa2, pa3); pv_one<1>(o[1], vb, pa0, pa1, pa2, pa3); pv_one<2>(o[2], vb, pa0, pa1, pa2, pa3); pv_one<3>(o[3], vb, pa0, pa1, pa2, pa3);
}

__device__ __forceinline__ void attn_unit(const bf16* __restrict__ Q, const bf16* __restrict__ Kb, const bf16* __restrict__ Vb, bf16* __restrict__ O, const float* __restrict__ sinkp,
                                          int qrow0, int h0, int kvh, int klat, int kctx, int add0, int skipnext, int NT, char* lds, const int tid) {
  const int wid = tid >> 6, lane = tid & 63, r32 = lane & 31, hi = lane >> 5;
  bf16* V_lds = (bf16*)lds; bf16* K_lds = (bf16*)(lds + 2 * SHM_V);
  float* ws = (float*)(lds + 2 * SHM_V + 2 * SHM_K) + wid * 64; float* li_l = ws; float* al_l = ws + 32;
  const int head = h0 + (wid >> 2), iq = (wid & 3) * QBLK + r32;
  float m_reg = sinkp[head] * (1.0f / SCALE), l_reg = 1.0f; f32x16 o[4] = {}; bf16x8 qr[8];
  const bf16* Qw = Q + (size_t)(qrow0 + iq) * LDQ + head * DH + hi * 8;
#pragma unroll
  for (int d0 = 0; d0 < 8; ++d0) qr[d0] = *reinterpret_cast<const bf16x8*>(Qw + d0 * 16);
  const int sr = tid >> 4, sc = (tid & 15) * 8, vst0 = v_st(sr, sc), vst1 = v_st(32 + sr, sc);
  const int vb0 = (int)(uintptr_t)V_lds + v_rd_base(lane);
  int kb4[4];
#pragma unroll
  for (int q = 0; q < 4; ++q) kb4[q] = (int)(uintptr_t)K_lds + r32 * 256 + ((q << 5) ^ ((hi << 4) ^ ((r32 & 7) << 4)));
  const unsigned kvoff = (unsigned)((sr * LDK + kvh * DH + sc) * 2);
  struct { bf16x8 vs0, vs1, ks0, ks1; } sr_[2];
#define TILE_T(s) ({ int _t = (s) + add0; if (skipnext && _t >= 4) _t += 2; _t; })
#define TILE_ROW(t) ((t) < 6 ? klat + 64 * (t) : kctx + 64 * ((t) - 6))
#define TILE_MK(t) ((t) < 2 ? 1 : (((t) >= 4 && (t) < 6) ? 2 : 0))
#define SLOAD(i, s) do { const int _t = TILE_T(s); const size_t _k0 = (size_t)TILE_ROW(_t) * (LDK * 2); const char* _kp = (const char*)Kb + _k0; const char* _vp = (const char*)Vb + _k0; \
    sr_[i].vs0 = *reinterpret_cast<const bf16x8*>(_vp + kvoff); sr_[i].vs1 = *reinterpret_cast<const bf16x8*>(_vp + 32 * LDK * 2 + kvoff); \
    sr_[i].ks0 = *reinterpret_cast<const bf16x8*>(_kp + kvoff); sr_[i].ks1 = *reinterpret_cast<const bf16x8*>(_kp + 32 * LDK * 2 + kvoff); } while (0)
#define SWRITE(b, i) do { *(bf16x8*)((char*)V_lds + (b) * SHM_V + vst0) = sr_[i].vs0;          \
    *(bf16x8*)((char*)V_lds + (b) * SHM_V + vst1) = sr_[i].vs1; int kc = sc * 2;               \
    *(bf16x8*)((char*)K_lds + (b) * SHM_K + KSWZ(sr, kc)) = sr_[i].ks0;                       \
    *(bf16x8*)((char*)K_lds + (b) * SHM_K + KSWZ(32 + sr, kc)) = sr_[i].ks1; } while (0)
#define SWAIT() asm volatile("s_waitcnt vmcnt(4)" ::: "memory")
#define RESC(a) do { if (__any((a) < 1.f)) { if (hi == 0) al_l[r32] = (a); asm volatile("s_waitcnt lgkmcnt(0)" ::: "memory"); \
    for (int d = 0; d < 4; ++d) for (int r = 0; r < 16; ++r) o[d][r] *= al_l[crow(r, hi)]; } } while (0)
#define MASK(P0, P1, s) do { const int _t = TILE_T(s); mask_tile(P0, P1, TILE_MK(_t), 64 * (_t & 1), iq, hi); } while (0)
  f32x16 pA0, pA1, pB0, pB1; float mnA, mnB, alA, alB; bf16x8 pa0, pa1, pa2, pa3;
  constexpr int SE = 0, SO = 1;
  SLOAD(SE, 0); asm volatile("s_waitcnt vmcnt(0)" ::: "memory"); SWRITE(0, SE); __syncthreads();
  qkt(pA0, pA1, kb4, 0, qr); MASK(pA0, pA1, 0); partialSM(pA0, pA1, m_reg, mnA, alA);
  SLOAD(SO, 1); if (2 < NT) SLOAD(SE, 2);
  SWAIT(); SWRITE(1, SO); __syncthreads();
  for (int j = 1; j + 1 < NT; j += 2) {
    SBAR(); qkt(pB0, pB1, kb4, (int)SHM_K, qr); MASK(pB0, pB1, j);
    finishSM(pA0, pA1, alA, l_reg, pa0, pa1, pa2, pa3); SBAR();
    SLOAD(SO, j + 2); SBAR();
    pv_d0(o, vb0, pa0, pa1, pa2, pa3); partialSM(pB0, pB1, m_reg, mnB, alB);
    __syncthreads(); SWAIT(); SWRITE(0, SE);
    RESC(alB); __syncthreads();
    SBAR(); qkt(pA0, pA1, kb4, 0, qr); MASK(pA0, pA1, j + 1);
    finishSM(pB0, pB1, alB, l_reg, pa0, pa1, pa2, pa3); SBAR();
    if (j + 3 < NT) SLOAD(SE, j + 3); SBAR();
    pv_d0(o, vb0 + (int)SHM_V, pa0, pa1, pa2, pa3); partialSM(pA0, pA1, m_reg, mnA, alA);
    __syncthreads(); SWAIT(); SWRITE(1, SO);
    RESC(alA); __syncthreads();
  }
  SBAR(); qkt(pB0, pB1, kb4, (int)SHM_K, qr); MASK(pB0, pB1, NT - 1);
  finishSM(pA0, pA1, alA, l_reg, pa0, pa1, pa2, pa3); SBAR();
  pv_d0(o, vb0, pa0, pa1, pa2, pa3); partialSM(pB0, pB1, m_reg, mnB, alB);
  __syncthreads(); RESC(alB);
  finishSM(pB0, pB1, alB, l_reg, pa0, pa1, pa2, pa3); SBAR();
  pv_d0(o, vb0 + (int)SHM_V, pa0, pa1, pa2, pa3);
  if (hi == 0) li_l[r32] = l_reg; asm volatile("s_waitcnt lgkmcnt(0)" ::: "memory");
  float rli[16];
#pragma unroll
  for (int r = 0; r < 16; ++r) rli[r] = __builtin_amdgcn_rcpf(li_l[crow(r, hi)]);
  bf16* Ow = O + (size_t)(qrow0 + (wid & 3) * QBLK) * LDO + head * DH;
#pragma unroll
  for (int r = 0; r < 16; ++r) { int orow = crow(r, hi);
    for (int d0 = 0; d0 < 4; ++d0) Ow[(size_t)orow * LDO + d0 * 32 + r32] = f2bf(o[d0][r] * rli[r]); }
  __syncthreads();
#undef TILE_T
#undef TILE_ROW
#undef TILE_MK
#undef SLOAD
#undef SWRITE
#undef SWAIT
#undef RESC
#undef MASK
}
}

__device__ __forceinline__ void attn_phase(Frame& F, int li, bool need_ctx) {
    const bf16* Q = F.BIG; const bf16* Kb = (const bf16*)((const char*)F.BIG + BIG_K); const bf16* Vb = (const bf16*)((const char*)F.BIG + BIG_V);
    const float* sinkp = F.sink + li * 8;
    const int NU = 1024 + (need_ctx ? 64 : 0);
    for (int u = F.vcu; u < NU; u += F.G) {
        if (u < 1024) { const int pair = u & 1, kvh = (u >> 1) & 1, n = (u >> 2) & 31, b = u >> 7;
            const int add0 = (n == 0) ? 2 : 0, skipnext = (n == 31) ? 1 : 0, NT = 10 - ((n == 0 || n == 31) ? 2 : 0);
            att::attn_unit(Q, Kb, Vb, F.MIX, sinkp, b * SEQ + n * 128, kvh * 4 + pair * 2, kvh, b * SEQ + (n - 1) * 128, RL + b * LC, add0, skipnext, NT, F.ldsg, F.tid);
        } else { const int v = u - 1024, pair = v & 1, kvh = (v >> 1) & 1, cb = (v >> 2) & 1, b = v >> 3;
            att::attn_unit(Q, Kb, Vb, F.MIX, sinkp, RL + b * LC + cb * 128, kvh * 4 + pair * 2, kvh, 0, RL + b * LC, 6, 0, 4, F.ldsg, F.tid);
        }
    }
}

#ifndef MK_SINGLE
#define MK_SINGLE 1
#endif
#ifndef REP_SET
#define REP_SET 0
#endif
#define RP(n) ((REP_SET == 200 + (n)) ? 2 : 1)
constexpr int REPS[14] = {RP(0), RP(1), RP(2), RP(3), RP(4), RP(5), RP(6), RP(7), RP(8), RP(9), RP(10), RP(11), RP(12), RP(13)};
#ifdef ONLY
#define ONLYX(n, stmt) do { if constexpr (ONLY == (n)) { stmt; } } while (0)
#else
#define ONLYX(n, stmt) do { for (int rep_ = 0; rep_ < REPS[n]; ++rep_) { stmt; if (rep_ + 1 < REPS[n]) xcd_barrier(bar); } } while (0)
#endif
constexpr int PPL = 9;
constexpr int NPHASE = 1 + DEPTH * PPL + 1;

#define CAS __attribute__((address_space(4)))
__device__ __forceinline__ void fill_ptrs(Frame& F, LAS unsigned char* ldsbase, int wv) {
    const CAS char* ka = (const CAS char*)__builtin_amdgcn_kernarg_segment_ptr(); asm volatile("" : "+s"(ka));
    { F.lds = ldsbase; F.ldsg = (char*)ldsbase; F.MISC = (volatile LAS unsigned*)(ldsbase + MISC_OFF); }
    { asm volatile("" : "+s"(wv)); unsigned am = ~0u; asm volatile("" : "+s"(am)); int ln = (int)__builtin_amdgcn_mbcnt_hi(am, __builtin_amdgcn_mbcnt_lo(am, 0u)); asm volatile("" : "+v"(ln)); F.lane = ln; F.wave = wv; F.tid = wv * 64 + ln; }
    { int g = gridDim.x, bx = blockIdx.x; asm volatile("" : "+s"(g), "+s"(bx)); F.G = g; F.vcu = (g % 8 == 0) ? (bx % 8) * (g / 8) + bx / 8 : bx; F.bx = bx; }
#define KIN(k) (*(const float* const CAS*)(ka + 8 * (k)))
    F.x_in = KIN(0); F.c_in = KIN(1); F.ctx_in = KIN(2); F.cctx_in = KIN(3); F.w_mod = KIN(4); F.b_mod = KIN(5); F.norm_g = KIN(6);
    F.w_in_even = KIN(7); F.w_out_even = KIN(8); F.ret_ld = KIN(9); F.ret_gn = KIN(10); F.sg_ln_g = KIN(11); F.sg_ln_b = KIN(12); F.sg_w = KIN(13); F.sg_b = KIN(14);
    F.w_qkv = KIN(15); F.w_o = KIN(16); F.sink = KIN(17); F.w_router = KIN(18); F.b_router = KIN(19); F.w_eg = KIN(20); F.w_eu = KIN(21); F.w_ed = KIN(22); F.final_g = KIN(23);
    F.out = *(float* const CAS*)(ka + 8 * 24);
    unsigned char* ws = *(unsigned char* const CAS*)(ka + 8 * 25);
#undef KIN
    F.ctl = (unsigned*)(ws + WS_CTL);
    F.MOD = (float*)(ws + WS_MOD); F.ROPE = (float*)(ws + WS_ROPE); F.X = (bf16*)(ws + WS_X); F.KV = (float*)(ws + WS_C);
    F.SGW = (bf16*)(ws + WS_SGW); F.W1T = (bf16*)(ws + WS_W1T); F.W2T = (bf16*)(ws + WS_W2T); F.WIN = (bf16*)(ws + WS_WIN); F.WOUT = (bf16*)(ws + WS_WOUT); F.WQKV = (bf16*)(ws + WS_WQKV); F.WO = (bf16*)(ws + WS_WO);
    F.H = (bf16*)(ws + WS_H); F.BIG = (bf16*)(ws + WS_BIG); F.MIX = (bf16*)(ws + WS_MIX); F.CS = (bf16*)(ws + WS_C); F.ST = (bf16*)(ws + WS_C + C_ST);
    F.STATS = (f32x2*)(ws + WS_STATS); F.TOK = (v4u*)(ws + WS_TOK); F.LIST = (int*)(ws + WS_LIST);
}
struct Args { const float* in[24]; float* out; unsigned char* ws; int ph_lo, ph_hi; };

__global__ void __launch_bounds__(NWAVES * 64, 2) fwd_kernel(Args args) {
    extern __shared__ __attribute__((aligned(16))) unsigned char lds[];
    Frame F; const int wv0 = __builtin_amdgcn_readfirstlane((int)threadIdx.x >> 6);
    fill_ptrs(F, (LAS unsigned char*)lds, wv0);
    for (int u = F.tid; u < (LDS_BYTES - MISC_OFF) / 4; u += NWAVES * 64) ((LAS unsigned*)(F.lds + MISC_OFF))[u] = 0u;
    __syncthreads();
    XcdBarrier bar; bar.bar = F.ctl + CW_BAR; bar.x = 0; bar.st = nullptr;
    if (MK_SINGLE) bar = xcd_barrier_post(F.ctl + CW_BAR, F.MISC);
    const int lo = args.ph_lo, hi = args.ph_hi;
#define IN(k) (lo <= (k) && (k) < hi)
#define SEAM(k) do { if (IN((k) + 1)) xcd_barrier(bar); } while (0)

    if (IN(0)) { fill_ptrs(F, (LAS unsigned char*)lds, wv0); ONLYX(0, p0_prologue(F)); SEAM(0); }

#pragma unroll 1
    for (int l = 0; l < DEPTH; ++l) {
        const int pb = 1 + l * PPL, li = l >> 1; const bool even = !(l & 1), need_ctx = l < DEPTH - 1;
        const int nrows = need_ctx ? RT : RL;
        if (IN(pb + 0)) { fill_ptrs(F, (LAS unsigned char*)lds, wv0); if (l == 0) { ONLYX(1, (norm_phase<false, false, false, true>(F, l, RT, 0, even ? IN8 : QKV8))); } else { ONLYX(2, (norm_phase<true, false, false, false>(F, l, RT, 0, even ? IN8 : QKV8))); } SEAM(pb + 0); }
        if (IN(pb + 1)) {
            fill_ptrs(F, (LAS unsigned char*)lds, wv0);
            if (even) { pg8::Gemm g{F.H, (const bf16*)((const unsigned char*)F.WIN + (size_t)li * EVEN_IN * 1024 * (IN8 ? 1 : 2)), 0}; pg8::StaticOrder S; S.init(RT, EVEN_IN, F.G, F.bx); EpiIn E{F.BIG};
                ONLYX(3, (pg8::gemm_phase<EpiIn, pg8::StaticOrder, true, false, IN8>(F.lds, g, S, E, F.tid))); }
            else { pg8::Gemm g{F.H, (const bf16*)((const unsigned char*)F.WQKV + (size_t)li * ODD_IN * 1024 * (QKV8 ? 1 : 2)), 0}; pg8::StaticOrder S; S.init(RT, ODD_IN, F.G, F.bx);
                EpiQKV E{F.BIG, (bf16*)((char*)F.BIG + BIG_K), (bf16*)((char*)F.BIG + BIG_V), F.ROPE};
                ONLYX(4, (pg8::gemm_phase<EpiQKV, pg8::StaticOrder, true, false, QKV8>(F.lds, g, S, E, F.tid))); }
            SEAM(pb + 1);
        }
        if (even) {
            if (IN(pb + 2)) { fill_ptrs(F, (LAS unsigned char*)lds, wv0); ONLYX(5, ret_kv_phase(F, li)); SEAM(pb + 2); }
            if (IN(pb + 3)) { fill_ptrs(F, (LAS unsigned char*)lds, wv0); ONLYX(6, ret_scan_phase(F, li)); SEAM(pb + 3); }
            if (IN(pb + 4)) { fill_ptrs(F, (LAS unsigned char*)lds, wv0); ONLYX(7, mixer_phase(F, li)); SEAM(pb + 4); }
        } else {
            if (IN(pb + 4)) { fill_ptrs(F, (LAS unsigned char*)lds, wv0); ONLYX(8, attn_phase(F, li, need_ctx)); SEAM(pb + 4); }
        }
        if (IN(pb + 5)) {
            fill_ptrs(F, (LAS unsigned char*)lds, wv0);
            pg8::Gemm g{F.MIX, (even ? F.WOUT : F.WO) + (size_t)li * 1048576, 0}; pg8::StaticOrder S; S.init(nrows, D, F.G, F.bx);
            EpiRes E{l == 0 ? F.x_in : nullptr, l == 0 ? F.ctx_in : nullptr, F.X, F.MOD + (size_t)l * 9 * 6144};
            ONLYX(9, (pg8::gemm_phase<EpiRes, pg8::StaticOrder, true, false, false>(F.lds, g, S, E, F.tid)));
            SEAM(pb + 5);
        }
        if (IN(pb + 6)) { fill_ptrs(F, (LAS unsigned char*)lds, wv0); ONLYX(10, (norm_phase<false, true, false, false>(F, l, nrows, 1, true))); SEAM(pb + 6); }
        if (IN(pb + 7)) {
            fill_ptrs(F, (LAS unsigned char*)lds, wv0);
            const LAS int* tab = moe_table(F, l);
            pg8::Gemm g{F.H, (const bf16*)((const unsigned char*)F.W1T + (size_t)l * 16 * 2048 * 1024), (size_t)2048 * 1024}; pg8::MoeOrder S; S.init(tab, F.LIST, 8, F.G, F.bx); EpiMoe1 E{(unsigned char*)F.BIG};
            ONLYX(11, (pg8::gemm_phase<EpiMoe1, pg8::MoeOrder, true, true, true>(F.lds, g, S, E, F.tid)));
            SEAM(pb + 7);
        }
        if (IN(pb + 8)) {
            fill_ptrs(F, (LAS unsigned char*)lds, wv0);
            const LAS int* tab = moe_table(F, l);
            pg8::Gemm g{F.BIG, (const bf16*)((const unsigned char*)F.W2T + (size_t)l * 16 * 1048576), (size_t)1048576}; pg8::MoeOrder S; S.init(tab, F.LIST, 4, F.G, F.bx); EpiBf8 E{F.CS};
            ONLYX(12, (pg8::gemm_phase<EpiBf8, pg8::MoeOrder, true, false, true, true>(F.lds, g, S, E, F.tid)));
            SEAM(pb + 8);
        }
    }
    if (IN(NPHASE - 1)) { fill_ptrs(F, (LAS unsigned char*)lds, wv0); ONLYX(13, (norm_phase<true, false, true, false>(F, DEPTH, RL, 0, true))); }
#undef IN
#undef SEAM
}

extern "C" void kernel_launch(void* const* d_in, const int* in_sizes, int n_in, void* d_out, int out_size, void* d_ws, size_t ws_size, hipStream_t stream) {
    static int grid = 0;
    if (grid == 0) {
        if (n_in != 24 || in_sizes[0] != RL * D || out_size != RL * D || ws_size < WS_END) { fprintf(stderr, "kernel_launch: shape mismatch: n_in %d in0 %d out %d ws %zu (need %zu)\n", n_in, n_in > 0 ? in_sizes[0] : -1, out_size, ws_size, (size_t)WS_END); grid = -1; return; }
        int dev = 0, cus = 0, per_cu = 0;
        if (hipGetDevice(&dev) != hipSuccess || hipDeviceGetAttribute(&cus, hipDeviceAttributeMultiprocessorCount, dev) != hipSuccess) { fprintf(stderr, "kernel_launch: device query failed\n"); grid = -1; return; }
        if (hipFuncSetAttribute((const void*)fwd_kernel, hipFuncAttributeMaxDynamicSharedMemorySize, LDS_BYTES) != hipSuccess) { fprintf(stderr, "kernel_launch: hipFuncSetAttribute failed\n"); grid = -1; return; }
        if (hipOccupancyMaxActiveBlocksPerMultiprocessor(&per_cu, (const void*)fwd_kernel, NWAVES * 64, LDS_BYTES) != hipSuccess || per_cu < 1) { fprintf(stderr, "kernel_launch: occupancy query reports %d workgroups per CU\n", per_cu); }
        (void)hipGetLastError();
        grid = cus;
    }
    if (grid < 0) return;
    if (hipMemsetAsync((char*)d_ws + WS_CTL, 0, CTL_ZERO_BYTES, stream) != hipSuccess) { fprintf(stderr, "kernel_launch: memset failed\n"); return; }
    Args a{};
    for (int i = 0; i < 24; ++i) a.in[i] = (const float*)d_in[i];
    a.out = (float*)d_out; a.ws = (unsigned char*)d_ws;
#if MK_SINGLE
    a.ph_lo = 0; a.ph_hi = NPHASE;
    hipLaunchKernelGGL(fwd_kernel, dim3(grid), dim3(NWAVES * 64), LDS_BYTES, stream, a);
#else
    for (int p = 0; p < NPHASE; ++p) {
        if (p >= 1 && p < NPHASE - 1) { const int l = (p - 1) / PPL, k = (p - 1) % PPL; if ((l & 1) && (k == 2 || k == 3)) continue; }
        a.ph_lo = p; a.ph_hi = p + 1;
        hipLaunchKernelGGL(fwd_kernel, dim3(grid), dim3(NWAVES * 64), LDS_BYTES, stream, a);
    }
#endif
    const hipError_t le = hipPeekAtLastError();
    if (le != hipSuccess) fprintf(stderr, "kernel_launch: launch failed: %s\n", hipGetErrorName(le));
}
```

```cpp
#include <hip/hip_runtime.h>
#include <cstdio>
#include <cstdint>
#include <type_traits>

#define GAS __attribute__((address_space(1)))
#define LAS __attribute__((address_space(3)))
typedef unsigned short bf16;
typedef unsigned v4u __attribute__((ext_vector_type(4)));
typedef unsigned u32x2 __attribute__((ext_vector_type(2)));
typedef float f32x2 __attribute__((ext_vector_type(2)));
typedef float f32x4 __attribute__((ext_vector_type(4)));
typedef float f32x16 __attribute__((ext_vector_type(16)));
typedef short bf16x8 __attribute__((ext_vector_type(8)));
typedef short s16x4 __attribute__((ext_vector_type(4)));
typedef GAS unsigned gu32;
#define RLX_AGENT __ATOMIC_RELAXED, __HIP_MEMORY_SCOPE_AGENT
#define LDS_WAIT() asm volatile("s_waitcnt lgkmcnt(0)" ::: "memory")
#define VM_WAIT() asm volatile("s_waitcnt vmcnt(0)" ::: "memory")

constexpr int D = 1024, NB = 8, SEQ = 4096, LC = 256, DEPTH = 4;
constexpr int RL = NB * SEQ;
constexpr int RC = NB * LC;
constexpr int RT = RL + RC;
constexpr int NCH = 34;
constexpr int EVEN_IN = 2560, ODD_IN = 1536;
constexpr int NE = 16;
constexpr float EPS = 1e-6f;
constexpr int MAXSLOT = 73728;

__device__ __forceinline__ unsigned cvt_pk_bf16(float lo, float hi) { unsigned r; asm volatile("v_cvt_pk_bf16_f32 %0, %1, %2" : "=v"(r) : "v"(lo), "v"(hi)); return r; }
__device__ __forceinline__ float bf_lo(unsigned w) { return __uint_as_float(w << 16); }
__device__ __forceinline__ float bf_hi(unsigned w) { return __uint_as_float(w & 0xffff0000u); }
__device__ __forceinline__ float bf2f(unsigned short h) { return __uint_as_float(((unsigned)h) << 16); }
__device__ __forceinline__ unsigned short f2bf(float f) { return (unsigned short)(cvt_pk_bf16(f, 0.f) & 0xffffu); }
__device__ __forceinline__ float gelu_tanh(float x) { const float u = x + 0.044715f * x * x * x; return x * __builtin_amdgcn_rcpf(1.0f + __builtin_amdgcn_exp2f(-2.302208198f * u)); }
__device__ __forceinline__ float silu_f(float x) { return x * __builtin_amdgcn_rcpf(1.0f + __builtin_amdgcn_exp2f(-1.4426950409f * x)); }
__device__ __forceinline__ float fexp2(float x) { return __builtin_amdgcn_exp2f(x); }
__device__ __forceinline__ float fexp(float x) { return __builtin_amdgcn_exp2f(x * 1.4426950409f); }
__device__ __forceinline__ float frsq(float x) { return __builtin_amdgcn_rsqf(x); }
__device__ __forceinline__ float dpp_f(float v, const int ctrl_b1, const int sel) {
    const int x = __float_as_int(v);
    const int y = sel == 0 ? __builtin_amdgcn_mov_dpp(x, 0xB1, 0xf, 0xf, true) : sel == 1 ? __builtin_amdgcn_mov_dpp(x, 0x4E, 0xf, 0xf, true) : sel == 2 ? __builtin_amdgcn_mov_dpp(x, 0x141, 0xf, 0xf, true) : __builtin_amdgcn_mov_dpp(x, 0x140, 0xf, 0xf, true);
    return __int_as_float(y);
}
__device__ __forceinline__ float row_sum16(float v) { v += dpp_f(v, 0, 0); v += dpp_f(v, 0, 1); v += dpp_f(v, 0, 2); v += dpp_f(v, 0, 3); return v; }
__device__ __forceinline__ float wave_sum(float v, int) {
    v = row_sum16(v);
    const int x = __float_as_int(v);
    return (__int_as_float(__builtin_amdgcn_readlane(x, 0)) + __int_as_float(__builtin_amdgcn_readlane(x, 16))) + (__int_as_float(__builtin_amdgcn_readlane(x, 32)) + __int_as_float(__builtin_amdgcn_readlane(x, 48)));
}
__device__ __forceinline__ float col_sum4(float v) {
    { auto r = __builtin_amdgcn_permlane16_swap(__float_as_uint(v), __float_as_uint(v), false, false); v = __uint_as_float(r[0]) + __uint_as_float(r[1]); }
    { auto r = __builtin_amdgcn_permlane32_swap(__float_as_uint(v), __float_as_uint(v), false, false); v = __uint_as_float(r[0]) + __uint_as_float(r[1]); }
    return v;
}

namespace pg8 {
typedef unsigned short bf16_t;
constexpr int BM = 256, BK = 64, HALF = 128, HTB = HALF * BK * 2, STAGE_BYTES = 8 * HTB, NXCD = 8, WGM = 8, KD = 1024;

__host__ __device__ __forceinline__ int lds_byte(int r, int c) { const int st = (r >> 4) * 2 + (c >> 5), rr = r & 15, cc = c & 31, ob = rr * 64 + cc * 2; return st * 1024 + (ob ^ (((ob >> 9) & 1) << 5)); }
__host__ __device__ __forceinline__ void stage_rc(int b, int& R, int& C) { const int st = b / 1024, sb = b % 1024, swz = sb ^ (((sb >> 9) & 1) << 5); R = (st >> 1) * 16 + swz / 64; C = (st & 1) * 32 + (swz % 64) / 2; }
__host__ __device__ __forceinline__ int perm32(int rho) { const int n = rho >> 4, i = rho & 15; return 8 * (i >> 2) + 4 * n + (i & 3); }

struct Unit { int pm, pn, e, nvalid; const int* gidx; };
typedef int i32x8 __attribute__((ext_vector_type(8)));
typedef int i32x4 __attribute__((ext_vector_type(4)));
typedef i32x8 Frag;
__device__ __forceinline__ bf16x8 frag_half(const Frag& f, int k) { const i32x4 q = k ? __builtin_shufflevector(f, f, 4, 5, 6, 7) : __builtin_shufflevector(f, f, 0, 1, 2, 3); return __builtin_bit_cast(bf16x8, q); }
struct Gemm { const bf16_t* A; const bf16_t* Bt; size_t bstride; };

struct StaticOrder {
    int nM, nN, nwg, G, c;
    __device__ void init(int M, int N, int G_, int c_) { nM = M / BM; nN = N / BM; nwg = nM * nN; G = G_; c = c_; }
    __device__ bool next(int i, Unit& u) const {
        const long L = (long)i * G + c; if (L >= nwg) return false;
        int wgid = (int)L; { const int q = nwg / NXCD, r = nwg % NXCD, xcd = wgid % NXCD, off = wgid / NXCD; wgid = (xcd < r ? xcd * (q + 1) : r * (q + 1) + (xcd - r) * q) + off; }
        const int nig = WGM * nN, gid = wgid / nig, fm = gid * WGM, gsz = (nM - fm) < WGM ? (nM - fm) : WGM;
        u.pm = fm + ((wgid % nig) % gsz); u.pn = (wgid % nig) / gsz; u.e = 0; u.nvalid = 256; u.gidx = nullptr; return true;
    }
};
struct MoeOrder {
    const LAS int* tab; const int* lists; int npn, G, c, nwg;
    __device__ void init(const LAS int* tab_, const int* lists_, int npn_, int G_, int c_) { tab = tab_; lists = lists_; npn = npn_; G = G_; c = c_; nwg = tab_[16] * npn_; }
    __device__ bool next(int i, Unit& u) const {
        const long L = (long)i * G + c; if (L >= nwg) return false;
        int wgid = (int)L; { const int q = nwg / NXCD, r = nwg % NXCD, xcd = wgid % NXCD, off = wgid / NXCD; wgid = (xcd < r ? xcd * (q + 1) : r * (q + 1) + (xcd - r) * q) + off; }
        int e = 0;
#pragma unroll 1
        for (int k = 1; k < 16; ++k) if (wgid >= tab[k] * npn) e = k;
        const int t0 = tab[e], loc = wgid - t0 * npn, mt = loc / npn;
        u.pm = t0 + mt; u.pn = loc - mt * npn; u.e = e; u.nvalid = tab[32 + e] - mt * 256; u.gidx = lists + (size_t)e * RT + mt * 256; return true;
    }
};

template <class Epi, class Sched, bool ALIGN_EPI, bool GATHER, bool FP8, bool ATILED = false>
__device__ __forceinline__ void gemm_phase(LAS unsigned char* lds, const Gemm g, const Sched& S, const Epi& E, const int tid) {
    const int wid = __builtin_amdgcn_readfirstlane(tid >> 6), lane = tid & 63, wr = wid >> 2, wc = wid & 3, fr = lane & 15, fq = lane >> 4;
    constexpr int ROWB = FP8 ? 1024 : 2048, nt = ROWB / 128;
    unsigned voffA[2], voffB[2]; int RA[2]; unsigned CA2[2];
#pragma unroll
    for (int i = 0; i < 2; ++i) { int R, C; stage_rc(tid * 16 + i * 8192, R, C); const int Rb = Epi::PERM ? ((R & ~31) + perm32(R & 31)) : R;
        voffA[i] = (unsigned)(R * (ATILED ? 128 : ROWB) + C * 2); voffB[i] = (unsigned)(Rb * ROWB + C * 2); RA[i] = R; CA2[i] = (unsigned)C * 2u; }
    const size_t kstep = (size_t)(BK * 2);
    const size_t hstep = (size_t)HALF * ROWB;
    const size_t kstepA = ATILED ? (size_t)32768 : kstep, hstepA = ATILED ? (size_t)16384 : hstep;
    const size_t tstep = 2 * hstep;
    const unsigned ldsw = (unsigned)wid * 1024u;
    const int aoff = lds_byte(wr * 64 + fr, fq * 8), boff = lds_byte(wc * 32 + fr, fq * 8);
#define PG8_SA(b, h) (((b) * 2 + (h)) * HTB)
#define PG8_SB(b, h) ((4 + (b) * 2 + (h)) * HTB)
#define PG8_STAGE(bufoff, gbase, voff) do { _Pragma("unroll") for (int _i = 0; _i < 2; ++_i) \
        __builtin_amdgcn_global_load_lds((const unsigned*)((const char*)(gbase) + (voff)[_i]), (LAS unsigned*)(lds + (bufoff) + ldsw + _i * 8192), 16, 0, 0); } while (0)
#define PG8_STA(bufoff, kptr, H, VG) do { if constexpr (GATHER) { PG8_STAGE(bufoff, kptr, VG[H]); } else { PG8_STAGE(bufoff, (kptr) + (H) * hstepA, voffA); } } while (0)
#define PG8_LDA(dst, b, h) do { _Pragma("unroll") for (int m = 0; m < 4; ++m) dst[m] = __builtin_shufflevector(*(const LAS i32x4*)(lds + PG8_SA(b, h) + aoff + m * 2048), *(const LAS i32x4*)(lds + PG8_SA(b, h) + aoff + m * 2048 + 1024), 0, 1, 2, 3, 4, 5, 6, 7); } while (0)
#define PG8_LDB(dst, b, h) do { _Pragma("unroll") for (int n = 0; n < 2; ++n) dst[n] = __builtin_shufflevector(*(const LAS i32x4*)(lds + PG8_SB(b, h) + boff + n * 2048), *(const LAS i32x4*)(lds + PG8_SB(b, h) + boff + n * 2048 + 1024), 0, 1, 2, 3, 4, 5, 6, 7); } while (0)
#define PG8_MMA(ai, bj, At, Bt) do { __builtin_amdgcn_s_setprio(1); _Pragma("unroll") for (int m = 0; m < 4; ++m) _Pragma("unroll") for (int n = 0; n < 2; ++n) { \
        if constexpr (FP8) asm volatile("v_mfma_scale_f32_16x16x128_f8f6f4 %0, %1, %2, %0, %3, %3 op_sel_hi:[0,0,0]" : "+v"(acc[ai][bj][m][n]) : "v"(Bt[n]), "v"(At[m]), "v"(sc1)); \
        else { _Pragma("unroll") for (int k = 0; k < 2; ++k) acc[ai][bj][m][n] = __builtin_amdgcn_mfma_f32_16x16x32_bf16(frag_half(Bt[n], k), frag_half(At[m], k), acc[ai][bj][m][n], 0, 0, 0); } } \
        __builtin_amdgcn_s_setprio(0); } while (0)
#define PG8_WAIT_V(n) asm volatile("s_waitcnt vmcnt(" #n ")" ::: "memory")
#define PG8_WAIT_L(n) asm volatile("s_waitcnt lgkmcnt(" #n ")" ::: "memory")
#define PG8_BAR __builtin_amdgcn_s_barrier()
#define PG8_SCHED __builtin_amdgcn_sched_barrier(0)
#define PG8_GLOAD(U, TK) do { _Pragma("unroll") for (int _h = 0; _h < 2; ++_h) _Pragma("unroll") for (int _i = 0; _i < 2; ++_i) { const int _r = _h * HALF + RA[_i]; \
        const int _rc = _r < (U).nvalid ? _r : (U).nvalid - 1; TK[_h][_i] = (U).gidx[_rc]; } } while (0)
#define PG8_GADDR(TK, VG) do { _Pragma("unroll") for (int _h = 0; _h < 2; ++_h) _Pragma("unroll") for (int _i = 0; _i < 2; ++_i) VG[_h][_i] = (unsigned)TK[_h][_i] * (unsigned)ROWB + CA2[_i]; } while (0)
    Unit cur, nxt; int ui = 0;
    if (!S.next(0, cur)) return;
    f32x4 acc[2][2][4][2];
#pragma unroll
    for (int a = 0; a < 2; ++a)
#pragma unroll
        for (int b = 0; b < 2; ++b)
#pragma unroll
            for (int m = 0; m < 4; ++m)
#pragma unroll
                for (int n = 0; n < 2; ++n) acc[a][b][m][n] = (f32x4){0.f, 0.f, 0.f, 0.f};
    Frag At[4], B0[2], B1[2];
    const int sc1 = 0x7f7f7f7f;
    unsigned vgc[2][2] = {{0u, 0u}, {0u, 0u}}, vgn[2][2] = {{0u, 0u}, {0u, 0u}};
    int tkn[2][2] = {{0, 0}, {0, 0}};
    if constexpr (GATHER) { PG8_GLOAD(cur, tkn); PG8_GADDR(tkn, vgc); }
    const char* cA = GATHER ? (const char*)g.A : (const char*)g.A + (size_t)cur.pm * tstep;
    const char* cB = (const char*)g.Bt + (size_t)cur.e * g.bstride + (size_t)cur.pn * tstep;
    PG8_STAGE(PG8_SB(0, 0), cB, voffB); PG8_STAGE(PG8_SB(0, 1), cB + hstep, voffB); PG8_STA(PG8_SA(0, 0), cA, 0, vgc); PG8_STA(PG8_SA(0, 1), cA, 1, vgc);
    if (wr == 1) PG8_BAR;
    PG8_WAIT_V(2); PG8_BAR;
    PG8_STAGE(PG8_SB(1, 0), cB + kstep, voffB); PG8_STA(PG8_SA(1, 0), cA + kstepA, 0, vgc); PG8_STAGE(PG8_SB(1, 1), cB + hstep + kstep, voffB);
    PG8_WAIT_V(6); PG8_BAR;
    for (;;) {
        const bool has_next = S.next(ui + 1, nxt);
        if constexpr (GATHER) { if (has_next) { PG8_GLOAD(nxt, tkn); } }
        const char* nA = GATHER ? (const char*)g.A : (has_next ? (const char*)g.A + (size_t)nxt.pm * tstep : cA);
        const char* nB = has_next ? (const char*)g.Bt + (size_t)nxt.e * g.bstride + (size_t)nxt.pn * tstep : cB;
#pragma unroll 1
        for (int t = 0; t < nt; t += 2) {
            const bool last = (t == nt - 2);
            const char* a1 = cA + (size_t)(t + 1) * kstepA;
            const char* a2 = last ? nA : cA + (size_t)(t + 2) * kstepA; const char* b2 = last ? nB : cB + (size_t)(t + 2) * kstep;
            const char* a3 = a2 + kstepA; const char* b3 = b2 + kstep;
            unsigned va2[2][2] = {{vgc[0][0], vgc[0][1]}, {vgc[1][0], vgc[1][1]}};
            if constexpr (GATHER) { if (last && has_next) { asm volatile("" : "+v"(tkn[0][0]), "+v"(tkn[0][1]), "+v"(tkn[1][0]), "+v"(tkn[1][1])); PG8_GADDR(tkn, vgn);
                va2[0][0] = vgn[0][0]; va2[0][1] = vgn[0][1]; va2[1][0] = vgn[1][0]; va2[1][1] = vgn[1][1]; } }
            PG8_LDB(B0, 0, 0); PG8_LDB(B1, 0, 1); PG8_SCHED; PG8_LDA(At, 0, 0); PG8_STA(PG8_SA(1, 1), a1, 1, vgc);
            PG8_WAIT_V(8); PG8_WAIT_L(0); PG8_BAR; PG8_MMA(0, 0, At, B0); PG8_MMA(0, 1, At, B1); PG8_BAR; PG8_SCHED;
            PG8_LDA(At, 0, 1); PG8_STAGE(PG8_SB(0, 0), b2, voffB); PG8_STAGE(PG8_SB(0, 1), b2 + hstep, voffB); PG8_STA(PG8_SA(0, 0), a2, 0, va2);
            PG8_WAIT_V(8); PG8_WAIT_L(0); PG8_BAR; PG8_MMA(1, 0, At, B0); PG8_MMA(1, 1, At, B1); PG8_BAR; PG8_SCHED;
            PG8_LDB(B0, 1, 0); PG8_LDB(B1, 1, 1); PG8_SCHED; PG8_LDA(At, 1, 0); PG8_STA(PG8_SA(0, 1), a2, 1, va2);
            PG8_WAIT_V(8); PG8_WAIT_L(0); PG8_BAR; PG8_MMA(0, 0, At, B0); PG8_MMA(0, 1, At, B1); PG8_BAR; PG8_SCHED;
            PG8_LDA(At, 1, 1); PG8_STAGE(PG8_SB(1, 0), b3, voffB); PG8_STAGE(PG8_SB(1, 1), b3 + hstep, voffB); PG8_STA(PG8_SA(1, 0), a3, 0, va2);
            PG8_WAIT_V(8); PG8_WAIT_L(0); PG8_BAR; PG8_MMA(1, 0, At, B0); PG8_MMA(1, 1, At, B1); PG8_BAR; PG8_SCHED;
        }
        if constexpr (ALIGN_EPI) { if (wr == 0) PG8_BAR; }
        if constexpr (FP8) asm volatile("s_nop 15\n\ts_nop 15" ::: "memory");
        E(acc, cur, wr, wc, fr, fq);
        if (!has_next) break;
#pragma unroll
        for (int a = 0; a < 2; ++a)
#pragma unroll
            for (int b = 0; b < 2; ++b)
#pragma unroll
                for (int m = 0; m < 4; ++m)
#pragma unroll
                    for (int n = 0; n < 2; ++n) acc[a][b][m][n] = (f32x4){0.f, 0.f, 0.f, 0.f};
        cur = nxt; cA = nA; cB = nB; ++ui;
        if constexpr (GATHER) {
#pragma unroll
            for (int h = 0; h < 2; ++h)
#pragma unroll
                for (int i = 0; i < 2; ++i) vgc[h][i] = vgn[h][i]; }
        if constexpr (ALIGN_EPI) { if (wr == 1) PG8_BAR; }
    }
    PG8_WAIT_V(0);
    if constexpr (!ALIGN_EPI) { if (wr == 0) PG8_BAR; }
    PG8_BAR;
#undef PG8_SA
#undef PG8_SB
#undef PG8_STAGE
#undef PG8_STA
#undef PG8_LDA
#undef PG8_LDB
#undef PG8_MMA
#undef PG8_WAIT_V
#undef PG8_WAIT_L
#undef PG8_BAR
#undef PG8_SCHED
#undef PG8_GLOAD
#undef PG8_GADDR
}
}
#define XB_TMO      128
#define XB_XCNT(j)  (256  + 64 * (j))
#define XB_XSUB(j)  (1280 + 64 * (j))
#define XB_XGEN(j)  (2304 + 64 * (j))
#define XB_TOP      3328
#define XB_TOPGEN   3392
#define XCD_BAR_WORDS 3456
#define XB_SPIN_CAP (1u << 22)

__device__ __forceinline__ unsigned xb_ld(unsigned* p)              { return __hip_atomic_load(p, __ATOMIC_RELAXED, __HIP_MEMORY_SCOPE_AGENT); }
__device__ __forceinline__ unsigned xb_add(unsigned* p, unsigned v) { return __hip_atomic_fetch_add(p, v, __ATOMIC_RELAXED, __HIP_MEMORY_SCOPE_AGENT); }
__device__ __forceinline__ unsigned xb_xcc_id() { return (unsigned)__builtin_amdgcn_s_getreg((3 << 11) | 20) & 0xFu; }
#define XB_SPIN(cond, bar) do { unsigned _sp = 0; while (cond) { __builtin_amdgcn_s_sleep(1); \
    if ((++_sp & 255u) == 0u) { if (xb_ld(&(bar)[XB_TMO])) break; if (_sp > XB_SPIN_CAP) { atomicAdd(&(bar)[XB_TMO], 1u); break; } } } } while (0)

struct XcdBarrier {
    unsigned* bar; unsigned x;
    volatile LAS unsigned* st;
};

__device__ __forceinline__ XcdBarrier xcd_barrier_post(unsigned* bar, volatile LAS unsigned* st) {
    XcdBarrier b; b.bar = bar; b.x = xb_xcc_id(); b.st = st;
    if (threadIdx.x == 0) (void)xb_add(&bar[XB_XCNT(b.x)], 1u);
    return b;
}
__device__ __forceinline__ void xcd_barrier_complete(unsigned* bar, unsigned x, unsigned& nloc, unsigned& nx) {
    const unsigned G = gridDim.x * gridDim.y * gridDim.z;
    unsigned sum, cnt, mine, sp = 0u;
    for (;;) {
        sum = 0u; cnt = 0u; mine = 0u;
#pragma unroll
        for (unsigned j = 0; j < 16; ++j) { const unsigned c = xb_ld(&bar[XB_XCNT(j)]); sum += c; cnt += (c > 0u) ? 1u : 0u; mine = (j == x) ? c : mine; }
        if (sum == G) break;
        __builtin_amdgcn_s_sleep(1);
        if ((++sp & 255u) == 0u) { if (xb_ld(&bar[XB_TMO])) break; if (sp > XB_SPIN_CAP) { atomicAdd(&bar[XB_TMO], 1u); break; } }
    }
    nloc = mine > 0u ? mine : 1u; nx = cnt > 0u ? cnt : 1u;
}

__device__ __forceinline__ void xcd_barrier(const XcdBarrier& b) {
    asm volatile("s_waitcnt vmcnt(0)" ::: "memory");
    __syncthreads();
    if (threadIdx.x == 0) {
        unsigned* bar = b.bar; unsigned bxx = b.x; asm volatile("" : "+s"(bxx), "+s"(bar));
        __builtin_amdgcn_s_waitcnt(0);
        unsigned nloc = b.st[0], nx = b.st[1];
        if (nloc == 0u) { xcd_barrier_complete(bar, bxx, nloc, nx); b.st[0] = nloc; b.st[1] = nx; }
        const unsigned old = xb_add(&bar[XB_XSUB(bxx)], 1u);
        const unsigned gen = old / nloc;
        if (old + 1u == (gen + 1u) * nloc) {
            __builtin_amdgcn_fence(__ATOMIC_RELEASE, "agent");
            asm volatile("s_waitcnt vmcnt(0)" ::: "memory");
            const unsigned og = xb_add(&bar[XB_TOP], 1u);
            const unsigned tg = og / nx;
            if (og + 1u == (tg + 1u) * nx) xb_add(&bar[XB_TOPGEN], 1u);
            else XB_SPIN(xb_ld(&bar[XB_TOPGEN]) == tg, bar);
            __builtin_amdgcn_fence(__ATOMIC_ACQUIRE, "agent");
            xb_add(&bar[XB_XGEN(bxx)], 1u);
            asm volatile("s_waitcnt vmcnt(0)" ::: "memory");
        } else {
            XB_SPIN(xb_ld(&bar[XB_XGEN(bxx)]) == gen, bar);
            __builtin_amdgcn_fence(__ATOMIC_ACQUIRE, "agent");
            asm volatile("s_waitcnt vmcnt(0)" ::: "memory");
        }
    }
    __syncthreads();
}

constexpr size_t MiB = 1u << 20;
constexpr size_t WS_CTL = 0, CTL_ZERO_BYTES = 1 * MiB;
constexpr size_t WS_MOD = 1 * MiB;
constexpr size_t WS_ROPE = 2 * MiB;
constexpr size_t WS_SGW = 2 * MiB + 65536;
constexpr size_t WS_TOK = 3 * MiB;
constexpr size_t WS_STATS = 3 * MiB + 655360;
constexpr size_t WS_LIST = 4 * MiB;
constexpr size_t WS_W1T = 8 * MiB;
constexpr size_t WS_W2T = 264 * MiB;
constexpr size_t WS_WIN = 392 * MiB;
constexpr size_t WS_WOUT = 402 * MiB;
constexpr size_t WS_WQKV = 406 * MiB;
constexpr size_t WS_WO = 412 * MiB;
constexpr size_t WS_X = 416 * MiB;
constexpr size_t WS_H = 552 * MiB;
constexpr size_t WS_BIG = 620 * MiB;
constexpr size_t WS_MIX = 790 * MiB;
constexpr size_t WS_C = 858 * MiB;
constexpr size_t WS_END = 1002 * MiB;
constexpr size_t BIG_K = 68 * MiB, BIG_V = 85 * MiB, C_ST = 68 * MiB;
constexpr int CW_TMO = 0, CW_BAR = 4096, CW_CNT = 8192;

constexpr int RING_BYTES = 131072, MISC_OFF = RING_BYTES, LDS_BYTES = 147456;
constexpr int NWAVES = 8;

struct Frame {
    LAS unsigned char* lds; char* ldsg;
    volatile LAS unsigned* MISC;
    unsigned* ctl;
    int tid, lane, wave, vcu, G, bx;
    const float *x_in, *c_in, *ctx_in, *cctx_in, *w_mod, *b_mod, *norm_g, *w_in_even, *w_out_even, *ret_ld, *ret_gn, *sg_ln_g, *sg_ln_b, *sg_w, *sg_b,
                *w_qkv, *w_o, *sink, *w_router, *b_router, *w_eg, *w_eu, *w_ed, *final_g;
    float* out;
    float *MOD, *ROPE, *KV; f32x2* STATS;
    bf16 *X, *SGW, *W1T, *W2T, *WIN, *WOUT, *WQKV, *WO, *H, *BIG, *MIX, *CS, *ST;
    v4u* TOK; int* LIST;
};

using pg8::Unit;
__device__ __forceinline__ unsigned cvt4_fp8(float a, float b, float c, float d) { int w = 0; w = __builtin_amdgcn_cvt_pk_fp8_f32(a, b, w, false); w = __builtin_amdgcn_cvt_pk_fp8_f32(c, d, w, true); return (unsigned)w; }
__device__ __forceinline__ float clamp448(float x) { return __builtin_amdgcn_fmed3f(x, -448.f, 448.f); }
constexpr bool IN8 = true, QKV8 = true;
constexpr float W8_SCALE = 32.f, W8_INV = 1.f / 32.f;
constexpr float ACT8_SCALE = 4.f, ACT8_INV = 0.25f;
struct EpiIn {
    static constexpr bool PERM = true;
    bf16* O;
    __device__ __forceinline__ void operator()(const f32x4 (&acc)[2][2][4][2], const Unit& u, int wr, int wc, int fr, int fq) const {
        const int row0 = u.pm * 256 + wr * 64 + fr, col0 = u.pn * 256 + wc * 32 + 8 * fq;
        const int mode = (u.pn == 1) ? 1 : (u.pn >= 6 ? 2 : 0);
#pragma unroll
        for (int ai = 0; ai < 2; ++ai)
#pragma unroll
            for (int m = 0; m < 4; ++m) { bf16* rowp = O + (size_t)(row0 + ai * 128 + m * 16) * EVEN_IN + col0;
#pragma unroll
                for (int bj = 0; bj < 2; ++bj) { f32x4 v0 = acc[ai][bj][m][0] * (IN8 ? W8_INV : 1.f), v1 = acc[ai][bj][m][1] * (IN8 ? W8_INV : 1.f);
                    if (mode == 1) { v0 = v0 * 0.125f; v1 = v1 * 0.125f; }
                    if (mode == 2) {
#pragma unroll
                        for (int j = 0; j < 4; ++j) { v0[j] = gelu_tanh(v0[j]); v1[j] = gelu_tanh(v1[j]); } }
                    v4u w; w.x = cvt_pk_bf16(v0[0], v0[1]); w.y = cvt_pk_bf16(v0[2], v0[3]); w.z = cvt_pk_bf16(v1[0], v1[1]); w.w = cvt_pk_bf16(v1[2], v1[3]);
                    *(v4u*)(rowp + bj * 128) = w; } }
    }
};
struct EpiRes {
    static constexpr bool PERM = true;
    const float* xlat; const float* xctx; bf16* X; const float* modl;
    __device__ __forceinline__ void operator()(const f32x4 (&acc)[2][2][4][2], const Unit& u, int wr, int wc, int fr, int fq) const {
        const int row0 = u.pm * 256 + wr * 64 + fr, col0 = u.pn * 256 + wc * 32 + 8 * fq;
        const bool lat = u.pm < (RL / 256); const int bb = lat ? (u.pm >> 4) : 8;
        const float* gp = modl + bb * 6144 + 2 * 1024 + col0;
        f32x4 gv[2][2];
#pragma unroll
        for (int bj = 0; bj < 2; ++bj)
#pragma unroll
            for (int n = 0; n < 2; ++n) gv[bj][n] = *(const f32x4*)(gp + bj * 128 + n * 4);
#pragma unroll
        for (int ai = 0; ai < 2; ++ai) {
            f32x4 x0[4][2], x1[4][2];
#pragma unroll
            for (int m = 0; m < 4; ++m) { const int r = row0 + ai * 128 + m * 16; const bf16* xo = X + (size_t)r * D + col0;
#pragma unroll
                for (int bj = 0; bj < 2; ++bj) {
                    if (xlat) { const float* xi = (lat ? xlat + (size_t)r * D : xctx + (size_t)(r - RL) * D) + col0 + bj * 128; x0[m][bj] = *(const f32x4*)xi; x1[m][bj] = *(const f32x4*)(xi + 4); }
                    else { const v4u xw = *(const v4u*)(xo + bj * 128); x0[m][bj] = (f32x4){bf_lo(xw.x), bf_hi(xw.x), bf_lo(xw.y), bf_hi(xw.y)}; x1[m][bj] = (f32x4){bf_lo(xw.z), bf_hi(xw.z), bf_lo(xw.w), bf_hi(xw.w)}; } } }
#pragma unroll
            for (int m = 0; m < 4; ++m) { const int r = row0 + ai * 128 + m * 16; bf16* xo = X + (size_t)r * D + col0;
#pragma unroll
                for (int bj = 0; bj < 2; ++bj) {
                    const f32x4 v0 = x0[m][bj] + gv[bj][0] * acc[ai][bj][m][0], v1 = x1[m][bj] + gv[bj][1] * acc[ai][bj][m][1];
                    v4u w; w.x = cvt_pk_bf16(v0[0], v0[1]); w.y = cvt_pk_bf16(v0[2], v0[3]); w.z = cvt_pk_bf16(v1[0], v1[1]); w.w = cvt_pk_bf16(v1[2], v1[3]);
                    *(v4u*)(xo + bj * 128) = w; } }
        }
    }
};
struct EpiQKV {
    static constexpr bool PERM = true;
    bf16 *Q, *K, *V; const float* rope;
    __device__ __forceinline__ void operator()(const f32x4 (&acc)[2][2][4][2], const Unit& u, int wr, int wc, int fr, int fq) const {
        const int row0 = u.pm * 256 + wr * 64 + fr; const int cin = wc * 32 + 8 * fq;
        const bool lat = u.pm < (RL / 256); const bool dorope = lat && (u.pn < 5);
        bf16* base; int ld;
        if (u.pn < 4) { base = Q + u.pn * 256; ld = 1024; } else if (u.pn == 4) { base = K; ld = 256; } else { base = V; ld = 256; }
        const int half = (cin >> 6) & 1, i0 = (cin & 63) >> 1;
#pragma unroll
        for (int ai = 0; ai < 2; ++ai)
#pragma unroll
            for (int m = 0; m < 4; ++m) { const int r = row0 + ai * 128 + m * 16; bf16* rowp = base + (size_t)r * ld + cin;
                f32x4 cs0 = {1.f, 0.f, 1.f, 0.f}, cs1 = {1.f, 0.f, 1.f, 0.f};
                if (dorope) { const int t = r & (SEQ - 1); const int pos = half ? (t & 63) : (t >> 6); const float* tp = rope + (size_t)(pos * 32 + i0) * 2; cs0 = *(const f32x4*)tp; cs1 = *(const f32x4*)(tp + 4); }
#pragma unroll
                for (int bj = 0; bj < 2; ++bj) { const f32x4 v0 = acc[ai][bj][m][0] * (QKV8 ? W8_INV : 1.f), v1 = acc[ai][bj][m][1] * (QKV8 ? W8_INV : 1.f);
                    const float a0 = v0[0] * cs0[0] - v0[1] * cs0[1], a1 = v0[1] * cs0[0] + v0[0] * cs0[1];
                    const float a2 = v0[2] * cs0[2] - v0[3] * cs0[3], a3 = v0[3] * cs0[2] + v0[2] * cs0[3];
                    const float a4 = v1[0] * cs1[0] - v1[1] * cs1[1], a5 = v1[1] * cs1[0] + v1[0] * cs1[1];
                    const float a6 = v1[2] * cs1[2] - v1[3] * cs1[3], a7 = v1[3] * cs1[2] + v1[2] * cs1[3];
                    v4u w; w.x = cvt_pk_bf16(a0, a1); w.y = cvt_pk_bf16(a2, a3); w.z = cvt_pk_bf16(a4, a5); w.w = cvt_pk_bf16(a6, a7);
                    *(v4u*)(rowp + bj * 128) = w; } }
    }
};
struct EpiMoe1 {
    static constexpr bool PERM = true;
    unsigned char* O;
    __device__ __forceinline__ void operator()(const f32x4 (&acc)[2][2][4][2], const Unit& u, int wr, int wc, int fr, int fq) const {
        unsigned char* const tb = O + (size_t)u.pm * 262144 + (size_t)u.pn * 32768 + (wr * 64 + fr) * 128 + wc * 32 + 8 * fq;
#pragma unroll
        for (int ai = 0; ai < 2; ++ai)
#pragma unroll
            for (int m = 0; m < 4; ++m) { unsigned char* rowp = tb + (ai * 128 + m * 16) * 128;
                const f32x4 g0 = acc[ai][0][m][0] * W8_INV, g1 = acc[ai][0][m][1] * W8_INV, u0 = acc[ai][1][m][0] * (W8_INV * ACT8_SCALE), u1 = acc[ai][1][m][1] * (W8_INV * ACT8_SCALE);
                f32x4 v0, v1;
#pragma unroll
                for (int j = 0; j < 4; ++j) { v0[j] = clamp448(silu_f(g0[j]) * u0[j]); v1[j] = clamp448(silu_f(g1[j]) * u1[j]); }
                u32x2 w; w.x = cvt4_fp8(v0[0], v0[1], v0[2], v0[3]); w.y = cvt4_fp8(v1[0], v1[1], v1[2], v1[3]);
                *(u32x2*)rowp = w; }
    }
};
struct EpiBf8 {
    static constexpr bool PERM = true;
    bf16* O;
    __device__ __forceinline__ void operator()(const f32x4 (&acc)[2][2][4][2], const Unit& u, int wr, int wc, int fr, int fq) const {
        const int row0 = u.pm * 256 + wr * 64 + fr, col0 = u.pn * 256 + wc * 32 + 8 * fq;
#pragma unroll
        for (int ai = 0; ai < 2; ++ai)
#pragma unroll
            for (int m = 0; m < 4; ++m) { bf16* rowp = O + (size_t)(row0 + ai * 128 + m * 16) * 1024 + col0;
#pragma unroll
                for (int bj = 0; bj < 2; ++bj) { const f32x4 v0 = acc[ai][bj][m][0] * (W8_INV * ACT8_INV), v1 = acc[ai][bj][m][1] * (W8_INV * ACT8_INV);
                    v4u w; w.x = cvt_pk_bf16(v0[0], v0[1]); w.y = cvt_pk_bf16(v0[2], v0[3]); w.z = cvt_pk_bf16(v1[0], v1[1]); w.w = cvt_pk_bf16(v1[2], v1[3]);
                    *(v4u*)(rowp + bj * 128) = w; } }
    }
};

template <class RowMap>
__device__ __forceinline__ void p0_transpose_item(const float* W, int N, bf16* WT, const RowMap& rm, LAS float* scr, int item, int lane) {
    const int nblk = N / 32, kb = item / nblk, nb = item % nblk, k0 = 64 * kb, n0 = 32 * nb;
#pragma unroll 8
    for (int i = 0; i < 32; ++i) { const int kk = 2 * i + (lane >> 5); scr[kk * 33 + (lane & 31)] = W[(size_t)(k0 + kk) * N + n0 + (lane & 31)]; }
    LDS_WAIT(); asm volatile("" ::: "memory");
    const int c = lane & 7;
#pragma unroll
    for (int j = 0; j < 4; ++j) { const int n = (lane >> 3) + 8 * j; const LAS float* s = scr + (8 * c) * 33 + n;
        v4u o; o.x = cvt_pk_bf16(s[0 * 33], s[1 * 33]); o.y = cvt_pk_bf16(s[2 * 33], s[3 * 33]); o.z = cvt_pk_bf16(s[4 * 33], s[5 * 33]); o.w = cvt_pk_bf16(s[6 * 33], s[7 * 33]);
        *(v4u*)(WT + (size_t)rm(n0 + n) * 1024 + k0 + 8 * c) = o; }
    LDS_WAIT(); asm volatile("" ::: "memory");
}
template <class RowMap>
__device__ __forceinline__ void p0_transpose_item8(const float* W, int N, unsigned char* WT, const RowMap& rm, LAS float* scr, int item, int lane) {
    const int nblk = N / 32, kb = item / nblk, nb = item % nblk, k0 = 64 * kb, n0 = 32 * nb;
#pragma unroll 16
    for (int i = 0; i < 32; ++i) { const int kk = 2 * i + (lane >> 5); scr[kk * 33 + (lane & 31)] = W[(size_t)(k0 + kk) * N + n0 + (lane & 31)] * W8_SCALE; }
    LDS_WAIT(); asm volatile("" ::: "memory");
    const int c = lane & 7;
#pragma unroll
    for (int j = 0; j < 4; ++j) { const int n = (lane >> 3) + 8 * j; const LAS float* s = scr + (8 * c) * 33 + n;
        u32x2 o; o.x = cvt4_fp8(s[0 * 33], s[1 * 33], s[2 * 33], s[3 * 33]); o.y = cvt4_fp8(s[4 * 33], s[5 * 33], s[6 * 33], s[7 * 33]);
        *(u32x2*)(WT + (size_t)rm(n0 + n) * 1024 + k0 + 8 * c) = o; }
    LDS_WAIT(); asm volatile("" ::: "memory");
}
struct RmId { __device__ __forceinline__ int operator()(int n) const { return n; } };
struct RmGU { int type; __device__ __forceinline__ int operator()(int n) const { return ((n >> 7) << 8) + type * 128 + (n & 127); } };
struct RmQKV { __device__ __forceinline__ int operator()(int n) const { if (n >= 1280) return n; const int ps = n & 63; return (n & ~63) + (ps < 32 ? 2 * ps : 2 * (ps - 32) + 1); } };

__device__ __forceinline__ void p0_prologue(Frame& F) {
    LAS float* scr = (LAS float*)(F.lds + F.wave * 16384);
    const int gw = F.vcu * NWAVES + F.wave, NGW = F.G * NWAVES;
    constexpr int I_E = 512, N_EXP = 4 * 3 * 16 * I_E;
    constexpr int I_IN = 16 * 80, I_SQ = 512, I_QKV = 16 * 48;
    constexpr int NITEMS = N_EXP + 2 * I_IN + 2 * I_SQ + 2 * I_QKV + 2 * I_SQ;
    for (int it = gw; it < NITEMS; it += NGW) {
        int r = it;
        if (r < N_EXP) { const int mtx = r / I_E, item = r % I_E, layer = mtx / 48, rem = mtx % 48, type = rem / 16, e = rem % 16; const size_t mo = (size_t)(layer * 16 + e) * 1048576;
            if (type == 2) p0_transpose_item8(F.w_ed + mo, 1024, (unsigned char*)F.W2T + mo, RmId{}, scr, item, F.lane);
            else p0_transpose_item8((type ? F.w_eu : F.w_eg) + mo, 1024, (unsigned char*)F.W1T + 2 * mo, RmGU{type}, scr, item, F.lane);
            continue; }
        r -= N_EXP;
        if (r < 2 * I_IN) { const int i = r / I_IN; if (IN8) p0_transpose_item8(F.w_in_even + (size_t)i * 1024 * EVEN_IN, EVEN_IN, (unsigned char*)F.WIN + (size_t)i * EVEN_IN * 1024, RmId{}, scr, r % I_IN, F.lane); else p0_transpose_item(F.w_in_even + (size_t)i * 1024 * EVEN_IN, EVEN_IN, F.WIN + (size_t)i * EVEN_IN * 1024, RmId{}, scr, r % I_IN, F.lane); continue; } r -= 2 * I_IN;
        if (r < 2 * I_SQ) { const int i = r / I_SQ; p0_transpose_item(F.w_out_even + (size_t)i * 1048576, 1024, F.WOUT + (size_t)i * 1048576, RmId{}, scr, r % I_SQ, F.lane); continue; } r -= 2 * I_SQ;
        if (r < 2 * I_QKV) { const int i = r / I_QKV; if (QKV8) p0_transpose_item8(F.w_qkv + (size_t)i * 1024 * ODD_IN, ODD_IN, (unsigned char*)F.WQKV + (size_t)i * ODD_IN * 1024, RmQKV{}, scr, r % I_QKV, F.lane); else p0_transpose_item(F.w_qkv + (size_t)i * 1024 * ODD_IN, ODD_IN, F.WQKV + (size_t)i * ODD_IN * 1024, RmQKV{}, scr, r % I_QKV, F.lane); continue; } r -= 2 * I_QKV;
        { const int i = r / I_SQ; p0_transpose_item(F.w_o + (size_t)i * 1048576, 1024, F.WO + (size_t)i * 1048576, RmId{}, scr, r % I_SQ, F.lane); }
    }
    { const int gt = F.vcu * 512 + F.tid, GT = F.G * 512;
      for (int i = gt; i < 2 * 4 * 128 * 128 / 4; i += GT) { const f32x4 v = ((const f32x4*)F.sg_w)[i]; u32x2 w; w.x = cvt_pk_bf16(v[0], v[1]); w.y = cvt_pk_bf16(v[2], v[3]); ((u32x2*)F.SGW)[i] = w; }
      for (int i = gt; i < 64 * 32; i += GT) { const int pos = i >> 5, fi = i & 31; const float inv = fexp2(-(float)fi * (13.287712379549449f / 32.0f)); const float rev = __builtin_amdgcn_fractf((float)pos * inv * 0.15915494309189535f);
          F.ROPE[2 * i] = __builtin_amdgcn_cosf(rev); F.ROPE[2 * i + 1] = __builtin_amdgcn_sinf(rev); } }
    __syncthreads();
    LAS float* sc = (LAS float*)F.lds;
    LAS float* part = (LAS float*)(F.lds + 49152);
    for (int i = F.tid; i < 9 * 1024; i += 512) { const int bb = i >> 10, k = i & 1023; const float cv = bb < 8 ? F.c_in[bb * 1024 + k] : F.cctx_in[k]; sc[k * 12 + bb] = silu_f(cv); }
    __syncthreads();
    for (int it = F.vcu; it < 4 * 96; it += F.G) {
        const int l = it / 96, n = (it % 96) * 64 + F.lane;
        float a[9];
#pragma unroll
        for (int bb = 0; bb < 9; ++bb) a[bb] = 0.f;
        const float* wp = F.w_mod + ((size_t)l * 1024 + F.wave * 128) * 6144 + n;
#pragma unroll 8
        for (int k = 0; k < 128; ++k) { const float wv = wp[(size_t)k * 6144]; const LAS float* sp = sc + (F.wave * 128 + k) * 12;
            const f32x4 s0 = *(const LAS f32x4*)sp, s1 = *(const LAS f32x4*)(sp + 4); const float s8 = sp[8];
            a[0] += s0[0] * wv; a[1] += s0[1] * wv; a[2] += s0[2] * wv; a[3] += s0[3] * wv; a[4] += s1[0] * wv; a[5] += s1[1] * wv; a[6] += s1[2] * wv; a[7] += s1[3] * wv; a[8] += s8 * wv; }
#pragma unroll
        for (int bb = 0; bb < 9; ++bb) part[(F.wave * 9 + bb) * 64 + F.lane] = a[bb];
        __syncthreads();
        for (int i = F.tid; i < 9 * 64; i += 512) { const int bb = i >> 6, ln = i & 63; float s = 0.f;
#pragma unroll
            for (int w = 0; w < 8; ++w) s += part[(w * 9 + bb) * 64 + ln];
            const int nn = (it % 96) * 64 + ln; F.MOD[((size_t)l * 9 + bb) * 6144 + nn] = s + F.b_mod[l * 6144 + nn]; }
        __syncthreads();
    }
}

template <bool COMBINE, bool ROUTE, bool FINAL, bool FIN>
__device__ __forceinline__ void norm_phase(Frame& F, int l, int nrows, int sel, bool h8) {
    const int rpb = (nrows + F.G - 1) / F.G, r0 = F.vcu * rpb, r1 = (r0 + rpb < nrows) ? r0 + rpb : nrows;
    LAS int* rinfo = (LAS int*)(F.lds + 81920);
    LAS int* lcnt = (LAS int*)(F.lds + 81920 + 12288);
    unsigned wr16[16][8];
    if (ROUTE) {
#pragma unroll
        for (int j = 0; j < 4; ++j)
#pragma unroll
            for (int q = 0; q < 4; ++q) { const char* wp = (const char*)(F.w_router + (256 * j + q) * 16); const unsigned lo_ = (unsigned)F.lane * 256u;
#pragma unroll
                for (int e4 = 0; e4 < 4; ++e4) { const f32x4 v = *(const f32x4*)(wp + (size_t)(lo_ + 16u * e4));
                    typedef _Float16 h2v __attribute__((ext_vector_type(2)));
                    const h2v p0 = {(_Float16)v[0], (_Float16)v[1]}, p1 = {(_Float16)v[2], (_Float16)v[3]};
                    wr16[j * 4 + q][2 * e4] = __builtin_bit_cast(unsigned, p0); wr16[j * 4 + q][2 * e4 + 1] = __builtin_bit_cast(unsigned, p1); }
                if (q == 3) asm volatile("" ::: "memory"); }
        if (F.tid < 16) lcnt[F.tid] = 0;
    }
    if (COMBINE) { if (F.tid == 0) { int s = 0;
#pragma unroll 1
        for (int e = 0; e < 16; ++e) { lcnt[32 + e] = s; const int cn = (int)__hip_atomic_load(F.ctl + CW_CNT + 64 * (l - 1) + e, RLX_AGENT); s += ((cn + 255) >> 8) << 8; } } }
    __syncthreads();
    const int cnt = (r1 - r0 - F.wave + 7) >> 3;
    typedef typename std::conditional<FIN, f32x4, u32x2>::type XR;
#define NP_ROW(i) ({ int _r = r0 + F.wave + 8 * (i); _r < r1 ? _r : r1 - 1; })
#define NP_LOAD_TK(dst, i) do { if constexpr (COMBINE) dst = F.TOK[NP_ROW(i)]; } while (0)
#define NP_LOAD_ROW(XQ_, O0, O1, TK, i) do { const int _rr = NP_ROW(i); \
        if constexpr (FIN) { const float* _xr = _rr < RL ? F.x_in + (size_t)_rr * D : F.ctx_in + (size_t)(_rr - RL) * D; \
            _Pragma("unroll") for (int j = 0; j < 4; ++j) XQ_[j] = ((const XR*)_xr)[F.lane + 64 * j]; } \
        else { _Pragma("unroll") for (int j = 0; j < 4; ++j) XQ_[j] = ((const XR*)(F.X + (size_t)_rr * D))[F.lane + 64 * j]; } \
        if constexpr (COMBINE) { const int _s0 = lcnt[32 + (TK.x & 15)] + (int)(TK.x >> 4), _s1 = lcnt[32 + (TK.y & 15)] + (int)(TK.y >> 4); \
            const u32x2* _o0 = (const u32x2*)(F.CS + (size_t)_s0 * 1024); const u32x2* _o1 = (const u32x2*)(F.CS + (size_t)_s1 * 1024); \
            _Pragma("unroll") for (int j = 0; j < 4; ++j) { O0[j] = _o0[F.lane + 64 * j]; O1[j] = _o1[F.lane + 64 * j]; } } } while (0)
    if (cnt > 0) {
        v4u tkA = {0u, 0u, 0u, 0u}, tkB = tkA; XR xa[4], xn[4]; u32x2 oa0[4], oa1[4], on0[4], on1[4];
#pragma unroll
        for (int j = 0; j < 4; ++j) { oa0[j] = (u32x2){0u, 0u}; oa1[j] = oa0[j]; on0[j] = oa0[j]; on1[j] = oa0[j]; }
        NP_LOAD_TK(tkA, 0); NP_LOAD_TK(tkB, 1);
        NP_LOAD_ROW(xa, oa0, oa1, tkA, 0);
#pragma unroll 1
        for (int i = 0; i < cnt; ++i) {
            const int r = r0 + F.wave + 8 * i;
            v4u tkC = tkB; NP_LOAD_TK(tkC, i + 2);
            NP_LOAD_ROW(xn, on0, on1, tkB, i + 1);
            const int bb = r < RL ? (r >> 12) : 8;
            f32x4 v[4];
#pragma unroll
            for (int j = 0; j < 4; ++j) { if constexpr (FIN) v[j] = xa[j]; else v[j] = (f32x4){bf_lo(xa[j].x), bf_hi(xa[j].x), bf_lo(xa[j].y), bf_hi(xa[j].y)}; }
            if (COMBINE) {
                const float w0 = __uint_as_float(tkA.z), w1 = __uint_as_float(tkA.w);
                const float* g2 = F.MOD + ((size_t)(l - 1) * 9 + bb) * 6144 + 5 * 1024;
#pragma unroll
                for (int j = 0; j < 4; ++j) { const u32x2 a = oa0[j], b = oa1[j]; const f32x4 gg = ((const f32x4*)g2)[F.lane + 64 * j];
                    v[j][0] += gg[0] * (w0 * bf_lo(a.x) + w1 * bf_lo(b.x)); v[j][1] += gg[1] * (w0 * bf_hi(a.x) + w1 * bf_hi(b.x));
                    v[j][2] += gg[2] * (w0 * bf_lo(a.y) + w1 * bf_lo(b.y)); v[j][3] += gg[3] * (w0 * bf_hi(a.y) + w1 * bf_hi(b.y)); }
                if (!FINAL) {
#pragma unroll
                    for (int j = 0; j < 4; ++j) { u32x2 w; w.x = cvt_pk_bf16(v[j][0], v[j][1]); w.y = cvt_pk_bf16(v[j][2], v[j][3]); ((u32x2*)(F.X + (size_t)r * D))[F.lane + 64 * j] = w; } }
            }
            float ss = 0.f;
#pragma unroll
            for (int j = 0; j < 4; ++j) ss += (v[j][0] * v[j][0] + v[j][1] * v[j][1]) + (v[j][2] * v[j][2] + v[j][3] * v[j][3]);
            const float rstd = frsq(wave_sum(ss, F.lane) * (1.0f / D) + EPS);
            if (FINAL) {
#pragma unroll
                for (int j = 0; j < 4; ++j) { const f32x4 fg = ((const f32x4*)F.final_g)[F.lane + 64 * j]; ((f32x4*)(F.out + (size_t)r * D))[F.lane + 64 * j] = v[j] * rstd * fg; }
            } else {
                const float* ng = F.norm_g + (size_t)(l * 2 + sel) * D; const float* md = F.MOD + ((size_t)l * 9 + bb) * 6144;
                const float* shp = md + (sel ? 3 : 0) * 1024; const float* scp = md + (sel ? 4 : 1) * 1024;
                f32x4 h[4];
#pragma unroll
                for (int j = 0; j < 4; ++j) { const f32x4 g = ((const f32x4*)ng)[F.lane + 64 * j], sc = ((const f32x4*)scp)[F.lane + 64 * j], sh = ((const f32x4*)shp)[F.lane + 64 * j];
                    h[j] = v[j] * rstd * g * (sc + 1.0f) + sh;
                    if (ROUTE) asm volatile("" ::: "memory");
                    if (h8) ((unsigned*)((unsigned char*)F.H + (size_t)r * D))[F.lane + 64 * j] = cvt4_fp8(h[j][0], h[j][1], h[j][2], h[j][3]);
                    else { u32x2 w; w.x = cvt_pk_bf16(h[j][0], h[j][1]); w.y = cvt_pk_bf16(h[j][2], h[j][3]); ((u32x2*)(F.H + (size_t)r * D))[F.lane + 64 * j] = w; } }
                if (ROUTE) {
                    float a[16];
#pragma unroll
                    for (int e = 0; e < 16; ++e) a[e] = 0.f;
#pragma unroll
                    for (int j = 0; j < 4; ++j)
#pragma unroll
                        for (int q = 0; q < 4; ++q) { const float hk = h[j][q];
#pragma unroll
                            for (int ep = 0; ep < 8; ++ep) { const unsigned wp2 = wr16[j * 4 + q][ep];
                                asm("v_fma_mix_f32 %0, %1, %2, %0 op_sel:[0,0,0] op_sel_hi:[0,1,0]" : "+v"(a[2 * ep]) : "v"(hk), "v"(wp2));
                                asm("v_fma_mix_f32 %0, %1, %2, %0 op_sel:[0,1,0] op_sel_hi:[0,1,0]" : "+v"(a[2 * ep + 1]) : "v"(hk), "v"(wp2)); } }
                    float mx = -3.0e38f;
#pragma unroll
                    for (int e = 0; e < 16; ++e) { a[e] = wave_sum(a[e], F.lane) + F.b_router[e]; mx = fmaxf(mx, a[e]); }
#pragma unroll
                    for (int e = 0; e < 16; ++e) a[e] = fexp(a[e] - mx);
                    float bs = -1.f, ba = 0.f, bbv = 0.f; int bi0 = 0, bi1 = 1;
#pragma unroll
                    for (int g = 0; g < 4; ++g) {
                        float p0 = a[4 * g]; int i0 = 0;
#pragma unroll
                        for (int k = 1; k < 4; ++k) if (a[4 * g + k] > p0) { p0 = a[4 * g + k]; i0 = k; }
                        float p1 = -1.f; int i1 = 0;
#pragma unroll
                        for (int k = 0; k < 4; ++k) if (k != i0 && a[4 * g + k] > p1) { p1 = a[4 * g + k]; i1 = k; }
                        const float gs = p0 + p1;
                        if (gs > bs) { bs = gs; ba = p0; bbv = p1; bi0 = 4 * g + i0; bi1 = 4 * g + i1; }
                    }
                    if (F.lane == 0) { const float inv = 1.0f / (ba + bbv);
                        const int lp0 = __hip_atomic_fetch_add(lcnt + bi0, 1, __ATOMIC_RELAXED, __HIP_MEMORY_SCOPE_WORKGROUP), lp1 = __hip_atomic_fetch_add(lcnt + bi1, 1, __ATOMIC_RELAXED, __HIP_MEMORY_SCOPE_WORKGROUP);
                        LAS int* ri = rinfo + (r - r0) * 6; ri[0] = bi0; ri[1] = lp0; ri[2] = bi1; ri[3] = lp1; ri[4] = (int)__float_as_uint(ba * inv); ri[5] = (int)__float_as_uint(bbv * inv); }
                }
            }
#pragma unroll
            for (int j = 0; j < 4; ++j) { xa[j] = xn[j]; oa0[j] = on0[j]; oa1[j] = on1[j]; }
            tkA = tkB; tkB = tkC;
        }
    }
#undef NP_ROW
#undef NP_LOAD_TK
#undef NP_LOAD_ROW
    if (ROUTE) {
        __syncthreads();
        if (F.tid < 16) lcnt[16 + F.tid] = (int)__hip_atomic_fetch_add(F.ctl + CW_CNT + 64 * l + F.tid, (unsigned)lcnt[F.tid], RLX_AGENT);
        __syncthreads();
        for (int i = F.tid; i < r1 - r0; i += 512) { const LAS int* ri = rinfo + i * 6; const int e0 = ri[0], e1 = ri[2], p0 = lcnt[16 + e0] + ri[1], p1 = lcnt[16 + e1] + ri[3];
            v4u tk; tk.x = (unsigned)e0 | ((unsigned)p0 << 4); tk.y = (unsigned)e1 | ((unsigned)p1 << 4); tk.z = (unsigned)ri[4]; tk.w = (unsigned)ri[5]; F.TOK[r0 + i] = tk;
            F.LIST[(size_t)e0 * RT + p0] = r0 + i; F.LIST[(size_t)e1 * RT + p1] = r0 + i; }
    }
    __syncthreads();
}

__device__ __forceinline__ void norm_route_phase(Frame& F, int l, int nrows) {
    const int rpb = (nrows + F.G - 1) / F.G, r0 = F.vcu * rpb, r1 = (r0 + rpb < nrows) ? r0 + rpb : nrows;
    LAS int* rinfo = (LAS int*)(F.lds + 81920);
    LAS int* lcnt = (LAS int*)(F.lds + 81920 + 12288);
    LAS float* wrl = (LAS float*)F.lds;
    for (int i = F.tid; i < 1024 * 4; i += 512) { const int k = i >> 2, q4 = i & 3; const f32x4 v = *(const f32x4*)(F.w_router + k * 16 + q4 * 4);
        *(LAS f32x4*)(wrl + (((k >> 8) * 4 + (k & 3)) * 64 + ((k >> 2) & 63)) * 20 + q4 * 4) = v; }
    __syncthreads();
    typedef _Float16 h2v __attribute__((ext_vector_type(2)));
    unsigned wp16[8][16];
#pragma unroll
    for (int s = 0; s < 8; ++s) { const LAS float* w0 = wrl + ((2 * s) * 64 + F.lane) * 20; const LAS float* w1 = wrl + ((2 * s + 1) * 64 + F.lane) * 20;
#pragma unroll
        for (int e4 = 0; e4 < 4; ++e4) { const f32x4 va = *(const LAS f32x4*)(w0 + 4 * e4), vb = *(const LAS f32x4*)(w1 + 4 * e4);
#pragma unroll
            for (int t = 0; t < 4; ++t) { const h2v p = {(_Float16)va[t], (_Float16)vb[t]}; wp16[s][4 * e4 + t] = __builtin_bit_cast(unsigned, p); asm volatile("" : "+v"(wp16[s][4 * e4 + t])); } }
        if (s & 1) { asm volatile("s_waitcnt lgkmcnt(0)" ::: "memory"); __builtin_amdgcn_sched_barrier(0); } }
    if (F.tid < 16) lcnt[F.tid] = 0;
    LAS f32x4* mvec = (LAS f32x4*)(F.lds + 98304);
    const int bbA = (r0 < RL) ? (r0 >> 12) : 8, bbB = (r1 - 1 < RL) ? ((r1 - 1) >> 12) : 8;
    { const float* ng = F.norm_g + (size_t)(l * 2 + 1) * D;
      for (int i = F.tid; i < 2 * 256; i += 512) { const int which = i >> 8, c4 = i & 255; const float* md = F.MOD + ((size_t)l * 9 + (which ? bbB : bbA)) * 6144;
          const f32x4 g = ((const f32x4*)ng)[c4], sc = ((const f32x4*)(md + 4 * 1024))[c4], sh = ((const f32x4*)(md + 3 * 1024))[c4];
          mvec[which * 512 + c4] = g * (sc + 1.0f); mvec[which * 512 + 256 + c4] = sh; } }
    __syncthreads();
    const int cnt = (r1 - r0 - F.wave + 7) >> 3;
    if (cnt > 0) {
        u32x2 xa[4];
        { const u32x2* xr = (const u32x2*)(F.X + (size_t)(r0 + F.wave) * D);
#pragma unroll
          for (int j = 0; j < 4; ++j) xa[j] = xr[F.lane + 64 * j]; }
#pragma unroll 1
        for (int i = 0; i < cnt; ++i) {
            const int r = r0 + F.wave + 8 * i; const int bb = r < RL ? (r >> 12) : 8;
            f32x4 h[4]; float ss = 0.f;
#pragma unroll
            for (int j = 0; j < 4; ++j) { h[j] = (f32x4){bf_lo(xa[j].x), bf_hi(xa[j].x), bf_lo(xa[j].y), bf_hi(xa[j].y)}; ss += (h[j][0] * h[j][0] + h[j][1] * h[j][1]) + (h[j][2] * h[j][2] + h[j][3] * h[j][3]); }
            { const int rn = (r + 8 < r1) ? r + 8 : r; const u32x2* xr = (const u32x2*)(F.X + (size_t)rn * D);
#pragma unroll
              for (int j = 0; j < 4; ++j) xa[j] = xr[F.lane + 64 * j]; }
            const float rstd = frsq(wave_sum(ss, F.lane) * (1.0f / D) + EPS);
            const LAS f32x4* mv = mvec + (bb == bbA ? 0 : 512);
            float a[16];
#pragma unroll
            for (int e = 0; e < 16; ++e) a[e] = 0.f;
#pragma unroll
            for (int j = 0; j < 4; ++j) { const f32x4 ga = mv[F.lane + 64 * j], sh = mv[256 + F.lane + 64 * j];
                h[j] = h[j] * rstd * ga + sh;
                ((unsigned*)((unsigned char*)F.H + (size_t)r * D))[F.lane + 64 * j] = cvt4_fp8(h[j][0], h[j][1], h[j][2], h[j][3]);
#pragma unroll
                for (int hf = 0; hf < 2; ++hf) { const h2v hp = {(_Float16)h[j][2 * hf], (_Float16)h[j][2 * hf + 1]};
#pragma unroll
                    for (int e = 0; e < 16; ++e) a[e] = __builtin_amdgcn_fdot2(hp, __builtin_bit_cast(h2v, wp16[2 * j + hf][e]), a[e], false); } }
            { float b8[8], c4[4];
#pragma unroll
              for (int e = 0; e < 8; ++e) { auto rr = __builtin_amdgcn_permlane32_swap(__float_as_uint(a[e]), __float_as_uint(a[e + 8]), false, false); b8[e] = __uint_as_float(rr[0]) + __uint_as_float(rr[1]); }
#pragma unroll
              for (int e = 0; e < 4; ++e) { auto rr = __builtin_amdgcn_permlane16_swap(__float_as_uint(b8[e]), __float_as_uint(b8[e + 4]), false, false); c4[e] = row_sum16(__uint_as_float(rr[0]) + __uint_as_float(rr[1])); }
#pragma unroll
              for (int r4 = 0; r4 < 4; ++r4)
#pragma unroll
                  for (int e = 0; e < 4; ++e) a[e + 4 * (r4 & 1) + 8 * (r4 >> 1)] = __int_as_float(__builtin_amdgcn_readlane(__float_as_int(c4[e]), 16 * r4)); }
            float mx = -3.0e38f;
#pragma unroll
            for (int e = 0; e < 16; ++e) { a[e] = a[e] + F.b_router[e]; mx = fmaxf(mx, a[e]); }
#pragma unroll
            for (int e = 0; e < 16; ++e) a[e] = fexp(a[e] - mx);
            float bs = -1.f, ba = 0.f, bbv = 0.f; int bi0 = 0, bi1 = 1;
#pragma unroll
            for (int g = 0; g < 4; ++g) {
                float p0 = a[4 * g]; int i0 = 0;
#pragma unroll
                for (int k = 1; k < 4; ++k) if (a[4 * g + k] > p0) { p0 = a[4 * g + k]; i0 = k; }
                float p1 = -1.f; int i1 = 0;
#pragma unroll
                for (int k = 0; k < 4; ++k) if (k != i0 && a[4 * g + k] > p1) { p1 = a[4 * g + k]; i1 = k; }
                const float gs = p0 + p1;
                if (gs > bs) { bs = gs; ba = p0; bbv = p1; bi0 = 4 * g + i0; bi1 = 4 * g + i1; }
            }
            if (F.lane == 0) { const float inv = 1.0f / (ba + bbv);
                const int lp0 = __hip_atomic_fetch_add(lcnt + bi0, 1, __ATOMIC_RELAXED, __HIP_MEMORY_SCOPE_WORKGROUP), lp1 = __hip_atomic_fetch_add(lcnt + bi1, 1, __ATOMIC_RELAXED, __HIP_MEMORY_SCOPE_WORKGROUP);
                LAS int* ri = rinfo + (r - r0) * 6; ri[0] = bi0; ri[1] = lp0; ri[2] = bi1; ri[3] = lp1; ri[4] = (int)__float_as_uint(ba * inv); ri[5] = (int)__float_as_uint(bbv * inv); }
        }
    }
    __syncthreads();
    if (F.tid < 16) lcnt[16 + F.tid] = (int)__hip_atomic_fetch_add(F.ctl + CW_CNT + 64 * l + F.tid, (unsigned)lcnt[F.tid], RLX_AGENT);
    __syncthreads();
    for (int i = F.tid; i < r1 - r0; i += 512) { const LAS int* ri = rinfo + i * 6; const int e0 = ri[0], e1 = ri[2], p0 = lcnt[16 + e0] + ri[1], p1 = lcnt[16 + e1] + ri[3];
        v4u tk; tk.x = (unsigned)e0 | ((unsigned)p0 << 4); tk.y = (unsigned)e1 | ((unsigned)p1 << 4); tk.z = (unsigned)ri[4]; tk.w = (unsigned)ri[5]; F.TOK[r0 + i] = tk;
        F.LIST[(size_t)e0 * RT + p0] = r0 + i; F.LIST[(size_t)e1 * RT + p1] = r0 + i; }
    __syncthreads();
}

__device__ __forceinline__ const LAS int* moe_table(Frame& F, int l) {
    LAS int* tab = (LAS int*)(F.MISC + 16);
    __syncthreads();
    if (F.tid == 0) { int s = 0;
#pragma unroll 1
        for (int e = 0; e < 16; ++e) { const int cn = (int)__hip_atomic_load(F.ctl + CW_CNT + 64 * l + e, RLX_AGENT); tab[e] = s; tab[32 + e] = cn; s += (cn + 255) >> 8; } tab[16] = s; }
    __syncthreads();
    return tab;
}

#define MMA16(acc, afrag, bfrag) acc = __builtin_amdgcn_mfma_f32_16x16x32_bf16(bfrag, afrag, acc, 0, 0, 0)
constexpr int TP = 136;
__device__ __forceinline__ int chunk_row0(int b, int c) { return c < 2 ? RL + b * LC + c * 128 : b * SEQ + (c - 2) * 128; }

__device__ __forceinline__ void stage_vt(Frame& F, LAS bf16* VT, const bf16* src  , int ld) {
    const int j = F.tid >> 2, e0 = (F.tid & 3) * 32;
    const v4u* p = (const v4u*)(src + (size_t)j * ld + e0);
    v4u q[4];
#pragma unroll
    for (int t = 0; t < 4; ++t) q[t] = p[t];
#pragma unroll
    for (int t = 0; t < 4; ++t) { const unsigned w[4] = {q[t].x, q[t].y, q[t].z, q[t].w};
#pragma unroll
        for (int k = 0; k < 4; ++k) { VT[(e0 + t * 8 + 2 * k) * TP + j] = (bf16)(w[k] & 0xffffu); VT[(e0 + t * 8 + 2 * k + 1) * TP + j] = (bf16)(w[k] >> 16); } }
}

__device__ __forceinline__ void ret_kv_phase(Frame& F, int li) {
    LAS bf16* KTf = (LAS bf16*)F.lds; LAS bf16* KTb = KTf + 64 * TP; LAS bf16* VT = KTb + 64 * TP;
    const int fr = F.lane & 15, fq = F.lane >> 4;
    for (int u = F.vcu; u < NB * NCH * 4; u += F.G) {
        const int h = u & 3, c = (u >> 2) % NCH, b = u / (NCH * 4); const int row0 = chunk_row0(b, c);
        const float l2f = -fexp(F.ret_ld[(li * 2 + 0) * 4 + h]) * 1.4426950409f, l2b = -fexp(F.ret_ld[(li * 2 + 1) * 4 + h]) * 1.4426950409f;
        { const int j = F.tid >> 2, d0 = (F.tid & 3) * 16; const v4u* kp = (const v4u*)(F.BIG + (size_t)(row0 + j) * EVEN_IN + 256 + h * 64 + d0);
          const v4u k0 = kp[0], k1 = kp[1]; const float wf = fexp2((float)(127 - j) * l2f), wb = fexp2((float)j * l2b);
          const unsigned w[8] = {k0.x, k0.y, k0.z, k0.w, k1.x, k1.y, k1.z, k1.w};
#pragma unroll
          for (int k = 0; k < 8; ++k) { const float lo = bf_lo(w[k]), hi = bf_hi(w[k]);
              KTf[(d0 + 2 * k) * TP + j] = f2bf(lo * wf); KTf[(d0 + 2 * k + 1) * TP + j] = f2bf(hi * wf);
              KTb[(d0 + 2 * k) * TP + j] = f2bf(lo * wb); KTb[(d0 + 2 * k + 1) * TP + j] = f2bf(hi * wb); } }
        stage_vt(F, VT, F.BIG + (size_t)row0 * EVEN_IN + 512 + h * 128, EVEN_IN);
        {
            v4u sv[4];
#pragma unroll
            for (int tt = 0; tt < 4; ++tt) sv[tt] = *(const v4u*)(F.BIG + (size_t)(row0 + 32 * h + 4 * F.wave + tt) * EVEN_IN + 2048 + 8 * F.lane);
#pragma unroll
            for (int tt = 0; tt < 4; ++tt) { const float x[8] = {bf_lo(sv[tt].x), bf_hi(sv[tt].x), bf_lo(sv[tt].y), bf_hi(sv[tt].y), bf_lo(sv[tt].z), bf_hi(sv[tt].z), bf_lo(sv[tt].w), bf_hi(sv[tt].w)};
                float s = 0.f;
#pragma unroll
                for (int k = 0; k < 8; ++k) s += x[k];
                const float mean = wave_sum(s, F.lane) * (1.0f / 512.0f); float q = 0.f;
#pragma unroll
                for (int k = 0; k < 8; ++k) q += (x[k] - mean) * (x[k] - mean);
                const float rstd = frsq(wave_sum(q, F.lane) * (1.0f / 512.0f) + EPS);
                if (F.lane == 0) F.STATS[row0 + 32 * h + 4 * F.wave + tt] = (f32x2){mean, rstd}; } }
        __syncthreads();
        const int dir = F.wave >> 2, mp = F.wave & 3; const LAS bf16* KT = dir ? KTb : KTf;
        f32x4 acc[2][4];
#pragma unroll
        for (int mi = 0; mi < 2; ++mi)
#pragma unroll
            for (int n = 0; n < 4; ++n) acc[mi][n] = (f32x4){0.f, 0.f, 0.f, 0.f};
#pragma unroll
        for (int ks = 0; ks < 4; ++ks) { bf16x8 bv[4];
#pragma unroll
            for (int n = 0; n < 4; ++n) bv[n] = *(const LAS bf16x8*)(KT + (16 * n + fr) * TP + 32 * ks + 8 * fq);
#pragma unroll
            for (int mi = 0; mi < 2; ++mi) { const bf16x8 a = *(const LAS bf16x8*)(VT + (32 * mp + 16 * mi + fr) * TP + 32 * ks + 8 * fq);
#pragma unroll
                for (int n = 0; n < 4; ++n) MMA16(acc[mi][n], a, bv[n]); } }
        float* op = F.KV + ((size_t)(((b * NCH + c) * 4 + h) * 2 + dir) * 128 + 32 * mp + fr) * 64 + 4 * fq;
#pragma unroll
        for (int mi = 0; mi < 2; ++mi)
#pragma unroll
            for (int n = 0; n < 4; ++n) *(f32x4*)(op + (size_t)mi * 16 * 64 + 16 * n) = acc[mi][n];
        __syncthreads();
    }
}

__device__ __forceinline__ void ret_scan_phase(Frame& F, int li) {
    const int gt = F.vcu * 512 + F.tid, GT = F.G * 512;
    for (int it = gt; it < 64 * 128 * 16; it += GT) {
        const int dg = it & 15, e = (it >> 4) & 127, chain = it >> 11, dir = chain & 1, h = (chain >> 1) & 3, b = chain >> 3;
        const float l2 = -fexp(F.ret_ld[(li * 2 + dir) * 4 + h]) * 1.4426950409f; const float cd = fexp2(128.f * l2);
        f32x4 s = {0.f, 0.f, 0.f, 0.f};
        const size_t eo = (size_t)e * 64 + 4 * dg;
#define SC_BLK(st) ((size_t)(((b * NCH + (dir ? ((st) == 0 ? 1 : ((st) == 1 ? 0 : 35 - (st))) : (st))) * 4 + h) * 2 + dir) * 8192)
#pragma unroll 1
        for (int s0 = 0; s0 < NCH; s0 += 8) {
            f32x4 kvv[8];
#pragma unroll
            for (int k = 0; k < 8; ++k) { const int st = (s0 + k < NCH) ? s0 + k : NCH - 1; kvv[k] = *(const f32x4*)(F.KV + SC_BLK(st) + eo); }
#pragma unroll
            for (int k = 0; k < 8; ++k) { if (s0 + k < NCH) { u32x2 w; w.x = cvt_pk_bf16(s[0], s[1]); w.y = cvt_pk_bf16(s[2], s[3]);
                *(u32x2*)(F.ST + SC_BLK(s0 + k) + eo) = w; s = s * cd + kvv[k]; } }
        }
#undef SC_BLK
    }
}

__device__ __forceinline__ void mixer_phase(Frame& F, int li) {
    LAS bf16* VT = (LAS bf16*)F.lds; LAS bf16* PB = VT + 128 * TP; LAS bf16* SN = PB + 128 * TP; LAS f32x2* stats = (LAS f32x2*)(F.lds + 3 * 128 * TP * 2);
    const int fr = F.lane & 15, fq = F.lane >> 4, irow = 16 * F.wave + fr;
    LAS float* cvec = (LAS float*)(F.lds + 3 * 128 * TP * 2 + 1024);
    const bool hfix = (F.G & 3) == 0; const int hw = F.vcu & 3;
    if (hfix) { if (F.tid < 128) { cvec[F.tid] = F.ret_gn[li * 512 + hw * 128 + F.tid]; cvec[128 + F.tid] = F.sg_ln_g[li * 512 + hw * 128 + F.tid]; cvec[256 + F.tid] = F.sg_ln_b[li * 512 + hw * 128 + F.tid]; cvec[384 + F.tid] = F.sg_b[(li * 4 + hw) * 128 + F.tid]; } __syncthreads(); }
    for (int u = F.vcu; u < NB * NCH * 4; u += F.G) {
        const int h = u & 3, c = (u >> 2) % NCH, b = u / (NCH * 4), row0 = chunk_row0(b, c); const size_t grow = (size_t)(row0 + irow);
        if (!hfix) { __syncthreads(); if (F.tid < 128) { cvec[F.tid] = F.ret_gn[li * 512 + h * 128 + F.tid]; cvec[128 + F.tid] = F.sg_ln_g[li * 512 + h * 128 + F.tid]; cvec[256 + F.tid] = F.sg_ln_b[li * 512 + h * 128 + F.tid]; cvec[384 + F.tid] = F.sg_b[(li * 4 + h) * 128 + F.tid]; } __syncthreads(); }
        const bf16* Pr = F.BIG + grow * EVEN_IN;
        const float l2f = -fexp(F.ret_ld[(li * 2 + 0) * 4 + h]) * 1.4426950409f, l2b = -fexp(F.ret_ld[(li * 2 + 1) * 4 + h]) * 1.4426950409f;
        v4u vq[4];
        { const v4u* vp = (const v4u*)(F.BIG + (size_t)(row0 + (F.tid >> 2)) * EVEN_IN + 512 + h * 128 + (F.tid & 3) * 32);
#pragma unroll
          for (int t = 0; t < 4; ++t) vq[t] = vp[t]; }
        bf16x8 qf[2], kf[8][2];
#pragma unroll
        for (int ks = 0; ks < 2; ++ks) qf[ks] = *(const bf16x8*)(Pr + h * 64 + 32 * ks + 8 * fq);
#pragma unroll
        for (int n = 0; n < 8; ++n)
#pragma unroll
            for (int ks = 0; ks < 2; ++ks) kf[n][ks] = *(const bf16x8*)(F.BIG + (size_t)(row0 + 16 * n + fr) * EVEN_IN + 256 + h * 64 + 32 * ks + 8 * fq);
        {
            const int qt = F.tid >> 2, c0 = (F.tid & 3) * 32, e0 = c0, j = qt;
#pragma unroll
            for (int t = 0; t < 4; ++t) { const unsigned w[4] = {vq[t].x, vq[t].y, vq[t].z, vq[t].w};
#pragma unroll
                for (int k = 0; k < 4; ++k) { VT[(e0 + t * 8 + 2 * k) * TP + j] = (bf16)(w[k] & 0xffffu); VT[(e0 + t * 8 + 2 * k + 1) * TP + j] = (bf16)(w[k] >> 16); } }
        }
        {
            const int qt = F.tid >> 2, c0 = (F.tid & 3) * 32; const f32x2 st = F.STATS[row0 + qt];
            const v4u* p = (const v4u*)(F.BIG + (size_t)(row0 + qt) * EVEN_IN + 2048 + h * 128 + c0);
            const LAS float* lg = cvec + 128 + c0; const LAS float* lb = cvec + 256 + c0;
#pragma unroll
            for (int t = 0; t < 4; ++t) { const v4u sv = p[t]; const unsigned w[4] = {sv.x, sv.y, sv.z, sv.w}; const f32x4 g0 = *(const LAS f32x4*)(lg + 8 * t), g1 = *(const LAS f32x4*)(lg + 8 * t + 4), b0 = *(const LAS f32x4*)(lb + 8 * t), b1 = *(const LAS f32x4*)(lb + 8 * t + 4);
                const float gg[8] = {g0[0], g0[1], g0[2], g0[3], g1[0], g1[1], g1[2], g1[3]}, bbv[8] = {b0[0], b0[1], b0[2], b0[3], b1[0], b1[1], b1[2], b1[3]};
#pragma unroll
                for (int k = 0; k < 4; ++k) { const float lo = (bf_lo(w[k]) - st.x) * st.y * gg[2 * k] + bbv[2 * k], hi = (bf_hi(w[k]) - st.x) * st.y * gg[2 * k + 1] + bbv[2 * k + 1];
                    SN[(c0 + 8 * t + 2 * k) * TP + qt] = f2bf(lo); SN[(c0 + 8 * t + 2 * k + 1) * TP + qt] = f2bf(hi); } }
        }
        __syncthreads();
        {
            f32x4 acc[8];
#pragma unroll
            for (int n = 0; n < 8; ++n) acc[n] = (f32x4){0.f, 0.f, 0.f, 0.f};
#pragma unroll
            for (int n = 0; n < 8; ++n)
#pragma unroll
                for (int ks = 0; ks < 2; ++ks) MMA16(acc[n], qf[ks], kf[n][ks]);
#pragma unroll
            for (int n = 0; n < 8; ++n) { float pv[4];
#pragma unroll
                for (int r = 0; r < 4; ++r) { const int dl = irow - (16 * n + 4 * fq + r); const float dec = dl > 0 ? fexp2((float)dl * l2f) : (dl < 0 ? fexp2((float)(-dl) * l2b) : 2.0f); pv[r] = acc[n][r] * dec; }
                u32x2 w; w.x = cvt_pk_bf16(pv[0], pv[1]); w.y = cvt_pk_bf16(pv[2], pv[3]); *(LAS u32x2*)(PB + irow * TP + 16 * n + 4 * fq) = w; }
        }
        const bf16* sp = F.ST + (size_t)((((b * NCH + c) * 4 + h) * 2) * 128 + fr) * 64 + 8 * fq;
        bf16x8 sfr[8][2];
#pragma unroll
        for (int n = 0; n < 8; ++n)
#pragma unroll
            for (int ks = 0; ks < 2; ++ks) sfr[n][ks] = *(const bf16x8*)(sp + (16 * n) * 64 + 32 * ks);
        LDS_WAIT();
        f32x4 ao[8];
#pragma unroll
        for (int n = 0; n < 8; ++n) ao[n] = (f32x4){0.f, 0.f, 0.f, 0.f};
#pragma unroll
        for (int ks = 0; ks < 4; ++ks) { const bf16x8 a = *(const LAS bf16x8*)(PB + irow * TP + 32 * ks + 8 * fq);
#pragma unroll
            for (int n = 0; n < 8; ++n) { const bf16x8 bv = *(const LAS bf16x8*)(VT + (16 * n + fr) * TP + 32 * ks + 8 * fq); MMA16(ao[n], a, bv); } }
#pragma unroll
        for (int dir = 0; dir < 2; ++dir) {
            const float xi = dir ? fexp2((float)(128 - irow) * l2b) : fexp2((float)(irow + 1) * l2f);
            f32x4 ax[8];
#pragma unroll
            for (int n = 0; n < 8; ++n) ax[n] = (f32x4){0.f, 0.f, 0.f, 0.f};
#pragma unroll
            for (int n = 0; n < 8; ++n)
#pragma unroll
                for (int ks = 0; ks < 2; ++ks) MMA16(ax[n], qf[ks], sfr[n][ks]);
            if (dir == 0) {
#pragma unroll
                for (int n = 0; n < 8; ++n)
#pragma unroll
                    for (int ks = 0; ks < 2; ++ks) sfr[n][ks] = *(const bf16x8*)(sp + 128 * 64 + (16 * n) * 64 + 32 * ks); }
#pragma unroll
            for (int n = 0; n < 8; ++n) ao[n] = ao[n] + ax[n] * xi;
        }
        float s = 0.f;
#pragma unroll
        for (int n = 0; n < 8; ++n) s += (ao[n][0] + ao[n][1]) + (ao[n][2] + ao[n][3]);
        s = col_sum4(s);
        const float mean = s * (1.0f / 128.0f); float q = 0.f;
#pragma unroll
        for (int n = 0; n < 8; ++n) { const f32x4 d = ao[n] - mean; q += (d[0] * d[0] + d[1] * d[1]) + (d[2] * d[2] + d[3] * d[3]); }
        q = col_sum4(q);
        const float rstd = frsq(q * (1.0f / 128.0f) + EPS);
#pragma unroll
        for (int n = 0; n < 8; ++n) { const int e0 = 16 * n + 4 * fq; const u32x2 gt = *(const u32x2*)(Pr + 1024 + h * 128 + e0); const f32x4 gn = *(const LAS f32x4*)(cvec + e0);
            const float y0 = (ao[n][0] - mean) * rstd * gn[0] * silu_f(bf_lo(gt.x)), y1 = (ao[n][1] - mean) * rstd * gn[1] * silu_f(bf_hi(gt.x));
            const float y2 = (ao[n][2] - mean) * rstd * gn[2] * silu_f(bf_lo(gt.y)), y3 = (ao[n][3] - mean) * rstd * gn[3] * silu_f(bf_hi(gt.y));
            u32x2 w; w.x = cvt_pk_bf16(y0, y1); w.y = cvt_pk_bf16(y2, y3); *(u32x2*)(F.MIX + grow * D + h * 128 + e0) = w; }
        {
            f32x4 acc[8];
#pragma unroll
            for (int n = 0; n < 8; ++n) acc[n] = (f32x4){0.f, 0.f, 0.f, 0.f};
#pragma unroll
            for (int ks = 0; ks < 4; ++ks) { const bf16x8 a = *(const bf16x8*)(F.SGW + ((size_t)(li * 4 + h) * 128 + irow) * 128 + 32 * ks + 8 * fq);
#pragma unroll
                for (int n = 0; n < 8; ++n) { const bf16x8 bv = *(const LAS bf16x8*)(SN + (16 * n + fr) * TP + 32 * ks + 8 * fq); MMA16(acc[n], a, bv); } }
            const float bsv = cvec[384 + irow];
#pragma unroll
            for (int n = 0; n < 8; ++n) { const int c0 = 16 * n + 4 * fq; const u32x2 uu = *(const u32x2*)(Pr + 1536 + h * 128 + c0);
                u32x2 w; w.x = cvt_pk_bf16(bf_lo(uu.x) * (acc[n][0] + bsv), bf_hi(uu.x) * (acc[n][1] + bsv)); w.y = cvt_pk_bf16(bf_lo(uu.y) * (acc[n][2] + bsv), bf_hi(uu.y) * (acc[n][3] + bsv));
                *(u32x2*)(F.MIX + grow * D + 512 + h * 128 + c0) = w; }
        }
        __syncthreads();
    }
}

namespace att {
constexpr int QBLK = 32, KVBLK = 64, DH = 128;
constexpr float SCALE = 0.088388347648318440f;
constexpr float THR = 8.f;
constexpr int LDQ = 1024, LDK = 256, LDO = 1024;
constexpr size_t SHM_V = KVBLK * DH * 2, SHM_K = KVBLK * DH * 2, SHM_ATTN = 2 * SHM_V + 2 * SHM_K + NWAVES * 64 * 4;
#define KSWZ(row, colB) ((row) * 256 + ((colB) ^ (((row) & 7) << 4)))
#define SBAR() __builtin_amdgcn_sched_barrier(0)
__device__ __forceinline__ int crow(int r, int hi) { return (r & 3) + 8 * (r >> 2) + 4 * hi; }
__device__ __forceinline__ void partialSM(f32x16& p0, f32x16& p1, float& m_reg, float& mn, float& alpha) {
  constexpr float C = SCALE * 1.4426950408889634f;
  float pmax = p0[0]; for (int r = 1; r < 16; ++r) pmax = fmaxf(pmax, p0[r]); for (int r = 0; r < 16; ++r) pmax = fmaxf(pmax, p1[r]);
  { auto rr = __builtin_amdgcn_permlane32_swap(__float_as_uint(pmax), __float_as_uint(pmax), false, false);
    pmax = fmaxf(__uint_as_float(rr[0]), __uint_as_float(rr[1])); }
  if (__builtin_expect(__all(pmax - m_reg <= THR / SCALE), 1)) { mn = m_reg; alpha = 1.f; }
  else { mn = fmaxf(m_reg, pmax); alpha = __builtin_amdgcn_exp2f((m_reg - mn) * C); m_reg = mn; }
  float mnC = -mn * C;
  for (int r = 0; r < 16; ++r) p0[r] = fmaf(p0[r], C, mnC); for (int r = 0; r < 16; ++r) p1[r] = fmaf(p1[r], C, mnC);
  for (int r = 0; r < 16; ++r) p0[r] = __builtin_amdgcn_exp2f(p0[r]);
}
__device__ __forceinline__ void finishSM(f32x16& p0, f32x16& p1, float alpha, float& l_reg, bf16x8& pa0, bf16x8& pa1, bf16x8& pa2, bf16x8& pa3) {
  for (int r = 0; r < 16; ++r) p1[r] = __builtin_amdgcn_exp2f(p1[r]);
  float ps = 0; for (int r = 0; r < 16; ++r) ps += p0[r]; for (int r = 0; r < 16; ++r) ps += p1[r];
  { auto rr = __builtin_amdgcn_permlane32_swap(__float_as_uint(ps), __float_as_uint(ps), false, false);
    ps = __uint_as_float(rr[0]) + __uint_as_float(rr[1]); }
  l_reg = l_reg * alpha + ps;
#define PK4(P, BASE, OUT) do { unsigned a0 = cvt_pk_bf16(P[BASE + 0], P[BASE + 1]), a1 = cvt_pk_bf16(P[BASE + 2], P[BASE + 3]);   \
    unsigned b0 = cvt_pk_bf16(P[BASE + 4], P[BASE + 5]), b1 = cvt_pk_bf16(P[BASE + 6], P[BASE + 7]);                              \
    auto r0 = __builtin_amdgcn_permlane32_swap(a0, b0, false, false); auto r1 = __builtin_amdgcn_permlane32_swap(a1, b1, false, false); \
    v4u w = {r0[0], r1[0], r0[1], r1[1]}; OUT = *reinterpret_cast<bf16x8*>(&w); } while (0)
  PK4(p0, 0, pa0); PK4(p0, 8, pa1); PK4(p1, 0, pa2); PK4(p1, 8, pa3);
#undef PK4
}
__device__ __forceinline__ void qkt(f32x16& p0, f32x16& p1, const int (&kb4)[4], int boff, const bf16x8* qr) {
  p0 = f32x16{}; p1 = f32x16{};
#pragma unroll
  for (int d0 = 0; d0 < 8; ++d0) { const LAS char* kp = (const LAS char*)(uintptr_t)(unsigned)(kb4[d0 & 3] + boff);
    bf16x8 b0 = *reinterpret_cast<const LAS bf16x8*>(kp + (d0 >> 2) * 128);
    bf16x8 b1 = *reinterpret_cast<const LAS bf16x8*>(kp + (d0 >> 2) * 128 + 8192);
    p0 = __builtin_amdgcn_mfma_f32_32x32x16_bf16(b0, qr[d0], p0, 0, 0, 0);
    p1 = __builtin_amdgcn_mfma_f32_32x32x16_bf16(b1, qr[d0], p1, 0, 0, 0); }
}
__device__ __forceinline__ void mask_tile(f32x16& p0, f32x16& p1, int mk, int jb, int i, int hi) {
  if (mk == 1) { for (int r = 0; r < 16; ++r) { const int j = jb + crow(r, hi); p0[r] = (j >= i) ? p0[r] : -1e30f; p1[r] = (j + 32 >= i) ? p1[r] : -1e30f; } }
  else if (mk == 2) { for (int r = 0; r < 16; ++r) { const int j = jb + crow(r, hi); p0[r] = (j <= i) ? p0[r] : -1e30f; p1[r] = (j + 32 <= i) ? p1[r] : -1e30f; } }
}
__device__ __forceinline__ int v_st(int k, int c) { const int kk = (k & ~0xC) | ((k & 4) << 1) | ((k & 8) >> 1); return ((kk >> 3) * 4 + (c >> 5)) * 512 + ((kk & 7) * 32 + (c & 31)) * 2; }
__device__ __forceinline__ int v_rd_base(int lane) { return ((lane & 3) << 3) | (((lane >> 2) & 3) << 6) | (((lane >> 4) & 1) << 5) | (((lane >> 5) & 1) << 8); }
constexpr int v_rd_off(int d0, int ks, int half) { return d0 * 512 + ks * 4096 + half * 2048; }
template <int OFF> __device__ __forceinline__ s16x4 tr_read(int vb) {
  s16x4 r; asm volatile("ds_read_b64_tr_b16 %0, %1 offset:%2" : "=&v"(r) : "v"(vb), "i"(OFF) : "memory"); return r;
}
template <int D0> __device__ __forceinline__ void pv_one(f32x16& od, int vb, bf16x8 pa0, bf16x8 pa1, bf16x8 pa2, bf16x8 pa3) {
  const s16x4 l0 = tr_read<v_rd_off(D0, 0, 0)>(vb), h0 = tr_read<v_rd_off(D0, 0, 1)>(vb), l1 = tr_read<v_rd_off(D0, 1, 0)>(vb), h1 = tr_read<v_rd_off(D0, 1, 1)>(vb);
  const s16x4 l2 = tr_read<v_rd_off(D0, 2, 0)>(vb), h2 = tr_read<v_rd_off(D0, 2, 1)>(vb), l3 = tr_read<v_rd_off(D0, 3, 0)>(vb), h3 = tr_read<v_rd_off(D0, 3, 1)>(vb);
  asm volatile("s_waitcnt lgkmcnt(0)" ::: "memory"); SBAR();
#define PK(L, H) (bf16x8){L[0], L[1], L[2], L[3], H[0], H[1], H[2], H[3]}
  od = __builtin_amdgcn_mfma_f32_32x32x16_bf16(pa0, PK(l0, h0), od, 0, 0, 0);
  od = __builtin_amdgcn_mfma_f32_32x32x16_bf16(pa1, PK(l1, h1), od, 0, 0, 0);
  od = __builtin_amdgcn_mfma_f32_32x32x16_bf16(pa2, PK(l2, h2), od, 0, 0, 0);
  od = __builtin_amdgcn_mfma_f32_32x32x16_bf16(pa3, PK(l3, h3), od, 0, 0, 0);
#undef PK
}
__device__ __forceinline__ void pv_d0(f32x16* o, int vb, bf16x8 pa0, bf16x8 pa1, bf16x8 pa2, bf16x8 pa3) {
  pv_one<0>(o[0], vb, pa0, pa1, pa2, pa3); pv_one<1>(o[1], vb, pa0, pa1, pa2, pa3); pv_one<2>(o[2], vb, pa0, pa1, pa2, pa3); pv_one<3>(o[3], vb, pa0, pa1, pa2, pa3);
}

__device__ __forceinline__ void attn_unit(const bf16* __restrict__ Q, const bf16* __restrict__ Kb, const bf16* __restrict__ Vb, bf16* __restrict__ O, const float* __restrict__ sinkp,
                                          int qrow0, int h0, int kvh, int klat, int kctx, int add0, int skipnext, int NT, char* lds, const int tid) {
  const int wid = tid >> 6, lane = tid & 63, r32 = lane & 31, hi = lane >> 5;
  bf16* V_lds = (bf16*)lds; bf16* K_lds = (bf16*)(lds + 2 * SHM_V);
  float* ws = (float*)(lds + 2 * SHM_V + 2 * SHM_K) + wid * 64; float* li_l = ws; float* al_l = ws + 32;
  const int head = h0 + (wid >> 2), iq = (wid & 3) * QBLK + r32;
  float m_reg = sinkp[head] * (1.0f / SCALE), l_reg = 1.0f; f32x16 o[4] = {}; bf16x8 qr[8];
  const bf16* Qw = Q + (size_t)(qrow0 + iq) * LDQ + head * DH + hi * 8;
#pragma unroll
  for (int d0 = 0; d0 < 8; ++d0) qr[d0] = *reinterpret_cast<const bf16x8*>(Qw + d0 * 16);
  const int sr = tid >> 4, sc = (tid & 15) * 8, vst0 = v_st(sr, sc), vst1 = v_st(32 + sr, sc);
  const int vb0 = (int)(uintptr_t)V_lds + v_rd_base(lane);
  int kb4[4];
#pragma unroll
  for (int q = 0; q < 4; ++q) kb4[q] = (int)(uintptr_t)K_lds + r32 * 256 + ((q << 5) ^ ((hi << 4) ^ ((r32 & 7) << 4)));
  const unsigned kvoff = (unsigned)((sr * LDK + kvh * DH + sc) * 2);
  struct { bf16x8 vs0, vs1, ks0, ks1; } sr_[2];
#define TILE_T(s) ({ int _t = (s) + add0; if (skipnext && _t >= 4) _t += 2; _t; })
#define TILE_ROW(t) ((t) < 6 ? klat + 64 * (t) : kctx + 64 * ((t) - 6))
#define TILE_MK(t) ((t) < 2 ? 1 : (((t) >= 4 && (t) < 6) ? 2 : 0))
#define SLOAD(i, s) do { const int _t = TILE_T(s); const size_t _k0 = (size_t)TILE_ROW(_t) * (LDK * 2); const char* _kp = (const char*)Kb + _k0; const char* _vp = (const char*)Vb + _k0; \
    sr_[i].vs0 = *reinterpret_cast<const bf16x8*>(_vp + kvoff); sr_[i].vs1 = *reinterpret_cast<const bf16x8*>(_vp + 32 * LDK * 2 + kvoff); \
    sr_[i].ks0 = *reinterpret_cast<const bf16x8*>(_kp + kvoff); sr_[i].ks1 = *reinterpret_cast<const bf16x8*>(_kp + 32 * LDK * 2 + kvoff); } while (0)
#define SWRITE(b, i) do { *(bf16x8*)((char*)V_lds + (b) * SHM_V + vst0) = sr_[i].vs0;          \
    *(bf16x8*)((char*)V_lds + (b) * SHM_V + vst1) = sr_[i].vs1; int kc = sc * 2;               \
    *(bf16x8*)((char*)K_lds + (b) * SHM_K + KSWZ(sr, kc)) = sr_[i].ks0;                       \
    *(bf16x8*)((char*)K_lds + (b) * SHM_K + KSWZ(32 + sr, kc)) = sr_[i].ks1; } while (0)
#define SWAIT() asm volatile("s_waitcnt vmcnt(4)" ::: "memory")
#define RESC(a) do { if (__any((a) < 1.f)) { if (hi == 0) al_l[r32] = (a); asm volatile("s_waitcnt lgkmcnt(0)" ::: "memory"); \
    for (int d = 0; d < 4; ++d) for (int r = 0; r < 16; ++r) o[d][r] *= al_l[crow(r, hi)]; } } while (0)
#define MASK(P0, P1, s) do { const int _t = TILE_T(s); mask_tile(P0, P1, TILE_MK(_t), 64 * (_t & 1), iq, hi); } while (0)
  f32x16 pA0, pA1, pB0, pB1; float mnA, mnB, alA, alB; bf16x8 pa0, pa1, pa2, pa3;
  constexpr int SE = 0, SO = 1;
  SLOAD(SE, 0); asm volatile("s_waitcnt vmcnt(0)" ::: "memory"); SWRITE(0, SE); __syncthreads();
  qkt(pA0, pA1, kb4, 0, qr); MASK(pA0, pA1, 0); partialSM(pA0, pA1, m_reg, mnA, alA);
  SLOAD(SO, 1); if (2 < NT) SLOAD(SE, 2);
  SWAIT(); SWRITE(1, SO); __syncthreads();
  for (int j = 1; j + 1 < NT; j += 2) {
    SBAR(); qkt(pB0, pB1, kb4, (int)SHM_K, qr); MASK(pB0, pB1, j);
    finishSM(pA0, pA1, alA, l_reg, pa0, pa1, pa2, pa3); SBAR();
    SLOAD(SO, j + 2); SBAR();
    pv_d0(o, vb0, pa0, pa1, pa2, pa3); partialSM(pB0, pB1, m_reg, mnB, alB);
    __syncthreads(); SWAIT(); SWRITE(0, SE);
    RESC(alB); __syncthreads();
    SBAR(); qkt(pA0, pA1, kb4, 0, qr); MASK(pA0, pA1, j + 1);
    finishSM(pB0, pB1, alB, l_reg, pa0, pa1, pa2, pa3); SBAR();
    if (j + 3 < NT) SLOAD(SE, j + 3); SBAR();
    pv_d0(o, vb0 + (int)SHM_V, pa0, pa1, pa2, pa3); partialSM(pA0, pA1, m_reg, mnA, alA);
    __syncthreads(); SWAIT(); SWRITE(1, SO);
    RESC(alA); __syncthreads();
  }
  SBAR(); qkt(pB0, pB1, kb4, (int)SHM_K, qr); MASK(pB0, pB1, NT - 1);
  finishSM(pA0, pA1, alA, l_reg, pa0, pa1, pa2, pa3); SBAR();
  pv_d0(o, vb0, pa0, pa1, pa2, pa3); partialSM(pB0, pB1, m_reg, mnB, alB);
  __syncthreads(); RESC(alB);
  finishSM(pB0, pB1, alB, l_reg, pa0, pa1, pa2, pa3); SBAR();
  pv_d0(o, vb0 + (int)SHM_V, pa0, pa1, pa2, pa3);
  if (hi == 0) li_l[r32] = l_reg; asm volatile("s_waitcnt lgkmcnt(0)" ::: "memory");
  float rli[16];
#pragma unroll
  for (int r = 0; r < 16; ++r) rli[r] = __builtin_amdgcn_rcpf(li_l[crow(r, hi)]);
  bf16* Ow = O + (size_t)(qrow0 + (wid & 3) * QBLK) * LDO + head * DH;
#pragma unroll
  for (int r = 0; r < 16; ++r) { int orow = crow(r, hi);
    for (int d0 = 0; d0 < 4; ++d0) Ow[(size_t)orow * LDO + d0 * 32 + r32] = f2bf(o[d0][r] * rli[r]); }
  __syncthreads();
#undef TILE_T
#undef TILE_ROW
#undef TILE_MK
#undef SLOAD
#undef SWRITE
#undef SWAIT
#undef RESC
#undef MASK
}
}

__device__ __forceinline__ void attn_phase(Frame& F, int li, bool need_ctx) {
    const bf16* Q = F.BIG; const bf16* Kb = (const bf16*)((const char*)F.BIG + BIG_K); const bf16* Vb = (const bf16*)((const char*)F.BIG + BIG_V);
    const float* sinkp = F.sink + li * 8;
    const int NU = 1024 + (need_ctx ? 64 : 0);
    for (int u = F.vcu; u < NU; u += F.G) {
        if (u < 1024) { const int pair = u & 1, kvh = (u >> 1) & 1, n = (u >> 2) & 31, b = u >> 7;
            const int add0 = (n == 0) ? 2 : 0, skipnext = (n == 31) ? 1 : 0, NT = 10 - ((n == 0 || n == 31) ? 2 : 0);
            att::attn_unit(Q, Kb, Vb, F.MIX, sinkp, b * SEQ + n * 128, kvh * 4 + pair * 2, kvh, b * SEQ + (n - 1) * 128, RL + b * LC, add0, skipnext, NT, F.ldsg, F.tid);
        } else { const int v = u - 1024, pair = v & 1, kvh = (v >> 1) & 1, cb = (v >> 2) & 1, b = v >> 3;
            att::attn_unit(Q, Kb, Vb, F.MIX, sinkp, RL + b * LC + cb * 128, kvh * 4 + pair * 2, kvh, 0, RL + b * LC, 6, 0, 4, F.ldsg, F.tid);
        }
    }
}

#ifndef MK_SINGLE
#define MK_SINGLE 1
#endif
#ifndef REP_SET
#define REP_SET 0
#endif
#define RP(n) ((REP_SET == 200 + (n)) ? 2 : 1)
constexpr int REPS[14] = {RP(0), RP(1), RP(2), RP(3), RP(4), RP(5), RP(6), RP(7), RP(8), RP(9), RP(10), RP(11), RP(12), RP(13)};
#ifdef ONLY
#define ONLYX(n, stmt) do { if constexpr (ONLY == (n)) { stmt; } } while (0)
#else
#define ONLYX(n, stmt) do { for (int rep_ = 0; rep_ < REPS[n]; ++rep_) { stmt; if (rep_ + 1 < REPS[n]) xcd_barrier(bar); } } while (0)
#endif
constexpr int PPL = 9;
constexpr int NPHASE = 1 + DEPTH * PPL + 1;

#define CAS __attribute__((address_space(4)))
__device__ __forceinline__ void fill_ptrs(Frame& F, LAS unsigned char* ldsbase, int wv) {
    const CAS char* ka = (const CAS char*)__builtin_amdgcn_kernarg_segment_ptr(); asm volatile("" : "+s"(ka));
    { F.lds = ldsbase; F.ldsg = (char*)ldsbase; F.MISC = (volatile LAS unsigned*)(ldsbase + MISC_OFF); }
    { asm volatile("" : "+s"(wv)); unsigned am = ~0u; asm volatile("" : "+s"(am)); int ln = (int)__builtin_amdgcn_mbcnt_hi(am, __builtin_amdgcn_mbcnt_lo(am, 0u)); asm volatile("" : "+v"(ln)); F.lane = ln; F.wave = wv; F.tid = wv * 64 + ln; }
    { int g = gridDim.x, bx = blockIdx.x; asm volatile("" : "+s"(g), "+s"(bx)); F.G = g; F.vcu = (g % 8 == 0) ? (bx % 8) * (g / 8) + bx / 8 : bx; F.bx = bx; }
#define KIN(k) (*(const float* const CAS*)(ka + 8 * (k)))
    F.x_in = KIN(0); F.c_in = KIN(1); F.ctx_in = KIN(2); F.cctx_in = KIN(3); F.w_mod = KIN(4); F.b_mod = KIN(5); F.norm_g = KIN(6);
    F.w_in_even = KIN(7); F.w_out_even = KIN(8); F.ret_ld = KIN(9); F.ret_gn = KIN(10); F.sg_ln_g = KIN(11); F.sg_ln_b = KIN(12); F.sg_w = KIN(13); F.sg_b = KIN(14);
    F.w_qkv = KIN(15); F.w_o = KIN(16); F.sink = KIN(17); F.w_router = KIN(18); F.b_router = KIN(19); F.w_eg = KIN(20); F.w_eu = KIN(21); F.w_ed = KIN(22); F.final_g = KIN(23);
    F.out = *(float* const CAS*)(ka + 8 * 24);
    unsigned char* ws = *(unsigned char* const CAS*)(ka + 8 * 25);
#undef KIN
    F.ctl = (unsigned*)(ws + WS_CTL);
    F.MOD = (float*)(ws + WS_MOD); F.ROPE = (float*)(ws + WS_ROPE); F.X = (bf16*)(ws + WS_X); F.KV = (float*)(ws + WS_C);
    F.SGW = (bf16*)(ws + WS_SGW); F.W1T = (bf16*)(ws + WS_W1T); F.W2T = (bf16*)(ws + WS_W2T); F.WIN = (bf16*)(ws + WS_WIN); F.WOUT = (bf16*)(ws + WS_WOUT); F.WQKV = (bf16*)(ws + WS_WQKV); F.WO = (bf16*)(ws + WS_WO);
    F.H = (bf16*)(ws + WS_H); F.BIG = (bf16*)(ws + WS_BIG); F.MIX = (bf16*)(ws + WS_MIX); F.CS = (bf16*)(ws + WS_C); F.ST = (bf16*)(ws + WS_C + C_ST);
    F.STATS = (f32x2*)(ws + WS_STATS); F.TOK = (v4u*)(ws + WS_TOK); F.LIST = (int*)(ws + WS_LIST);
}
struct Args { const float* in[24]; float* out; unsigned char* ws; int ph_lo, ph_hi; };

__global__ void __launch_bounds__(NWAVES * 64, 2) fwd_kernel(Args args) {
    extern __shared__ __attribute__((aligned(16))) unsigned char lds[];
    Frame F; const int wv0 = __builtin_amdgcn_readfirstlane((int)threadIdx.x >> 6);
    fill_ptrs(F, (LAS unsigned char*)lds, wv0);
    for (int u = F.tid; u < (LDS_BYTES - MISC_OFF) / 4; u += NWAVES * 64) ((LAS unsigned*)(F.lds + MISC_OFF))[u] = 0u;
    __syncthreads();
    XcdBarrier bar; bar.bar = F.ctl + CW_BAR; bar.x = 0; bar.st = nullptr;
    if (MK_SINGLE) bar = xcd_barrier_post(F.ctl + CW_BAR, F.MISC);
    const int lo = args.ph_lo, hi = args.ph_hi;
#define IN(k) (lo <= (k) && (k) < hi)
#define SEAM(k) do { if (IN((k) + 1)) xcd_barrier(bar); } while (0)

    if (IN(0)) { fill_ptrs(F, (LAS unsigned char*)lds, wv0); ONLYX(0, p0_prologue(F)); SEAM(0); }

#pragma unroll 1
    for (int l = 0; l < DEPTH; ++l) {
        const int pb = 1 + l * PPL, li = l >> 1; const bool even = !(l & 1), need_ctx = l < DEPTH - 1;
        const int nrows = need_ctx ? RT : RL;
        if (IN(pb + 0)) { fill_ptrs(F, (LAS unsigned char*)lds, wv0); if (l == 0) { ONLYX(1, (norm_phase<false, false, false, true>(F, l, RT, 0, even ? IN8 : QKV8))); } else { ONLYX(2, (norm_phase<true, false, false, false>(F, l, RT, 0, even ? IN8 : QKV8))); } SEAM(pb + 0); }
        if (IN(pb + 1)) {
            fill_ptrs(F, (LAS unsigned char*)lds, wv0);
            if (even) { pg8::Gemm g{F.H, (const bf16*)((const unsigned char*)F.WIN + (size_t)li * EVEN_IN * 1024 * (IN8 ? 1 : 2)), 0}; pg8::StaticOrder S; S.init(RT, EVEN_IN, F.G, F.bx); EpiIn E{F.BIG};
                ONLYX(3, (pg8::gemm_phase<EpiIn, pg8::StaticOrder, true, false, IN8>(F.lds, g, S, E, F.tid))); }
            else { pg8::Gemm g{F.H, (const bf16*)((const unsigned char*)F.WQKV + (size_t)li * ODD_IN * 1024 * (QKV8 ? 1 : 2)), 0}; pg8::StaticOrder S; S.init(RT, ODD_IN, F.G, F.bx);
                EpiQKV E{F.BIG, (bf16*)((char*)F.BIG + BIG_K), (bf16*)((char*)F.BIG + BIG_V), F.ROPE};
                ONLYX(4, (pg8::gemm_phase<EpiQKV, pg8::StaticOrder, true, false, QKV8>(F.lds, g, S, E, F.tid))); }
            SEAM(pb + 1);
        }
        if (even) {
            if (IN(pb + 2)) { fill_ptrs(F, (LAS unsigned char*)lds, wv0); ONLYX(5, ret_kv_phase(F, li)); SEAM(pb + 2); }
            if (IN(pb + 3)) { fill_ptrs(F, (LAS unsigned char*)lds, wv0); ONLYX(6, ret_scan_phase(F, li)); SEAM(pb + 3); }
            if (IN(pb + 4)) { fill_ptrs(F, (LAS unsigned char*)lds, wv0); ONLYX(7, mixer_phase(F, li)); SEAM(pb + 4); }
        } else {
            if (IN(pb + 4)) { fill_ptrs(F, (LAS unsigned char*)lds, wv0); ONLYX(8, attn_phase(F, li, need_ctx)); SEAM(pb + 4); }
        }
        if (IN(pb + 5)) {
            fill_ptrs(F, (LAS unsigned char*)lds, wv0);
            pg8::Gemm g{F.MIX, (even ? F.WOUT : F.WO) + (size_t)li * 1048576, 0}; pg8::StaticOrder S; S.init(nrows, D, F.G, F.bx);
            EpiRes E{l == 0 ? F.x_in : nullptr, l == 0 ? F.ctx_in : nullptr, F.X, F.MOD + (size_t)l * 9 * 6144};
            ONLYX(9, (pg8::gemm_phase<EpiRes, pg8::StaticOrder, true, false, false>(F.lds, g, S, E, F.tid)));
            SEAM(pb + 5);
        }
        if (IN(pb + 6)) { fill_ptrs(F, (LAS unsigned char*)lds, wv0); ONLYX(10, norm_route_phase(F, l, nrows)); SEAM(pb + 6); }
        if (IN(pb + 7)) {
            fill_ptrs(F, (LAS unsigned char*)lds, wv0);
            const LAS int* tab = moe_table(F, l);
            pg8::Gemm g{F.H, (const bf16*)((const unsigned char*)F.W1T + (size_t)l * 16 * 2048 * 1024), (size_t)2048 * 1024}; pg8::MoeOrder S; S.init(tab, F.LIST, 8, F.G, F.bx); EpiMoe1 E{(unsigned char*)F.BIG};
            ONLYX(11, (pg8::gemm_phase<EpiMoe1, pg8::MoeOrder, true, true, true>(F.lds, g, S, E, F.tid)));
            SEAM(pb + 7);
        }
        if (IN(pb + 8)) {
            fill_ptrs(F, (LAS unsigned char*)lds, wv0);
            const LAS int* tab = moe_table(F, l);
            pg8::Gemm g{F.BIG, (const bf16*)((const unsigned char*)F.W2T + (size_t)l * 16 * 1048576), (size_t)1048576}; pg8::MoeOrder S; S.init(tab, F.LIST, 4, F.G, F.bx); EpiBf8 E{F.CS};
            ONLYX(12, (pg8::gemm_phase<EpiBf8, pg8::MoeOrder, true, false, true, true>(F.lds, g, S, E, F.tid)));
            SEAM(pb + 8);
        }
    }
    if (IN(NPHASE - 1)) { fill_ptrs(F, (LAS unsigned char*)lds, wv0); ONLYX(13, (norm_phase<true, false, true, false>(F, DEPTH, RL, 0, true))); }
#undef IN
#undef SEAM
}

extern "C" void kernel_launch(void* const* d_in, const int* in_sizes, int n_in, void* d_out, int out_size, void* d_ws, size_t ws_size, hipStream_t stream) {
    static int grid = 0;
    if (grid == 0) {
        if (n_in != 24 || in_sizes[0] != RL * D || out_size != RL * D || ws_size < WS_END) { fprintf(stderr, "kernel_launch: shape mismatch: n_in %d in0 %d out %d ws %zu (need %zu)\n", n_in, n_in > 0 ? in_sizes[0] : -1, out_size, ws_size, (size_t)WS_END); grid = -1; return; }
        int dev = 0, cus = 0, per_cu = 0;
        if (hipGetDevice(&dev) != hipSuccess || hipDeviceGetAttribute(&cus, hipDeviceAttributeMultiprocessorCount, dev) != hipSuccess) { fprintf(stderr, "kernel_launch: device query failed\n"); grid = -1; return; }
        if (hipFuncSetAttribute((const void*)fwd_kernel, hipFuncAttributeMaxDynamicSharedMemorySize, LDS_BYTES) != hipSuccess) { fprintf(stderr, "kernel_launch: hipFuncSetAttribute failed\n"); grid = -1; return; }
        if (hipOccupancyMaxActiveBlocksPerMultiprocessor(&per_cu, (const void*)fwd_kernel, NWAVES * 64, LDS_BYTES) != hipSuccess || per_cu < 1) { fprintf(stderr, "kernel_launch: occupancy query reports %d workgroups per CU\n", per_cu); }
        (void)hipGetLastError();
        grid = cus;
    }
    if (grid < 0) return;
    if (hipMemsetAsync((char*)d_ws + WS_CTL, 0, CTL_ZERO_BYTES, stream) != hipSuccess) { fprintf(stderr, "kernel_launch: memset failed\n"); return; }
    Args a{};
    for (int i = 0; i < 24; ++i) a.in[i] = (const float*)d_in[i];
    a.out = (float*)d_out; a.ws = (unsigned char*)d_ws;
#if MK_SINGLE
    a.ph_lo = 0; a.ph_hi = NPHASE;
    hipLaunchKernelGGL(fwd_kernel, dim3(grid), dim3(NWAVES * 64), LDS_BYTES, stream, a);
#else
    for (int p = 0; p < NPHASE; ++p) {
        if (p >= 1 && p < NPHASE - 1) { const int l = (p - 1) / PPL, k = (p - 1) % PPL; if ((l & 1) && (k == 2 || k == 3)) continue; }
        a.ph_lo = p; a.ph_hi = p + 1;
        hipLaunchKernelGGL(fwd_kernel, dim3(grid), dim3(NWAVES * 64), LDS_BYTES, stream, a);
    }
#endif
    const hipError_t le = hipPeekAtLastError();
    if (le != hipSuccess) fprintf(stderr, "kernel_launch: launch failed: %s\n", hipGetErrorName(le));
}
```

```cpp
#include <hip/hip_runtime.h>
#include <cstdio>
#include <cstdint>
#include <type_traits>

#define GAS __attribute__((address_space(1)))
#define LAS __attribute__((address_space(3)))
typedef unsigned short bf16;
typedef unsigned v4u __attribute__((ext_vector_type(4)));
typedef unsigned u32x2 __attribute__((ext_vector_type(2)));
typedef float f32x2 __attribute__((ext_vector_type(2)));
typedef float f32x4 __attribute__((ext_vector_type(4)));
typedef float f32x16 __attribute__((ext_vector_type(16)));
typedef short bf16x8 __attribute__((ext_vector_type(8)));
typedef short s16x4 __attribute__((ext_vector_type(4)));
typedef GAS unsigned gu32;
#define RLX_AGENT __ATOMIC_RELAXED, __HIP_MEMORY_SCOPE_AGENT
#define LDS_WAIT() asm volatile("s_waitcnt lgkmcnt(0)" ::: "memory")
#define VM_WAIT() asm volatile("s_waitcnt vmcnt(0)" ::: "memory")

constexpr int D = 1024, NB = 8, SEQ = 4096, LC = 256, DEPTH = 4;
constexpr int RL = NB * SEQ;
constexpr int RC = NB * LC;
constexpr int RT = RL + RC;
constexpr int NCH = 34;
constexpr int EVEN_IN = 2560, ODD_IN = 1536;
constexpr int NE = 16;
constexpr float EPS = 1e-6f;
constexpr int MAXSLOT = 73728;

__device__ __forceinline__ unsigned cvt_pk_bf16(float lo, float hi) { unsigned r; asm volatile("v_cvt_pk_bf16_f32 %0, %1, %2" : "=v"(r) : "v"(lo), "v"(hi)); return r; }
__device__ __forceinline__ float bf_lo(unsigned w) { return __uint_as_float(w << 16); }
__device__ __forceinline__ float bf_hi(unsigned w) { return __uint_as_float(w & 0xffff0000u); }
__device__ __forceinline__ float bf2f(unsigned short h) { return __uint_as_float(((unsigned)h) << 16); }
__device__ __forceinline__ unsigned short f2bf(float f) { return (unsigned short)(cvt_pk_bf16(f, 0.f) & 0xffffu); }
__device__ __forceinline__ float gelu_tanh(float x) { const float u = x + 0.044715f * x * x * x; return x * __builtin_amdgcn_rcpf(1.0f + __builtin_amdgcn_exp2f(-2.302208198f * u)); }
__device__ __forceinline__ float silu_f(float x) { return x * __builtin_amdgcn_rcpf(1.0f + __builtin_amdgcn_exp2f(-1.4426950409f * x)); }
__device__ __forceinline__ float fexp2(float x) { return __builtin_amdgcn_exp2f(x); }
__device__ __forceinline__ float fexp(float x) { return __builtin_amdgcn_exp2f(x * 1.4426950409f); }
__device__ __forceinline__ float frsq(float x) { return __builtin_amdgcn_rsqf(x); }
__device__ __forceinline__ float dpp_f(float v, const int ctrl_b1, const int sel) {
    const int x = __float_as_int(v);
    const int y = sel == 0 ? __builtin_amdgcn_mov_dpp(x, 0xB1, 0xf, 0xf, true) : sel == 1 ? __builtin_amdgcn_mov_dpp(x, 0x4E, 0xf, 0xf, true) : sel == 2 ? __builtin_amdgcn_mov_dpp(x, 0x141, 0xf, 0xf, true) : __builtin_amdgcn_mov_dpp(x, 0x140, 0xf, 0xf, true);
    return __int_as_float(y);
}
__device__ __forceinline__ float row_sum16(float v) { v += dpp_f(v, 0, 0); v += dpp_f(v, 0, 1); v += dpp_f(v, 0, 2); v += dpp_f(v, 0, 3); return v; }
__device__ __forceinline__ float wave_sum(float v, int) {
    v = row_sum16(v);
    const int x = __float_as_int(v);
    return (__int_as_float(__builtin_amdgcn_readlane(x, 0)) + __int_as_float(__builtin_amdgcn_readlane(x, 16))) + (__int_as_float(__builtin_amdgcn_readlane(x, 32)) + __int_as_float(__builtin_amdgcn_readlane(x, 48)));
}
__device__ __forceinline__ float col_max4(float v) {
    { auto r = __builtin_amdgcn_permlane16_swap(__float_as_uint(v), __float_as_uint(v), false, false); v = fmaxf(__uint_as_float(r[0]), __uint_as_float(r[1])); }
    { auto r = __builtin_amdgcn_permlane32_swap(__float_as_uint(v), __float_as_uint(v), false, false); v = fmaxf(__uint_as_float(r[0]), __uint_as_float(r[1])); }
    return v;
}
__device__ __forceinline__ float col_min4(float v) {
    { auto r = __builtin_amdgcn_permlane16_swap(__float_as_uint(v), __float_as_uint(v), false, false); v = fminf(__uint_as_float(r[0]), __uint_as_float(r[1])); }
    { auto r = __builtin_amdgcn_permlane32_swap(__float_as_uint(v), __float_as_uint(v), false, false); v = fminf(__uint_as_float(r[0]), __uint_as_float(r[1])); }
    return v;
}
__device__ __forceinline__ float col_sum4(float v) {
    { auto r = __builtin_amdgcn_permlane16_swap(__float_as_uint(v), __float_as_uint(v), false, false); v = __uint_as_float(r[0]) + __uint_as_float(r[1]); }
    { auto r = __builtin_amdgcn_permlane32_swap(__float_as_uint(v), __float_as_uint(v), false, false); v = __uint_as_float(r[0]) + __uint_as_float(r[1]); }
    return v;
}

namespace pg8 {
typedef unsigned short bf16_t;
constexpr int BM = 256, BK = 64, HALF = 128, HTB = HALF * BK * 2, STAGE_BYTES = 8 * HTB, NXCD = 8, WGM = 8, KD = 1024;

__host__ __device__ __forceinline__ int lds_byte(int r, int c) { const int st = (r >> 4) * 2 + (c >> 5), rr = r & 15, cc = c & 31, ob = rr * 64 + cc * 2; return st * 1024 + (ob ^ (((ob >> 9) & 1) << 5)); }
__host__ __device__ __forceinline__ void stage_rc(int b, int& R, int& C) { const int st = b / 1024, sb = b % 1024, swz = sb ^ (((sb >> 9) & 1) << 5); R = (st >> 1) * 16 + swz / 64; C = (st & 1) * 32 + (swz % 64) / 2; }
__host__ __device__ __forceinline__ int perm32(int rho) { const int n = rho >> 4, i = rho & 15; return 8 * (i >> 2) + 4 * n + (i & 3); }

struct Unit { int pm, pn, e, nvalid; const int* gidx; };
typedef int i32x8 __attribute__((ext_vector_type(8)));
typedef int i32x4 __attribute__((ext_vector_type(4)));
typedef i32x8 Frag;
__device__ __forceinline__ bf16x8 frag_half(const Frag& f, int k) { const i32x4 q = k ? __builtin_shufflevector(f, f, 4, 5, 6, 7) : __builtin_shufflevector(f, f, 0, 1, 2, 3); return __builtin_bit_cast(bf16x8, q); }
struct Gemm { const bf16_t* A; const bf16_t* Bt; size_t bstride; };

struct StaticOrder {
    int nM, nN, nwg, G, c;
    __device__ void init(int M, int N, int G_, int c_) { nM = M / BM; nN = N / BM; nwg = nM * nN; G = G_; c = c_; }
    __device__ bool next(int i, Unit& u) const {
        const long L = (long)i * G + c; if (L >= nwg) return false;
        int wgid = (int)L; { const int q = nwg / NXCD, r = nwg % NXCD, xcd = wgid % NXCD, off = wgid / NXCD; wgid = (xcd < r ? xcd * (q + 1) : r * (q + 1) + (xcd - r) * q) + off; }
        const int nig = WGM * nN, gid = wgid / nig, fm = gid * WGM, gsz = (nM - fm) < WGM ? (nM - fm) : WGM;
        u.pm = fm + ((wgid % nig) % gsz); u.pn = (wgid % nig) / gsz; u.e = 0; u.nvalid = 256; u.gidx = nullptr; return true;
    }
};
struct MoeOrder {
    const LAS int* tab; const int* lists; int npn, G, c, nwg;
    __device__ void init(const LAS int* tab_, const int* lists_, int npn_, int G_, int c_) { tab = tab_; lists = lists_; npn = npn_; G = G_; c = c_; nwg = tab_[16] * npn_; }
    __device__ bool next(int i, Unit& u) const {
        const long L = (long)i * G + c; if (L >= nwg) return false;
        int wgid = (int)L; { const int q = nwg / NXCD, r = nwg % NXCD, xcd = wgid % NXCD, off = wgid / NXCD; wgid = (xcd < r ? xcd * (q + 1) : r * (q + 1) + (xcd - r) * q) + off; }
        int e = (wgid >= __builtin_amdgcn_readfirstlane(tab[8]) * npn) ? 8 : 0;
        e += (wgid >= __builtin_amdgcn_readfirstlane(tab[e + 4]) * npn) ? 4 : 0; e += (wgid >= __builtin_amdgcn_readfirstlane(tab[e + 2]) * npn) ? 2 : 0; e += (wgid >= __builtin_amdgcn_readfirstlane(tab[e + 1]) * npn) ? 1 : 0;
        const int t0 = __builtin_amdgcn_readfirstlane(tab[e]), loc = wgid - t0 * npn, mt = (npn == 8) ? (loc >> 3) : (npn == 4) ? (loc >> 2) : loc / npn;
        u.pm = t0 + mt; u.pn = loc - mt * npn; u.e = e; u.nvalid = tab[32 + e] - mt * 256; u.gidx = lists + (size_t)e * RT + mt * 256; return true;
    }
};

template <class Epi, class Sched, bool ALIGN_EPI, bool GATHER, bool FP8, bool ATILED = false>
__device__ __forceinline__ void gemm_phase(LAS unsigned char* lds, const Gemm g, const Sched& S, const Epi& E, const int tid) {
    const int wid = __builtin_amdgcn_readfirstlane(tid >> 6), lane = tid & 63, wr = wid >> 2, wc = wid & 3, fr = lane & 15, fq = lane >> 4;
    constexpr int ROWB = FP8 ? 1024 : 2048, nt = ROWB / 128;
    unsigned voffA[2], voffB[2]; int RA[2]; unsigned CA2[2];
#pragma unroll
    for (int i = 0; i < 2; ++i) { int R, C; stage_rc(tid * 16 + i * 8192, R, C); const int Rb = Epi::PERM ? ((R & ~31) + perm32(R & 31)) : R;
        voffA[i] = (unsigned)(R * (ATILED ? 128 : ROWB) + C * 2); voffB[i] = (unsigned)(Rb * ROWB + C * 2); RA[i] = R; CA2[i] = (unsigned)C * 2u; }
    const size_t kstep = (size_t)(BK * 2);
    const size_t hstep = (size_t)HALF * ROWB;
    const size_t kstepA = ATILED ? (size_t)32768 : kstep, hstepA = ATILED ? (size_t)16384 : hstep;
    const size_t tstep = 2 * hstep;
    const unsigned ldsw = (unsigned)wid * 1024u;
    const int aoff = lds_byte(wr * 64 + fr, fq * 8), boff = lds_byte(wc * 32 + fr, fq * 8);
#define PG8_SA(b, h) (((b) * 2 + (h)) * HTB)
#define PG8_SB(b, h) ((4 + (b) * 2 + (h)) * HTB)
#define PG8_STAGE(bufoff, gbase, voff) do { _Pragma("unroll") for (int _i = 0; _i < 2; ++_i) \
        __builtin_amdgcn_global_load_lds((const unsigned*)((const char*)(gbase) + (voff)[_i]), (LAS unsigned*)(lds + (bufoff) + ldsw + _i * 8192), 16, 0, 0); } while (0)
#define PG8_STA(bufoff, kptr, H, VG) do { if constexpr (GATHER) { PG8_STAGE(bufoff, kptr, VG[H]); } else { PG8_STAGE(bufoff, (kptr) + (H) * hstepA, voffA); } } while (0)
#define PG8_LDA(dst, b, h) do { _Pragma("unroll") for (int m = 0; m < 4; ++m) dst[m] = __builtin_shufflevector(*(const LAS i32x4*)(lds + PG8_SA(b, h) + aoff + m * 2048), *(const LAS i32x4*)(lds + PG8_SA(b, h) + aoff + m * 2048 + 1024), 0, 1, 2, 3, 4, 5, 6, 7); } while (0)
#define PG8_LDB(dst, b, h) do { _Pragma("unroll") for (int n = 0; n < 2; ++n) dst[n] = __builtin_shufflevector(*(const LAS i32x4*)(lds + PG8_SB(b, h) + boff + n * 2048), *(const LAS i32x4*)(lds + PG8_SB(b, h) + boff + n * 2048 + 1024), 0, 1, 2, 3, 4, 5, 6, 7); } while (0)
#define PG8_MMA(ai, bj, At, Bt) do { __builtin_amdgcn_s_setprio(0); _Pragma("unroll") for (int m = 0; m < 4; ++m) _Pragma("unroll") for (int n = 0; n < 2; ++n) { \
        if constexpr (FP8) asm volatile("v_mfma_scale_f32_16x16x128_f8f6f4 %0, %1, %2, %0, %3, %3 op_sel_hi:[0,0,0]" : "+v"(acc[ai][bj][m][n]) : "v"(Bt[n]), "v"(At[m]), "v"(sc1)); \
        else { _Pragma("unroll") for (int k = 0; k < 2; ++k) acc[ai][bj][m][n] = __builtin_amdgcn_mfma_f32_16x16x32_bf16(frag_half(Bt[n], k), frag_half(At[m], k), acc[ai][bj][m][n], 0, 0, 0); } } \
        __builtin_amdgcn_s_setprio(0); } while (0)
#define PG8_WAIT_V(n) asm volatile("s_waitcnt vmcnt(" #n ")" ::: "memory")
#define PG8_WAIT_L(n) asm volatile("s_waitcnt lgkmcnt(" #n ")" ::: "memory")
#define PG8_BAR __builtin_amdgcn_s_barrier()
#define PG8_SCHED __builtin_amdgcn_sched_barrier(0)
#define PG8_GLOAD(U, TK) do { _Pragma("unroll") for (int _h = 0; _h < 2; ++_h) _Pragma("unroll") for (int _i = 0; _i < 2; ++_i) { const int _r = _h * HALF + RA[_i]; \
        const int _rc = _r < (U).nvalid ? _r : (U).nvalid - 1; TK[_h][_i] = (U).gidx[_rc]; } } while (0)
#define PG8_GADDR(TK, VG) do { _Pragma("unroll") for (int _h = 0; _h < 2; ++_h) _Pragma("unroll") for (int _i = 0; _i < 2; ++_i) VG[_h][_i] = (unsigned)TK[_h][_i] * (unsigned)ROWB + CA2[_i]; } while (0)
    Unit cur, nxt; int ui = 0;
    if (!S.next(0, cur)) return;
    f32x4 acc[2][2][4][2];
#pragma unroll
    for (int a = 0; a < 2; ++a)
#pragma unroll
        for (int b = 0; b < 2; ++b)
#pragma unroll
            for (int m = 0; m < 4; ++m)
#pragma unroll
                for (int n = 0; n < 2; ++n) acc[a][b][m][n] = (f32x4){0.f, 0.f, 0.f, 0.f};
    Frag At[4], B0[2], B1[2];
    const int sc1 = 0x7f7f7f7f;
    unsigned vgc[2][2] = {{0u, 0u}, {0u, 0u}}, vgn[2][2] = {{0u, 0u}, {0u, 0u}};
    int tkn[2][2] = {{0, 0}, {0, 0}};
    if constexpr (GATHER) { PG8_GLOAD(cur, tkn); PG8_GADDR(tkn, vgc); }
    const char* cA = GATHER ? (const char*)g.A : (const char*)g.A + (size_t)cur.pm * tstep;
    const char* cB = (const char*)g.Bt + (size_t)cur.e * g.bstride + (size_t)cur.pn * tstep;
    PG8_STAGE(PG8_SB(0, 0), cB, voffB); PG8_STAGE(PG8_SB(0, 1), cB + hstep, voffB); PG8_STA(PG8_SA(0, 0), cA, 0, vgc); PG8_STA(PG8_SA(0, 1), cA, 1, vgc);
    if (wr == 1) PG8_BAR;
    PG8_WAIT_V(2); PG8_BAR;
    PG8_STAGE(PG8_SB(1, 0), cB + kstep, voffB); PG8_STA(PG8_SA(1, 0), cA + kstepA, 0, vgc); PG8_STAGE(PG8_SB(1, 1), cB + hstep + kstep, voffB);
    PG8_WAIT_V(6); PG8_BAR;
    for (;;) {
        const bool has_next = S.next(ui + 1, nxt);
        if constexpr (GATHER) { if (has_next) { PG8_GLOAD(nxt, tkn); } }
        const char* nA = GATHER ? (const char*)g.A : (has_next ? (const char*)g.A + (size_t)nxt.pm * tstep : cA);
        const char* nB = has_next ? (const char*)g.Bt + (size_t)nxt.e * g.bstride + (size_t)nxt.pn * tstep : cB;
#pragma unroll 1
        for (int t = 0; t < nt; t += 2) {
            const bool last = (t == nt - 2);
            const char* a1 = cA + (size_t)(t + 1) * kstepA;
            const char* a2 = last ? nA : cA + (size_t)(t + 2) * kstepA; const char* b2 = last ? nB : cB + (size_t)(t + 2) * kstep;
            const char* a3 = a2 + kstepA; const char* b3 = b2 + kstep;
            unsigned va2[2][2] = {{vgc[0][0], vgc[0][1]}, {vgc[1][0], vgc[1][1]}};
            if constexpr (GATHER) { if (last && has_next) { asm volatile("" : "+v"(tkn[0][0]), "+v"(tkn[0][1]), "+v"(tkn[1][0]), "+v"(tkn[1][1])); PG8_GADDR(tkn, vgn);
                va2[0][0] = vgn[0][0]; va2[0][1] = vgn[0][1]; va2[1][0] = vgn[1][0]; va2[1][1] = vgn[1][1]; } }
            PG8_LDB(B0, 0, 0); PG8_LDB(B1, 0, 1); PG8_SCHED; PG8_LDA(At, 0, 0); PG8_STA(PG8_SA(1, 1), a1, 1, vgc);
            PG8_WAIT_V(8); PG8_WAIT_L(0); PG8_BAR; PG8_MMA(0, 0, At, B0); PG8_MMA(0, 1, At, B1); PG8_BAR; PG8_SCHED;
            PG8_LDA(At, 0, 1); PG8_STAGE(PG8_SB(0, 0), b2, voffB); PG8_STAGE(PG8_SB(0, 1), b2 + hstep, voffB); PG8_STA(PG8_SA(0, 0), a2, 0, va2);
            PG8_WAIT_V(8); PG8_WAIT_L(0); PG8_BAR; PG8_MMA(1, 0, At, B0); PG8_MMA(1, 1, At, B1); PG8_BAR; PG8_SCHED;
            PG8_LDB(B0, 1, 0); PG8_LDB(B1, 1, 1); PG8_SCHED; PG8_LDA(At, 1, 0); PG8_STA(PG8_SA(0, 1), a2, 1, va2);
            PG8_WAIT_V(8); PG8_WAIT_L(0); PG8_BAR; PG8_MMA(0, 0, At, B0); PG8_MMA(0, 1, At, B1); PG8_BAR; PG8_SCHED;
            PG8_LDA(At, 1, 1); PG8_STAGE(PG8_SB(1, 0), b3, voffB); PG8_STAGE(PG8_SB(1, 1), b3 + hstep, voffB); PG8_STA(PG8_SA(1, 0), a3, 0, va2);
            PG8_WAIT_V(8); PG8_WAIT_L(0); PG8_BAR; PG8_MMA(1, 0, At, B0); PG8_MMA(1, 1, At, B1); PG8_BAR; PG8_SCHED;
        }
        if constexpr (ALIGN_EPI) { if (wr == 0) PG8_BAR; }
        if constexpr (FP8) asm volatile("s_nop 15\n\ts_nop 15" ::: "memory");
        E(acc, cur, wr, wc, fr, fq);
        if (!has_next) break;
#pragma unroll
        for (int a = 0; a < 2; ++a)
#pragma unroll
            for (int b = 0; b < 2; ++b)
#pragma unroll
                for (int m = 0; m < 4; ++m)
#pragma unroll
                    for (int n = 0; n < 2; ++n) acc[a][b][m][n] = (f32x4){0.f, 0.f, 0.f, 0.f};
        cur = nxt; cA = nA; cB = nB; ++ui;
        if constexpr (GATHER) {
#pragma unroll
            for (int h = 0; h < 2; ++h)
#pragma unroll
                for (int i = 0; i < 2; ++i) vgc[h][i] = vgn[h][i]; }
        if constexpr (ALIGN_EPI) { if (wr == 1) PG8_BAR; }
    }
    PG8_WAIT_V(0);
    if constexpr (!ALIGN_EPI) { if (wr == 0) PG8_BAR; }
    PG8_BAR;
#undef PG8_SA
#undef PG8_SB
#undef PG8_STAGE
#undef PG8_STA
#undef PG8_LDA
#undef PG8_LDB
#undef PG8_MMA
#undef PG8_WAIT_V
#undef PG8_WAIT_L
#undef PG8_BAR
#undef PG8_SCHED
#undef PG8_GLOAD
#undef PG8_GADDR
}
}
#define XB_TMO      128
#define XB_XCNT(j)  (256  + 64 * (j))
#define XB_XSUB(j)  (1280 + 64 * (j))
#define XB_XGEN(j)  (2304 + 64 * (j))
#define XB_TOP      3328
#define XB_TOPGEN   3392
#define XCD_BAR_WORDS 3456
#define XB_SPIN_CAP (1u << 22)

__device__ __forceinline__ unsigned xb_ld(unsigned* p)              { return __hip_atomic_load(p, __ATOMIC_RELAXED, __HIP_MEMORY_SCOPE_AGENT); }
__device__ __forceinline__ unsigned xb_add(unsigned* p, unsigned v) { return __hip_atomic_fetch_add(p, v, __ATOMIC_RELAXED, __HIP_MEMORY_SCOPE_AGENT); }
__device__ __forceinline__ unsigned xb_xcc_id() { return (unsigned)__builtin_amdgcn_s_getreg((3 << 11) | 20) & 0xFu; }
#define XB_SPIN(cond, bar) do { unsigned _sp = 0; while (cond) { __builtin_amdgcn_s_sleep(1); \
    if ((++_sp & 255u) == 0u) { if (xb_ld(&(bar)[XB_TMO])) break; if (_sp > XB_SPIN_CAP) { atomicAdd(&(bar)[XB_TMO], 1u); break; } } } } while (0)

struct XcdBarrier {
    unsigned* bar; unsigned x;
    volatile LAS unsigned* st;
};

__device__ __forceinline__ XcdBarrier xcd_barrier_post(unsigned* bar, volatile LAS unsigned* st) {
    XcdBarrier b; b.bar = bar; b.x = xb_xcc_id(); b.st = st;
    if (threadIdx.x == 0) (void)xb_add(&bar[XB_XCNT(b.x)], 1u);
    return b;
}
__device__ __forceinline__ void xcd_barrier_complete(unsigned* bar, unsigned x, unsigned& nloc, unsigned& nx) {
    const unsigned G = gridDim.x * gridDim.y * gridDim.z;
    unsigned sum, cnt, mine, sp = 0u;
    for (;;) {
        sum = 0u; cnt = 0u; mine = 0u;
#pragma unroll
        for (unsigned j = 0; j < 16; ++j) { const unsigned c = xb_ld(&bar[XB_XCNT(j)]); sum += c; cnt += (c > 0u) ? 1u : 0u; mine = (j == x) ? c : mine; }
        if (sum == G) break;
        __builtin_amdgcn_s_sleep(1);
        if ((++sp & 255u) == 0u) { if (xb_ld(&bar[XB_TMO])) break; if (sp > XB_SPIN_CAP) { atomicAdd(&bar[XB_TMO], 1u); break; } }
    }
    nloc = mine > 0u ? mine : 1u; nx = cnt > 0u ? cnt : 1u;
}

__device__ __forceinline__ void xcd_barrier(const XcdBarrier& b) {
    asm volatile("s_waitcnt vmcnt(0)" ::: "memory");
    __syncthreads();
    if (threadIdx.x == 0) {
        unsigned* bar = b.bar; unsigned bxx = b.x; asm volatile("" : "+s"(bxx), "+s"(bar));
        __builtin_amdgcn_s_waitcnt(0);
        unsigned nloc = b.st[0], nx = b.st[1];
        if (nloc == 0u) { xcd_barrier_complete(bar, bxx, nloc, nx); b.st[0] = nloc; b.st[1] = nx; }
        const unsigned old = xb_add(&bar[XB_XSUB(bxx)], 1u);
        const unsigned gen = old / nloc;
        if (old + 1u == (gen + 1u) * nloc) {
            __builtin_amdgcn_fence(__ATOMIC_RELEASE, "agent");
            asm volatile("s_waitcnt vmcnt(0)" ::: "memory");
            const unsigned og = xb_add(&bar[XB_TOP], 1u);
            const unsigned tg = og / nx;
            if (og + 1u == (tg + 1u) * nx) xb_add(&bar[XB_TOPGEN], 1u);
            else XB_SPIN(xb_ld(&bar[XB_TOPGEN]) == tg, bar);
            __builtin_amdgcn_fence(__ATOMIC_ACQUIRE, "agent");
            asm volatile("s_waitcnt vmcnt(0)" ::: "memory");
        } else {
            XB_SPIN(xb_ld(&bar[XB_TOPGEN]) == gen, bar);
            __builtin_amdgcn_fence(__ATOMIC_ACQUIRE, "agent");
            asm volatile("s_waitcnt vmcnt(0)" ::: "memory");
        }
    }
    __syncthreads();
}

constexpr size_t MiB = 1u << 20;
constexpr size_t WS_CTL = 0, CTL_ZERO_BYTES = 1 * MiB;
constexpr size_t WS_MOD = 1 * MiB;
constexpr size_t WS_ROPE = 2 * MiB;
constexpr size_t WS_WRT = 2 * MiB + 32768;
constexpr size_t WS_SGW = 2 * MiB + 65536;
constexpr size_t WS_TOK = 3 * MiB;
constexpr size_t WS_LIST = 4 * MiB;
constexpr size_t WS_W1T = 8 * MiB;
constexpr size_t WS_W2T = 264 * MiB;
constexpr size_t WS_WIN = 392 * MiB;
constexpr size_t WS_WOUT = 402 * MiB;
constexpr size_t WS_WQKV = 406 * MiB;
constexpr size_t WS_WO = 412 * MiB;
constexpr size_t WS_X = 416 * MiB;
constexpr size_t WS_H = 552 * MiB;
constexpr size_t WS_BIG = 620 * MiB;
constexpr size_t WS_MIX = 790 * MiB;
constexpr size_t WS_C = 858 * MiB;
constexpr size_t WS_END = 1002 * MiB;
constexpr size_t BIG_K = 68 * MiB, BIG_V = 85 * MiB, C_ST = 68 * MiB, C_STATS = 104 * MiB;
constexpr int CW_TMO = 0, CW_BAR = 4096, CW_CNT = 8192;

constexpr int RING_BYTES = 131072, MISC_OFF = 161792, LDS_BYTES = 163840;
constexpr int NWAVES = 8;

struct Frame {
    LAS unsigned char* lds; char* ldsg;
    volatile LAS unsigned* MISC;
    unsigned* ctl;
    int tid, lane, wave, vcu, G, bx;
    const float *x_in, *c_in, *ctx_in, *cctx_in, *w_mod, *b_mod, *norm_g, *w_in_even, *w_out_even, *ret_ld, *ret_gn, *sg_ln_g, *sg_ln_b, *sg_w, *sg_b,
                *w_qkv, *w_o, *sink, *w_router, *b_router, *w_eg, *w_eu, *w_ed, *final_g;
    float* out;
    float *MOD, *ROPE, *KV; f32x2* STATS; unsigned* WRT;
    bf16 *X, *SGW, *W1T, *W2T, *WIN, *WOUT, *WQKV, *WO, *H, *BIG, *MIX, *CS, *ST;
    v4u* TOK; int* LIST;
};

using pg8::Unit;
__device__ __forceinline__ unsigned cvt4_fp8(float a, float b, float c, float d) { int w = 0; w = __builtin_amdgcn_cvt_pk_fp8_f32(a, b, w, false); w = __builtin_amdgcn_cvt_pk_fp8_f32(c, d, w, true); return (unsigned)w; }
__device__ __forceinline__ float clamp448(float x) { return __builtin_amdgcn_fmed3f(x, -448.f, 448.f); }
constexpr bool IN8 = true, QKV8 = true;
constexpr float W8_SCALE = 32.f, W8_INV = 1.f / 32.f;
constexpr float ACT8_SCALE = 4.f, ACT8_INV = 0.25f;
struct EpiIn {
    static constexpr bool PERM = true;
    bf16* O; f32x2* stats;
    __device__ __forceinline__ void operator()(const f32x4 (&acc)[2][2][4][2], const Unit& u, int wr, int wc, int fr, int fq) const {
        const int row0 = u.pm * 256 + wr * 64 + fr, col0 = u.pn * 256 + wc * 32 + 8 * fq;
        const int mode = (u.pn == 1) ? 1 : (u.pn >= 6 ? 2 : 0);
#pragma unroll
        for (int ai = 0; ai < 2; ++ai)
#pragma unroll
            for (int m = 0; m < 4; ++m) { bf16* rowp = O + (size_t)(row0 + ai * 128 + m * 16) * EVEN_IN + col0;
#pragma unroll
                for (int bj = 0; bj < 2; ++bj) { f32x4 v0 = acc[ai][bj][m][0] * (IN8 ? W8_INV : 1.f), v1 = acc[ai][bj][m][1] * (IN8 ? W8_INV : 1.f);
                    if (mode == 1) { v0 = v0 * 0.125f; v1 = v1 * 0.125f; }
                    if (mode == 2) {
#pragma unroll
                        for (int j = 0; j < 4; ++j) { v0[j] = gelu_tanh(v0[j]); v1[j] = gelu_tanh(v1[j]); } }
                    v4u w; w.x = cvt_pk_bf16(v0[0], v0[1]); w.y = cvt_pk_bf16(v0[2], v0[3]); w.z = cvt_pk_bf16(v1[0], v1[1]); w.w = cvt_pk_bf16(v1[2], v1[3]);
                    *(v4u*)(rowp + bj * 128) = w;
                    if (u.pn >= 8) {
                        float s1 = (v0[0] + v0[1]) + (v0[2] + v0[3]) + (v1[0] + v1[1]) + (v1[2] + v1[3]);
                        float s2 = (v0[0] * v0[0] + v0[1] * v0[1]) + (v0[2] * v0[2] + v0[3] * v0[3]) + (v1[0] * v1[0] + v1[1] * v1[1]) + (v1[2] * v1[2] + v1[3] * v1[3]);
                        s1 = col_sum4(s1); s2 = col_sum4(s2);
                        if (fq == 0) stats[(size_t)(row0 + ai * 128 + m * 16) * 16 + ((u.pn - 8) * 2 + bj) * 4 + wc] = (f32x2){s1, s2}; } } }
    }
};
struct EpiRes {
    static constexpr bool PERM = true;
    const float* xlat; const float* xctx; bf16* X; const float* modl;
    __device__ __forceinline__ void operator()(const f32x4 (&acc)[2][2][4][2], const Unit& u, int wr, int wc, int fr, int fq) const {
        const int row0 = u.pm * 256 + wr * 64 + fr, col0 = u.pn * 256 + wc * 32 + 8 * fq;
        const bool lat = u.pm < (RL / 256); const int bb = lat ? (u.pm >> 4) : 8;
        const float* gp = modl + bb * 6144 + 2 * 1024 + col0;
        f32x4 gv[2][2];
#pragma unroll
        for (int bj = 0; bj < 2; ++bj)
#pragma unroll
            for (int n = 0; n < 2; ++n) gv[bj][n] = *(const f32x4*)(gp + bj * 128 + n * 4);
        if (xlat) {
#pragma unroll
            for (int ai = 0; ai < 2; ++ai) {
                f32x4 x0[4][2], x1[4][2];
#pragma unroll
                for (int m = 0; m < 4; ++m) { const int r = row0 + ai * 128 + m * 16;
#pragma unroll
                    for (int bj = 0; bj < 2; ++bj) { const float* xi = (lat ? xlat + (size_t)r * D : xctx + (size_t)(r - RL) * D) + col0 + bj * 128; x0[m][bj] = *(const f32x4*)xi; x1[m][bj] = *(const f32x4*)(xi + 4); } }
#pragma unroll
                for (int m = 0; m < 4; ++m) { const int r = row0 + ai * 128 + m * 16; bf16* xo = X + (size_t)r * D + col0;
#pragma unroll
                    for (int bj = 0; bj < 2; ++bj) {
                        const f32x4 v0 = x0[m][bj] + gv[bj][0] * acc[ai][bj][m][0], v1 = x1[m][bj] + gv[bj][1] * acc[ai][bj][m][1];
                        v4u w; w.x = cvt_pk_bf16(v0[0], v0[1]); w.y = cvt_pk_bf16(v0[2], v0[3]); w.z = cvt_pk_bf16(v1[0], v1[1]); w.w = cvt_pk_bf16(v1[2], v1[3]);
                        *(v4u*)(xo + bj * 128) = w; } }
            }
        } else {
            v4u xw[2][4][2];
#pragma unroll
            for (int ai = 0; ai < 2; ++ai)
#pragma unroll
                for (int m = 0; m < 4; ++m) { const bf16* xo = X + (size_t)(row0 + ai * 128 + m * 16) * D + col0;
#pragma unroll
                    for (int bj = 0; bj < 2; ++bj) xw[ai][m][bj] = *(const v4u*)(xo + bj * 128); }
#pragma unroll
            for (int ai = 0; ai < 2; ++ai)
#pragma unroll
                for (int m = 0; m < 4; ++m) { bf16* xo = X + (size_t)(row0 + ai * 128 + m * 16) * D + col0;
#pragma unroll
                    for (int bj = 0; bj < 2; ++bj) { const v4u q = xw[ai][m][bj];
                        const f32x4 x0 = {bf_lo(q.x), bf_hi(q.x), bf_lo(q.y), bf_hi(q.y)}, x1 = {bf_lo(q.z), bf_hi(q.z), bf_lo(q.w), bf_hi(q.w)};
                        const f32x4 v0 = x0 + gv[bj][0] * acc[ai][bj][m][0], v1 = x1 + gv[bj][1] * acc[ai][bj][m][1];
                        v4u w; w.x = cvt_pk_bf16(v0[0], v0[1]); w.y = cvt_pk_bf16(v0[2], v0[3]); w.z = cvt_pk_bf16(v1[0], v1[1]); w.w = cvt_pk_bf16(v1[2], v1[3]);
                        *(v4u*)(xo + bj * 128) = w; } }
        }
    }
};
struct EpiQKV {
    static constexpr bool PERM = true;
    bf16 *Q, *K, *V; const float* rope;
    __device__ __forceinline__ void operator()(const f32x4 (&acc)[2][2][4][2], const Unit& u, int wr, int wc, int fr, int fq) const {
        const int row0 = u.pm * 256 + wr * 64 + fr; const int cin = wc * 32 + 8 * fq;
        const bool lat = u.pm < (RL / 256); const bool dorope = lat && (u.pn < 5);
        bf16* base; int ld;
        if (u.pn < 4) { base = Q + u.pn * 256; ld = 1024; } else if (u.pn == 4) { base = K; ld = 256; } else { base = V; ld = 256; }
        const int half = (cin >> 6) & 1, i0 = (cin & 63) >> 1;
#pragma unroll
        for (int ai = 0; ai < 2; ++ai)
#pragma unroll
            for (int m = 0; m < 4; ++m) { const int r = row0 + ai * 128 + m * 16; bf16* rowp = base + (size_t)r * ld + cin;
                f32x4 cs0 = {1.f, 0.f, 1.f, 0.f}, cs1 = {1.f, 0.f, 1.f, 0.f};
                if (dorope) { const int t = r & (SEQ - 1); const int pos = half ? (t & 63) : (t >> 6); const float* tp = rope + (size_t)(pos * 32 + i0) * 2; cs0 = *(const f32x4*)tp; cs1 = *(const f32x4*)(tp + 4); }
#pragma unroll
                for (int bj = 0; bj < 2; ++bj) { const f32x4 v0 = acc[ai][bj][m][0] * (QKV8 ? W8_INV : 1.f), v1 = acc[ai][bj][m][1] * (QKV8 ? W8_INV : 1.f);
                    const float a0 = v0[0] * cs0[0] - v0[1] * cs0[1], a1 = v0[1] * cs0[0] + v0[0] * cs0[1];
                    const float a2 = v0[2] * cs0[2] - v0[3] * cs0[3], a3 = v0[3] * cs0[2] + v0[2] * cs0[3];
                    const float a4 = v1[0] * cs1[0] - v1[1] * cs1[1], a5 = v1[1] * cs1[0] + v1[0] * cs1[1];
                    const float a6 = v1[2] * cs1[2] - v1[3] * cs1[3], a7 = v1[3] * cs1[2] + v1[2] * cs1[3];
                    v4u w; w.x = cvt_pk_bf16(a0, a1); w.y = cvt_pk_bf16(a2, a3); w.z = cvt_pk_bf16(a4, a5); w.w = cvt_pk_bf16(a6, a7);
                    *(v4u*)(rowp + bj * 128) = w; } }
    }
};
struct EpiMoe1 {
    static constexpr bool PERM = true;
    unsigned char* O;
    __device__ __forceinline__ void operator()(const f32x4 (&acc)[2][2][4][2], const Unit& u, int wr, int wc, int fr, int fq) const {
        unsigned char* const tb = O + (size_t)u.pm * 262144 + (size_t)u.pn * 32768 + (wr * 64 + fr) * 128 + wc * 32 + 8 * fq;
#pragma unroll
        for (int ai = 0; ai < 2; ++ai)
#pragma unroll
            for (int m = 0; m < 4; ++m) { unsigned char* rowp = tb + (ai * 128 + m * 16) * 128;
                const f32x4 g0 = acc[ai][0][m][0] * W8_INV, g1 = acc[ai][0][m][1] * W8_INV, u0 = acc[ai][1][m][0] * (W8_INV * ACT8_SCALE), u1 = acc[ai][1][m][1] * (W8_INV * ACT8_SCALE);
                f32x4 v0, v1;
#pragma unroll
                for (int j = 0; j < 4; ++j) { v0[j] = clamp448(silu_f(g0[j]) * u0[j]); v1[j] = clamp448(silu_f(g1[j]) * u1[j]); }
                u32x2 w; w.x = cvt4_fp8(v0[0], v0[1], v0[2], v0[3]); w.y = cvt4_fp8(v1[0], v1[1], v1[2], v1[3]);
                *(u32x2*)rowp = w; }
    }
};
struct EpiBf8 {
    static constexpr bool PERM = true;
    bf16* O;
    __device__ __forceinline__ void operator()(const f32x4 (&acc)[2][2][4][2], const Unit& u, int wr, int wc, int fr, int fq) const {
        const int row0 = u.pm * 256 + wr * 64 + fr, col0 = u.pn * 256 + wc * 32 + 8 * fq;
#pragma unroll
        for (int ai = 0; ai < 2; ++ai)
#pragma unroll
            for (int m = 0; m < 4; ++m) { bf16* rowp = O + (size_t)(row0 + ai * 128 + m * 16) * 1024 + col0;
#pragma unroll
                for (int bj = 0; bj < 2; ++bj) { const f32x4 v0 = acc[ai][bj][m][0] * (W8_INV * ACT8_INV), v1 = acc[ai][bj][m][1] * (W8_INV * ACT8_INV);
                    v4u w; w.x = cvt_pk_bf16(v0[0], v0[1]); w.y = cvt_pk_bf16(v0[2], v0[3]); w.z = cvt_pk_bf16(v1[0], v1[1]); w.w = cvt_pk_bf16(v1[2], v1[3]);
                    *(v4u*)(rowp + bj * 128) = w; } }
    }
};

template <class RowMap>
__device__ __forceinline__ void p0_transpose_item(const float* W, int N, bf16* WT, const RowMap& rm, LAS float* scr, int item, int lane) {
    const int nblk = N / 32, kb = item / nblk, nb = item % nblk, k0 = 64 * kb, n0 = 32 * nb;
#pragma unroll 8
    for (int i = 0; i < 32; ++i) { const int kk = 2 * i + (lane >> 5); scr[kk * 33 + (lane & 31)] = __builtin_nontemporal_load(W + (size_t)(k0 + kk) * N + n0 + (lane & 31)); }
    LDS_WAIT(); asm volatile("" ::: "memory");
    const int c = lane & 7;
#pragma unroll
    for (int j = 0; j < 4; ++j) { const int n = (lane >> 3) + 8 * j; const LAS float* s = scr + (8 * c) * 33 + n;
        v4u o; o.x = cvt_pk_bf16(s[0 * 33], s[1 * 33]); o.y = cvt_pk_bf16(s[2 * 33], s[3 * 33]); o.z = cvt_pk_bf16(s[4 * 33], s[5 * 33]); o.w = cvt_pk_bf16(s[6 * 33], s[7 * 33]);
        *(v4u*)(WT + (size_t)rm(n0 + n) * 1024 + k0 + 8 * c) = o; }
    LDS_WAIT(); asm volatile("" ::: "memory");
}
template <class RowMap>
__device__ __forceinline__ void p0_transpose_item8(const float* W, int N, unsigned char* WT, const RowMap& rm, LAS float* scr, int item, int lane) {
    const int nblk = N / 32, kb = item / nblk, nb = item % nblk, k0 = 64 * kb, n0 = 32 * nb;
#pragma unroll 16
    for (int i = 0; i < 32; ++i) { const int kk = 2 * i + (lane >> 5); scr[kk * 33 + (lane & 31)] = W[(size_t)(k0 + kk) * N + n0 + (lane & 31)] * W8_SCALE; }
    LDS_WAIT(); asm volatile("" ::: "memory");
    const int c = lane & 7;
#pragma unroll
    for (int j = 0; j < 4; ++j) { const int n = (lane >> 3) + 8 * j; const LAS float* s = scr + (8 * c) * 33 + n;
        u32x2 o; o.x = cvt4_fp8(s[0 * 33], s[1 * 33], s[2 * 33], s[3 * 33]); o.y = cvt4_fp8(s[4 * 33], s[5 * 33], s[6 * 33], s[7 * 33]);
        *(u32x2*)(WT + (size_t)rm(n0 + n) * 1024 + k0 + 8 * c) = o; }
    LDS_WAIT(); asm volatile("" ::: "memory");
}
template <class RowMap>
__device__ __forceinline__ void p0_transpose_item8f(const float* W, int N, unsigned char* WT, const RowMap& rm, LAS float* scr, int item, int lane) {
    const int nblk = N / 32, kb = item / nblk, nb = item % nblk, k0 = 128 * kb, n0 = 32 * nb;
#pragma unroll 16
    for (int i = 0; i < 64; ++i) { const int kk = 2 * i + (lane >> 5); scr[kk * 33 + (lane & 31)] = __builtin_nontemporal_load(W + (size_t)(k0 + kk) * N + n0 + (lane & 31)) * W8_SCALE; }
    LDS_WAIT(); asm volatile("" ::: "memory");
    const int c = lane & 15;
#pragma unroll
    for (int j = 0; j < 8; ++j) { const int n = (lane >> 4) + 4 * j; const LAS float* s = scr + (8 * c) * 33 + n;
        u32x2 o; o.x = cvt4_fp8(s[0 * 33], s[1 * 33], s[2 * 33], s[3 * 33]); o.y = cvt4_fp8(s[4 * 33], s[5 * 33], s[6 * 33], s[7 * 33]);
        __builtin_nontemporal_store(o, (u32x2*)(WT + (size_t)rm(n0 + n) * 1024 + k0 + 8 * c)); }
    LDS_WAIT(); asm volatile("" ::: "memory");
}
struct RmId { __device__ __forceinline__ int operator()(int n) const { return n; } };
struct RmGU { int type; __device__ __forceinline__ int operator()(int n) const { return ((n >> 7) << 8) + type * 128 + (n & 127); } };
struct RmQKV { __device__ __forceinline__ int operator()(int n) const { if (n >= 1280) return n; const int ps = n & 63; return (n & ~63) + (ps < 32 ? 2 * ps : 2 * (ps - 32) + 1); } };

__device__ __forceinline__ void p0_prologue(Frame& F) {
    LAS float* scr = (LAS float*)(F.lds + F.wave * 16896);
    const int gw = F.vcu * NWAVES + F.wave, NGW = F.G * NWAVES;
    constexpr int I_E = 256, N_EXP = 4 * 3 * 16 * I_E;
    constexpr int I_IN = IN8 ? 8 * 80 : 16 * 80, I_SQ = 512, I_QKV = QKV8 ? 8 * 48 : 16 * 48;
    constexpr int NITEMS = N_EXP + 2 * I_IN + 2 * I_SQ + 2 * I_QKV + 2 * I_SQ;
    for (int it = gw; it < NITEMS; it += NGW) {
        int r = it;
        if (r < N_EXP) { const int mtx = r / I_E, item = r % I_E, layer = mtx / 48, rem = mtx % 48, type = rem / 16, e = rem % 16; const size_t mo = (size_t)(layer * 16 + e) * 1048576;
            if (type == 2) p0_transpose_item8f(F.w_ed + mo, 1024, (unsigned char*)F.W2T + mo, RmId{}, scr, item, F.lane);
            else p0_transpose_item8f((type ? F.w_eu : F.w_eg) + mo, 1024, (unsigned char*)F.W1T + 2 * mo, RmGU{type}, scr, item, F.lane);
            continue; }
        r -= N_EXP;
        if (r < 2 * I_IN) { const int i = r / I_IN; if (IN8) p0_transpose_item8f(F.w_in_even + (size_t)i * 1024 * EVEN_IN, EVEN_IN, (unsigned char*)F.WIN + (size_t)i * EVEN_IN * 1024, RmId{}, scr, r % I_IN, F.lane); else p0_transpose_item(F.w_in_even + (size_t)i * 1024 * EVEN_IN, EVEN_IN, F.WIN + (size_t)i * EVEN_IN * 1024, RmId{}, scr, r % I_IN, F.lane); continue; } r -= 2 * I_IN;
        if (r < 2 * I_SQ) { const int i = r / I_SQ; p0_transpose_item(F.w_out_even + (size_t)i * 1048576, 1024, F.WOUT + (size_t)i * 1048576, RmId{}, scr, r % I_SQ, F.lane); continue; } r -= 2 * I_SQ;
        if (r < 2 * I_QKV) { const int i = r / I_QKV; if (QKV8) p0_transpose_item8f(F.w_qkv + (size_t)i * 1024 * ODD_IN, ODD_IN, (unsigned char*)F.WQKV + (size_t)i * ODD_IN * 1024, RmQKV{}, scr, r % I_QKV, F.lane); else p0_transpose_item(F.w_qkv + (size_t)i * 1024 * ODD_IN, ODD_IN, F.WQKV + (size_t)i * ODD_IN * 1024, RmQKV{}, scr, r % I_QKV, F.lane); continue; } r -= 2 * I_QKV;
        { const int i = r / I_SQ; p0_transpose_item(F.w_o + (size_t)i * 1048576, 1024, F.WO + (size_t)i * 1048576, RmId{}, scr, r % I_SQ, F.lane); }
    }
    { const int gt = F.vcu * 512 + F.tid, GT = F.G * 512;
      for (int i = gt; i < 2 * 4 * 128 * 128 / 4; i += GT) { const f32x4 v = ((const f32x4*)F.sg_w)[i]; u32x2 w; w.x = cvt_pk_bf16(v[0], v[1]); w.y = cvt_pk_bf16(v[2], v[3]); ((u32x2*)F.SGW)[i] = w; }
      for (int i = gt; i < 8 * 16 * 64; i += GT) { const int t = i & 3, ln = (i >> 2) & 63, e4 = (i >> 8) & 3, s = i >> 10; const int k0 = 256 * (s >> 1) + 4 * ln + 2 * (s & 1), e = 4 * e4 + t;
          typedef _Float16 h2v __attribute__((ext_vector_type(2))); const h2v p = {(_Float16)F.w_router[k0 * 16 + e], (_Float16)F.w_router[(k0 + 1) * 16 + e]}; F.WRT[i] = __builtin_bit_cast(unsigned, p); }
      for (int i = gt; i < 64 * 32; i += GT) { const int pos = i >> 5, fi = i & 31; const float inv = fexp2(-(float)fi * (13.287712379549449f / 32.0f)); const float rev = __builtin_amdgcn_fractf((float)pos * inv * 0.15915494309189535f);
          F.ROPE[2 * i] = __builtin_amdgcn_cosf(rev); F.ROPE[2 * i + 1] = __builtin_amdgcn_sinf(rev); } }
    __syncthreads();
    LAS float* sc = (LAS float*)F.lds;
    LAS float* part = (LAS float*)(F.lds + 49152);
    for (int i = F.tid; i < 9 * 1024; i += 512) { const int bb = i >> 10, k = i & 1023; const float cv = bb < 8 ? F.c_in[bb * 1024 + k] : F.cctx_in[k]; sc[k * 12 + bb] = silu_f(cv); }
    __syncthreads();
    for (int it = F.vcu; it < 4 * 96; it += F.G) {
        const int l = it / 96, n = (it % 96) * 64 + F.lane;
        float a[9];
#pragma unroll
        for (int bb = 0; bb < 9; ++bb) a[bb] = 0.f;
        const float* wp = F.w_mod + ((size_t)l * 1024 + F.wave * 128) * 6144 + n;
#pragma unroll 1
        for (int k0 = 0; k0 < 128; k0 += 16) {
            float wv[16];
#pragma unroll
            for (int j = 0; j < 16; ++j) wv[j] = __builtin_nontemporal_load(wp + (size_t)(k0 + j) * 6144);
            asm volatile("s_waitcnt vmcnt(0)" ::: "memory");
#pragma unroll
            for (int j = 0; j < 16; ++j) { const LAS float* sp = sc + (F.wave * 128 + k0 + j) * 12;
                const f32x4 s0 = *(const LAS f32x4*)sp, s1 = *(const LAS f32x4*)(sp + 4); const float s8 = sp[8];
                a[0] += s0[0] * wv[j]; a[1] += s0[1] * wv[j]; a[2] += s0[2] * wv[j]; a[3] += s0[3] * wv[j]; a[4] += s1[0] * wv[j]; a[5] += s1[1] * wv[j]; a[6] += s1[2] * wv[j]; a[7] += s1[3] * wv[j]; a[8] += s8 * wv[j]; }
        }
#pragma unroll
        for (int bb = 0; bb < 9; ++bb) part[(F.wave * 9 + bb) * 64 + F.lane] = a[bb];
        __syncthreads();
        for (int i = F.tid; i < 9 * 64; i += 512) { const int bb = i >> 6, ln = i & 63; float s = 0.f;
#pragma unroll
            for (int w = 0; w < 8; ++w) s += part[(w * 9 + bb) * 64 + ln];
            const int nn = (it % 96) * 64 + ln; F.MOD[((size_t)l * 9 + bb) * 6144 + nn] = s + F.b_mod[l * 6144 + nn]; }
        __syncthreads();
    }
}

template <bool COMBINE, bool ROUTE, bool FINAL, bool FIN>
__device__ __forceinline__ void norm_phase(Frame& F, int l, int nrows, int sel, bool h8) {
    const int rpb = (nrows + F.G - 1) / F.G, r0 = F.vcu * rpb, r1 = (r0 + rpb < nrows) ? r0 + rpb : nrows;
    LAS int* rinfo = (LAS int*)(F.lds + 81920);
    LAS int* lcnt = (LAS int*)(F.lds + 81920 + 12288);
    unsigned wr16[16][8];
    if (ROUTE) {
#pragma unroll
        for (int j = 0; j < 4; ++j)
#pragma unroll
            for (int q = 0; q < 4; ++q) { const char* wp = (const char*)(F.w_router + (256 * j + q) * 16); const unsigned lo_ = (unsigned)F.lane * 256u;
#pragma unroll
                for (int e4 = 0; e4 < 4; ++e4) { const f32x4 v = *(const f32x4*)(wp + (size_t)(lo_ + 16u * e4));
                    typedef _Float16 h2v __attribute__((ext_vector_type(2)));
                    const h2v p0 = {(_Float16)v[0], (_Float16)v[1]}, p1 = {(_Float16)v[2], (_Float16)v[3]};
                    wr16[j * 4 + q][2 * e4] = __builtin_bit_cast(unsigned, p0); wr16[j * 4 + q][2 * e4 + 1] = __builtin_bit_cast(unsigned, p1); }
                if (q == 3) asm volatile("" ::: "memory"); }
        if (F.tid < 16) lcnt[F.tid] = 0;
    }
    if (COMBINE) {
        if (F.tid < 16) { const int cn = (int)__hip_atomic_load(F.ctl + CW_CNT + 64 * (l - 1) + F.tid, RLX_AGENT); lcnt[48 + F.tid] = ((cn + 255) >> 8) << 8; }
        __syncthreads();
        if (F.tid < 16) { int s = 0;
#pragma unroll
            for (int e = 0; e < 16; ++e) s += (e < F.tid) ? lcnt[48 + e] : 0;
            lcnt[32 + F.tid] = s; } }
    LAS f32x4* mvec = (LAS f32x4*)(F.lds + 98304);
    const int bbA = (r0 < RL) ? (r0 >> 12) : 8, bbB = (r1 - 1 < RL) ? ((r1 - 1) >> 12) : 8;
    for (int i = F.tid; i < 2 * 256; i += 512) { const int which = i >> 8, c4 = i & 255, bq = which ? bbB : bbA;
        if (FINAL) mvec[which * 768 + c4] = ((const f32x4*)F.final_g)[c4];
        else { const float* md = F.MOD + ((size_t)l * 9 + bq) * 6144; const f32x4 g = ((const f32x4*)(F.norm_g + (size_t)(l * 2 + sel) * D))[c4], sc = ((const f32x4*)(md + (sel ? 4 : 1) * 1024))[c4], sh = ((const f32x4*)(md + (sel ? 3 : 0) * 1024))[c4];
            mvec[which * 768 + c4] = g * (sc + 1.0f); mvec[which * 768 + 256 + c4] = sh; }
        if (COMBINE) mvec[which * 768 + 512 + c4] = ((const f32x4*)(F.MOD + ((size_t)(l - 1) * 9 + bq) * 6144 + 5 * 1024))[c4]; }
    __syncthreads();
    const int cnt = (r1 - r0 - F.wave + 7) >> 3;
    typedef typename std::conditional<FIN, f32x4, u32x2>::type XR;
#define NP_ROW(i) ({ int _r = r0 + F.wave + 8 * (i); _r < r1 ? _r : r1 - 1; })
#define NP_LOAD_TK(dst, i) do { if constexpr (COMBINE) dst = F.TOK[NP_ROW(i)]; } while (0)
#define NP_LOAD_ROW(XQ_, O0, O1, TK, i) do { const int _rr = NP_ROW(i); \
        if constexpr (FIN) { const float* _xr = _rr < RL ? F.x_in + (size_t)_rr * D : F.ctx_in + (size_t)(_rr - RL) * D; \
            _Pragma("unroll") for (int j = 0; j < 4; ++j) XQ_[j] = ((const XR*)_xr)[F.lane + 64 * j]; } \
        else { _Pragma("unroll") for (int j = 0; j < 4; ++j) XQ_[j] = ((const XR*)(F.X + (size_t)_rr * D))[F.lane + 64 * j]; } \
        if constexpr (COMBINE) { const int _s0 = lcnt[32 + (TK.x & 15)] + (int)(TK.x >> 4), _s1 = lcnt[32 + (TK.y & 15)] + (int)(TK.y >> 4); \
            const u32x2* _o0 = (const u32x2*)(F.CS + (size_t)_s0 * 1024); const u32x2* _o1 = (const u32x2*)(F.CS + (size_t)_s1 * 1024); \
            _Pragma("unroll") for (int j = 0; j < 4; ++j) { O0[j] = _o0[F.lane + 64 * j]; O1[j] = _o1[F.lane + 64 * j]; } } } while (0)
    if (cnt > 0) {
        v4u tkA = {0u, 0u, 0u, 0u}, tkB = tkA; XR xa[4], xn[4]; u32x2 oa0[4], oa1[4], on0[4], on1[4];
#pragma unroll
        for (int j = 0; j < 4; ++j) { oa0[j] = (u32x2){0u, 0u}; oa1[j] = oa0[j]; on0[j] = oa0[j]; on1[j] = oa0[j]; }
        NP_LOAD_TK(tkA, 0); NP_LOAD_TK(tkB, 1);
        NP_LOAD_ROW(xa, oa0, oa1, tkA, 0);
#pragma unroll 1
        for (int i = 0; i < cnt; ++i) {
            const int r = r0 + F.wave + 8 * i;
            v4u tkC = tkB; NP_LOAD_TK(tkC, i + 2);
            NP_LOAD_ROW(xn, on0, on1, tkB, i + 1);
            const int bb = r < RL ? (r >> 12) : 8; const LAS f32x4* mv = mvec + (bb == bbA ? 0 : 768);
            f32x4 v[4];
#pragma unroll
            for (int j = 0; j < 4; ++j) { if constexpr (FIN) v[j] = xa[j]; else v[j] = (f32x4){bf_lo(xa[j].x), bf_hi(xa[j].x), bf_lo(xa[j].y), bf_hi(xa[j].y)}; }
            if (COMBINE) {
                const float w0 = __uint_as_float(tkA.z), w1 = __uint_as_float(tkA.w);
#pragma unroll
                for (int j = 0; j < 4; ++j) { const u32x2 a = oa0[j], b = oa1[j]; const f32x4 gg = mv[512 + F.lane + 64 * j];
                    v[j][0] += gg[0] * (w0 * bf_lo(a.x) + w1 * bf_lo(b.x)); v[j][1] += gg[1] * (w0 * bf_hi(a.x) + w1 * bf_hi(b.x));
                    v[j][2] += gg[2] * (w0 * bf_lo(a.y) + w1 * bf_lo(b.y)); v[j][3] += gg[3] * (w0 * bf_hi(a.y) + w1 * bf_hi(b.y)); }
                if (!FINAL) {
#pragma unroll
                    for (int j = 0; j < 4; ++j) { u32x2 w; w.x = cvt_pk_bf16(v[j][0], v[j][1]); w.y = cvt_pk_bf16(v[j][2], v[j][3]); ((u32x2*)(F.X + (size_t)r * D))[F.lane + 64 * j] = w; } }
            }
            float ss = 0.f;
#pragma unroll
            for (int j = 0; j < 4; ++j) ss += (v[j][0] * v[j][0] + v[j][1] * v[j][1]) + (v[j][2] * v[j][2] + v[j][3] * v[j][3]);
            const float rstd = frsq(wave_sum(ss, F.lane) * (1.0f / D) + EPS);
            if (FINAL) {
#pragma unroll
                for (int j = 0; j < 4; ++j) { const f32x4 fg = mv[F.lane + 64 * j]; __builtin_nontemporal_store(v[j] * rstd * fg, (f32x4*)(F.out + (size_t)r * D) + F.lane + 64 * j); }
            } else {
                f32x4 h[4];
#pragma unroll
                for (int j = 0; j < 4; ++j) { const f32x4 ga = mv[F.lane + 64 * j], sh = mv[256 + F.lane + 64 * j];
                    h[j] = v[j] * rstd * ga + sh;
                    if (ROUTE) asm volatile("" ::: "memory");
                    if (h8) ((unsigned*)((unsigned char*)F.H + (size_t)r * D))[F.lane + 64 * j] = cvt4_fp8(h[j][0], h[j][1], h[j][2], h[j][3]);
                    else { u32x2 w; w.x = cvt_pk_bf16(h[j][0], h[j][1]); w.y = cvt_pk_bf16(h[j][2], h[j][3]); ((u32x2*)(F.H + (size_t)r * D))[F.lane + 64 * j] = w; } }
                if (ROUTE) {
                    float a[16];
#pragma unroll
                    for (int e = 0; e < 16; ++e) a[e] = 0.f;
#pragma unroll
                    for (int j = 0; j < 4; ++j)
#pragma unroll
                        for (int q = 0; q < 4; ++q) { const float hk = h[j][q];
#pragma unroll
                            for (int ep = 0; ep < 8; ++ep) { const unsigned wp2 = wr16[j * 4 + q][ep];
                                asm("v_fma_mix_f32 %0, %1, %2, %0 op_sel:[0,0,0] op_sel_hi:[0,1,0]" : "+v"(a[2 * ep]) : "v"(hk), "v"(wp2));
                                asm("v_fma_mix_f32 %0, %1, %2, %0 op_sel:[0,1,0] op_sel_hi:[0,1,0]" : "+v"(a[2 * ep + 1]) : "v"(hk), "v"(wp2)); } }
                    float mx = -3.0e38f;
#pragma unroll
                    for (int e = 0; e < 16; ++e) { a[e] = wave_sum(a[e], F.lane) + F.b_router[e]; mx = fmaxf(mx, a[e]); }
#pragma unroll
                    for (int e = 0; e < 16; ++e) a[e] = fexp(a[e] - mx);
                    float bs = -1.f, ba = 0.f, bbv = 0.f; int bi0 = 0, bi1 = 1;
#pragma unroll
                    for (int g = 0; g < 4; ++g) {
                        float p0 = a[4 * g]; int i0 = 0;
#pragma unroll
                        for (int k = 1; k < 4; ++k) if (a[4 * g + k] > p0) { p0 = a[4 * g + k]; i0 = k; }
                        float p1 = -1.f; int i1 = 0;
#pragma unroll
                        for (int k = 0; k < 4; ++k) if (k != i0 && a[4 * g + k] > p1) { p1 = a[4 * g + k]; i1 = k; }
                        const float gs = p0 + p1;
                        if (gs > bs) { bs = gs; ba = p0; bbv = p1; bi0 = 4 * g + i0; bi1 = 4 * g + i1; }
                    }
                    if (F.lane == 0) { const float inv = 1.0f / (ba + bbv);
                        const int lp0 = __hip_atomic_fetch_add(lcnt + bi0, 1, __ATOMIC_RELAXED, __HIP_MEMORY_SCOPE_WORKGROUP), lp1 = __hip_atomic_fetch_add(lcnt + bi1, 1, __ATOMIC_RELAXED, __HIP_MEMORY_SCOPE_WORKGROUP);
                        LAS int* ri = rinfo + (r - r0) * 6; ri[0] = bi0; ri[1] = lp0; ri[2] = bi1; ri[3] = lp1; ri[4] = (int)__float_as_uint(ba * inv); ri[5] = (int)__float_as_uint(bbv * inv); }
                }
            }
#pragma unroll
            for (int j = 0; j < 4; ++j) { xa[j] = xn[j]; oa0[j] = on0[j]; oa1[j] = on1[j]; }
            tkA = tkB; tkB = tkC;
        }
    }
#undef NP_ROW
#undef NP_LOAD_TK
#undef NP_LOAD_ROW
    if (ROUTE) {
        __syncthreads();
        if (F.tid < 16) lcnt[16 + F.tid] = (int)__hip_atomic_fetch_add(F.ctl + CW_CNT + 64 * l + F.tid, (unsigned)lcnt[F.tid], RLX_AGENT);
        __syncthreads();
        for (int i = F.tid; i < r1 - r0; i += 512) { const LAS int* ri = rinfo + i * 6; const int e0 = ri[0], e1 = ri[2], p0 = lcnt[16 + e0] + ri[1], p1 = lcnt[16 + e1] + ri[3];
            v4u tk; tk.x = (unsigned)e0 | ((unsigned)p0 << 4); tk.y = (unsigned)e1 | ((unsigned)p1 << 4); tk.z = (unsigned)ri[4]; tk.w = (unsigned)ri[5]; F.TOK[r0 + i] = tk;
            F.LIST[(size_t)e0 * RT + p0] = r0 + i; F.LIST[(size_t)e1 * RT + p1] = r0 + i; }
    }
    __syncthreads();
}

__device__ __forceinline__ void norm_route_phase(Frame& F, int l, int nrows) {
    const int rpb = (nrows + F.G - 1) / F.G, r0 = F.vcu * rpb, r1 = (r0 + rpb < nrows) ? r0 + rpb : nrows;
    LAS int* rinfo = (LAS int*)(F.lds + 81920);
    LAS int* lcnt = (LAS int*)(F.lds + 81920 + 12288);
    typedef _Float16 h2v __attribute__((ext_vector_type(2)));
    unsigned wp16[8][16];
#pragma unroll
    for (int s = 0; s < 8; ++s) {
#pragma unroll
        for (int e4 = 0; e4 < 4; ++e4) { const v4u q = ((const v4u*)F.WRT)[(s * 4 + e4) * 64 + F.lane]; wp16[s][4 * e4] = q.x; wp16[s][4 * e4 + 1] = q.y; wp16[s][4 * e4 + 2] = q.z; wp16[s][4 * e4 + 3] = q.w; } }
    if (F.tid < 16) lcnt[F.tid] = 0;
    LAS f32x4* mvec = (LAS f32x4*)(F.lds + 98304);
    const int bbA = (r0 < RL) ? (r0 >> 12) : 8, bbB = (r1 - 1 < RL) ? ((r1 - 1) >> 12) : 8;
    { const float* ng = F.norm_g + (size_t)(l * 2 + 1) * D;
      for (int i = F.tid; i < 2 * 256; i += 512) { const int which = i >> 8, c4 = i & 255; const float* md = F.MOD + ((size_t)l * 9 + (which ? bbB : bbA)) * 6144;
          const f32x4 g = ((const f32x4*)ng)[c4], sc = ((const f32x4*)(md + 4 * 1024))[c4], sh = ((const f32x4*)(md + 3 * 1024))[c4];
          mvec[which * 512 + c4] = g * (sc + 1.0f); mvec[which * 512 + 256 + c4] = sh; } }
    __syncthreads();
    const int cnt = (r1 - r0 - F.wave + 7) >> 3;
    if (cnt > 0) {
        u32x2 xa[4];
        { const u32x2* xr = (const u32x2*)(F.X + (size_t)(r0 + F.wave) * D);
#pragma unroll
          for (int j = 0; j < 4; ++j) xa[j] = xr[F.lane + 64 * j]; }
        f32x4 lq0 = {0.f, 0.f, 0.f, 0.f}, lq1 = {0.f, 0.f, 0.f, 0.f};
#pragma unroll 1
        for (int i = 0; i < cnt; ++i) {
            const int r = r0 + F.wave + 8 * i; const int bb = r < RL ? (r >> 12) : 8;
            f32x4 h[4]; float ss = 0.f;
#pragma unroll
            for (int j = 0; j < 4; ++j) { h[j] = (f32x4){bf_lo(xa[j].x), bf_hi(xa[j].x), bf_lo(xa[j].y), bf_hi(xa[j].y)}; ss += (h[j][0] * h[j][0] + h[j][1] * h[j][1]) + (h[j][2] * h[j][2] + h[j][3] * h[j][3]); }
            { const int rn = (r + 8 < r1) ? r + 8 : r; const u32x2* xr = (const u32x2*)(F.X + (size_t)rn * D);
#pragma unroll
              for (int j = 0; j < 4; ++j) xa[j] = xr[F.lane + 64 * j]; }
            const float rstd = frsq(wave_sum(ss, F.lane) * (1.0f / D) + EPS);
            const LAS f32x4* mv = mvec + (bb == bbA ? 0 : 512);
            float a[16];
#pragma unroll
            for (int e = 0; e < 16; ++e) a[e] = 0.f;
#pragma unroll
            for (int j = 0; j < 4; ++j) { const f32x4 ga = mv[F.lane + 64 * j], sh = mv[256 + F.lane + 64 * j];
                h[j] = h[j] * rstd * ga + sh;
                ((unsigned*)((unsigned char*)F.H + (size_t)r * D))[F.lane + 64 * j] = cvt4_fp8(h[j][0], h[j][1], h[j][2], h[j][3]);
#pragma unroll
                for (int hf = 0; hf < 2; ++hf) { const h2v hp = {(_Float16)h[j][2 * hf], (_Float16)h[j][2 * hf + 1]};
#pragma unroll
                    for (int e = 0; e < 16; ++e) a[e] = __builtin_amdgcn_fdot2(hp, __builtin_bit_cast(h2v, wp16[2 * j + hf][e]), a[e], false); } }
            { float b8[8], c4[4];
#pragma unroll
              for (int e = 0; e < 8; ++e) { auto rr = __builtin_amdgcn_permlane32_swap(__float_as_uint(a[e]), __float_as_uint(a[e + 8]), false, false); b8[e] = __uint_as_float(rr[0]) + __uint_as_float(rr[1]); }
#pragma unroll
              for (int e = 0; e < 4; ++e) { auto rr = __builtin_amdgcn_permlane16_swap(__float_as_uint(b8[e]), __float_as_uint(b8[e + 4]), false, false); c4[e] = row_sum16(__uint_as_float(rr[0]) + __uint_as_float(rr[1])); }
              const bool mine = (F.lane & 15) == (i & 15);
              if (i < 16) {
#pragma unroll
                  for (int e = 0; e < 4; ++e) lq0[e] = mine ? c4[e] : lq0[e];
              } else {
#pragma unroll
                  for (int e = 0; e < 4; ++e) lq1[e] = mine ? c4[e] : lq1[e]; } }
        }
        const int g = F.lane >> 4;
        const f32x4 bq = *(const f32x4*)(F.b_router + 4 * g);
#pragma unroll 1
        for (int st = 0; st * 16 < cnt; ++st) {
            const f32x4 lq = st ? lq1 : lq0; const int jr = 16 * st + (F.lane & 15);
            float a[4]; float mx;
#pragma unroll
            for (int e = 0; e < 4; ++e) a[e] = lq[e] + bq[e];
            mx = col_max4(fmaxf(fmaxf(a[0], a[1]), fmaxf(a[2], a[3])));
#pragma unroll
            for (int e = 0; e < 4; ++e) a[e] = fexp(a[e] - mx);
            float p0 = a[0]; int i0 = 0;
#pragma unroll
            for (int k = 1; k < 4; ++k) if (a[k] > p0) { p0 = a[k]; i0 = k; }
            float p1 = -1.f; int i1 = 0;
#pragma unroll
            for (int k = 0; k < 4; ++k) if (k != i0 && a[k] > p1) { p1 = a[k]; i1 = k; }
            const float gs = p0 + p1, mg = col_max4(gs), wg = col_min4(gs == mg ? (float)g : 4.f);
            if (jr < cnt && wg == (float)g) { const float inv = 1.0f / (p0 + p1); const int bi0 = 4 * g + i0, bi1 = 4 * g + i1;
                const int lp0 = __hip_atomic_fetch_add(lcnt + bi0, 1, __ATOMIC_RELAXED, __HIP_MEMORY_SCOPE_WORKGROUP), lp1 = __hip_atomic_fetch_add(lcnt + bi1, 1, __ATOMIC_RELAXED, __HIP_MEMORY_SCOPE_WORKGROUP);
                LAS int* ri = rinfo + (F.wave + 8 * jr) * 6; ri[0] = bi0; ri[1] = lp0; ri[2] = bi1; ri[3] = lp1; ri[4] = (int)__float_as_uint(p0 * inv); ri[5] = (int)__float_as_uint(p1 * inv); }
        }
    }
    __syncthreads();
    if (F.tid < 16) lcnt[16 + F.tid] = (int)__hip_atomic_fetch_add(F.ctl + CW_CNT + 64 * l + F.tid, (unsigned)lcnt[F.tid], RLX_AGENT);
    __syncthreads();
    for (int i = F.tid; i < r1 - r0; i += 512) { const LAS int* ri = rinfo + i * 6; const int e0 = ri[0], e1 = ri[2], p0 = lcnt[16 + e0] + ri[1], p1 = lcnt[16 + e1] + ri[3];
        v4u tk; tk.x = (unsigned)e0 | ((unsigned)p0 << 4); tk.y = (unsigned)e1 | ((unsigned)p1 << 4); tk.z = (unsigned)ri[4]; tk.w = (unsigned)ri[5]; F.TOK[r0 + i] = tk;
        F.LIST[(size_t)e0 * RT + p0] = r0 + i; F.LIST[(size_t)e1 * RT + p1] = r0 + i; }
    __syncthreads();
}

__device__ __forceinline__ const LAS int* moe_table(Frame& F, int l) {
    LAS int* tab = (LAS int*)(F.MISC + 16);
    __syncthreads();
    if (F.tid < 16) { const int cn = (int)__hip_atomic_load(F.ctl + CW_CNT + 64 * l + F.tid, RLX_AGENT); tab[32 + F.tid] = cn; tab[48 + F.tid] = (cn + 255) >> 8; }
    __syncthreads();
    if (F.tid <= 16) { int s = 0;
#pragma unroll
        for (int e = 0; e < 16; ++e) s += (e < F.tid) ? tab[48 + e] : 0;
        tab[F.tid] = s; }
    __syncthreads();
    return tab;
}

#define MMA16(acc, afrag, bfrag) acc = __builtin_amdgcn_mfma_f32_16x16x32_bf16(bfrag, afrag, acc, 0, 0, 0)
constexpr int TP = 136;
__device__ __forceinline__ int chunk_row0(int b, int c) { return c < 2 ? RL + b * LC + c * 128 : b * SEQ + (c - 2) * 128; }

__device__ __forceinline__ void stage_vt(Frame& F, LAS bf16* VT, const bf16* src  , int ld) {
    const int j = F.tid >> 2, e0 = (F.tid & 3) * 32;
    const v4u* p = (const v4u*)(src + (size_t)j * ld + e0);
    v4u q[4];
#pragma unroll
    for (int t = 0; t < 4; ++t) q[t] = p[t];
#pragma unroll
    for (int t = 0; t < 4; ++t) { const unsigned w[4] = {q[t].x, q[t].y, q[t].z, q[t].w};
#pragma unroll
        for (int k = 0; k < 4; ++k) { VT[(e0 + t * 8 + 2 * k) * TP + j] = (bf16)(w[k] & 0xffffu); VT[(e0 + t * 8 + 2 * k + 1) * TP + j] = (bf16)(w[k] >> 16); } }
}

__device__ __forceinline__ void ret_kv_phase(Frame& F, int li) {
    LAS bf16* KTf = (LAS bf16*)F.lds; LAS bf16* KTb = KTf + 64 * TP; LAS bf16* VT = KTb + 64 * TP;
    const int fr = F.lane & 15, fq = F.lane >> 4;
    for (int u = F.vcu; u < NB * NCH * 4; u += F.G) {
        const int h = u & 3, c = (u >> 2) % NCH, b = u / (NCH * 4); const int row0 = chunk_row0(b, c);
        const float l2f = -fexp(F.ret_ld[(li * 2 + 0) * 4 + h]) * 1.4426950409f, l2b = -fexp(F.ret_ld[(li * 2 + 1) * 4 + h]) * 1.4426950409f;
        { const int j = F.tid >> 2, d0 = (F.tid & 3) * 16; const v4u* kp = (const v4u*)(F.BIG + (size_t)(row0 + j) * EVEN_IN + 256 + h * 64 + d0);
          const v4u k0 = kp[0], k1 = kp[1]; const float wf = fexp2((float)(127 - j) * l2f), wb = fexp2((float)j * l2b);
          const unsigned w[8] = {k0.x, k0.y, k0.z, k0.w, k1.x, k1.y, k1.z, k1.w};
#pragma unroll
          for (int k = 0; k < 8; ++k) { const float lo = bf_lo(w[k]), hi = bf_hi(w[k]);
              KTf[(d0 + 2 * k) * TP + j] = f2bf(lo * wf); KTf[(d0 + 2 * k + 1) * TP + j] = f2bf(hi * wf);
              KTb[(d0 + 2 * k) * TP + j] = f2bf(lo * wb); KTb[(d0 + 2 * k + 1) * TP + j] = f2bf(hi * wb); } }
        stage_vt(F, VT, F.BIG + (size_t)row0 * EVEN_IN + 512 + h * 128, EVEN_IN);
        __syncthreads();
        const int dir = F.wave >> 2, mp = F.wave & 3; const LAS bf16* KT = dir ? KTb : KTf;
        f32x4 acc[2][4];
#pragma unroll
        for (int mi = 0; mi < 2; ++mi)
#pragma unroll
            for (int n = 0; n < 4; ++n) acc[mi][n] = (f32x4){0.f, 0.f, 0.f, 0.f};
#pragma unroll
        for (int ks = 0; ks < 4; ++ks) { bf16x8 bv[4];
#pragma unroll
            for (int n = 0; n < 4; ++n) bv[n] = *(const LAS bf16x8*)(KT + (16 * n + fr) * TP + 32 * ks + 8 * fq);
#pragma unroll
            for (int mi = 0; mi < 2; ++mi) { const bf16x8 a = *(const LAS bf16x8*)(VT + (32 * mp + 16 * mi + fr) * TP + 32 * ks + 8 * fq);
#pragma unroll
                for (int n = 0; n < 4; ++n) MMA16(acc[mi][n], a, bv[n]); } }
        float* op = F.KV + ((size_t)(((b * NCH + c) * 4 + h) * 2 + dir) * 128 + 32 * mp + fr) * 64 + 4 * fq;
#pragma unroll
        for (int mi = 0; mi < 2; ++mi)
#pragma unroll
            for (int n = 0; n < 4; ++n) *(f32x4*)(op + (size_t)mi * 16 * 64 + 16 * n) = acc[mi][n];
        __syncthreads();
    }
}

__device__ __forceinline__ void ret_scan_phase(Frame& F, int li) {
    const int gt = F.vcu * 512 + F.tid, GT = F.G * 512;
    for (int it = gt; it < 64 * 128 * 16; it += GT) {
        const int dg = it & 15, e = (it >> 4) & 127, chain = it >> 11, dir = chain & 1, h = (chain >> 1) & 3, b = chain >> 3;
        const float l2 = -fexp(F.ret_ld[(li * 2 + dir) * 4 + h]) * 1.4426950409f; const float cd = fexp2(128.f * l2);
        f32x4 s = {0.f, 0.f, 0.f, 0.f};
        const size_t eo = (size_t)e * 64 + 4 * dg;
#define SC_BLK(st) ((size_t)(((b * NCH + (dir ? ((st) == 0 ? 1 : ((st) == 1 ? 0 : 35 - (st))) : (st))) * 4 + h) * 2 + dir) * 8192)
#pragma unroll 1
        for (int s0 = 0; s0 < NCH; s0 += 8) {
            f32x4 kvv[8];
#pragma unroll
            for (int k = 0; k < 8; ++k) { const int st = (s0 + k < NCH) ? s0 + k : NCH - 1; kvv[k] = *(const f32x4*)(F.KV + SC_BLK(st) + eo); }
#pragma unroll
            for (int k = 0; k < 8; ++k) { if (s0 + k < NCH) { u32x2 w; w.x = cvt_pk_bf16(s[0], s[1]); w.y = cvt_pk_bf16(s[2], s[3]);
                *(u32x2*)(F.ST + SC_BLK(s0 + k) + eo) = w; s = s * cd + kvv[k]; } }
        }
#undef SC_BLK
    }
}

__device__ __forceinline__ void mixer_phase(Frame& F, int li) {
    LAS bf16* VT = (LAS bf16*)F.lds; LAS bf16* PB = VT + 128 * TP; LAS bf16* SN = PB + 128 * TP;
    constexpr int KP = 72;
    LAS bf16* KS = (LAS bf16*)(F.lds + 106496); LAS bf16* SF = KS + 128 * KP; LAS bf16* SB = SF + 128 * KP;
    const int fr = F.lane & 15, fq = F.lane >> 4, irow = 16 * F.wave + fr;
    LAS float* cvec = (LAS float*)(F.lds + 3 * 128 * TP * 2);
    const bool hfix = (F.G & 3) == 0; const int hw = F.vcu & 3;
    if (hfix) { if (F.tid < 128) { cvec[F.tid] = F.ret_gn[li * 512 + hw * 128 + F.tid]; cvec[128 + F.tid] = F.sg_ln_g[li * 512 + hw * 128 + F.tid]; cvec[256 + F.tid] = F.sg_ln_b[li * 512 + hw * 128 + F.tid]; cvec[384 + F.tid] = F.sg_b[(li * 4 + hw) * 128 + F.tid]; } __syncthreads(); }
    for (int u = F.vcu; u < NB * NCH * 4; u += F.G) {
        const int h = u & 3, c = (u >> 2) % NCH, b = u / (NCH * 4), row0 = chunk_row0(b, c); const size_t grow = (size_t)(row0 + irow);
        if (!hfix) { __syncthreads(); if (F.tid < 128) { cvec[F.tid] = F.ret_gn[li * 512 + h * 128 + F.tid]; cvec[128 + F.tid] = F.sg_ln_g[li * 512 + h * 128 + F.tid]; cvec[256 + F.tid] = F.sg_ln_b[li * 512 + h * 128 + F.tid]; cvec[384 + F.tid] = F.sg_b[(li * 4 + h) * 128 + F.tid]; } __syncthreads(); }
        const bf16* Pr = F.BIG + grow * EVEN_IN;
        const float l2f = -fexp(F.ret_ld[(li * 2 + 0) * 4 + h]) * 1.4426950409f, l2b = -fexp(F.ret_ld[(li * 2 + 1) * 4 + h]) * 1.4426950409f;
        u32x2 gtv[8], uuv[8]; bf16x8 sga[4];
#pragma unroll
        for (int n = 0; n < 8; ++n) { gtv[n] = *(const u32x2*)(Pr + 1024 + h * 128 + 16 * n + 4 * fq); uuv[n] = *(const u32x2*)(Pr + 1536 + h * 128 + 16 * n + 4 * fq); }
#pragma unroll
        for (int ks = 0; ks < 4; ++ks) sga[ks] = *(const bf16x8*)(F.SGW + ((size_t)(li * 4 + h) * 128 + irow) * 128 + 32 * ks + 8 * fq);
        v4u vq[4];
        { const v4u* vp = (const v4u*)(F.BIG + (size_t)(row0 + (F.tid >> 2)) * EVEN_IN + 512 + h * 128 + (F.tid & 3) * 32);
#pragma unroll
          for (int t = 0; t < 4; ++t) vq[t] = vp[t]; }
        bf16x8 qf[2];
#pragma unroll
        for (int ks = 0; ks < 2; ++ks) qf[ks] = *(const bf16x8*)(Pr + h * 64 + 32 * ks + 8 * fq);
        v4u kq[2], sfq[2], sbq[2];
        { const int rr = F.tid >> 2, cc = (F.tid & 3) * 16;
          const v4u* kp = (const v4u*)(F.BIG + (size_t)(row0 + rr) * EVEN_IN + 256 + h * 64 + cc);
          const v4u* sp = (const v4u*)(F.ST + (size_t)((((b * NCH + c) * 4 + h) * 2) * 128 + rr) * 64 + cc);
          kq[0] = kp[0]; kq[1] = kp[1]; sfq[0] = sp[0]; sfq[1] = sp[1]; sbq[0] = sp[1024]; sbq[1] = sp[1025]; }
        {
            const int qt = F.tid >> 2, c0 = (F.tid & 3) * 32, e0 = c0, j = qt;
#pragma unroll
            for (int t = 0; t < 4; ++t) { const unsigned w[4] = {vq[t].x, vq[t].y, vq[t].z, vq[t].w};
#pragma unroll
                for (int k = 0; k < 4; ++k) { VT[(e0 + t * 8 + 2 * k) * TP + j] = (bf16)(w[k] & 0xffffu); VT[(e0 + t * 8 + 2 * k + 1) * TP + j] = (bf16)(w[k] >> 16); } }
        }
        { const int rr = F.tid >> 2, cc = (F.tid & 3) * 16;
          *(LAS v4u*)(KS + rr * KP + cc) = kq[0]; *(LAS v4u*)(KS + rr * KP + cc + 8) = kq[1];
          *(LAS v4u*)(SF + rr * KP + cc) = sfq[0]; *(LAS v4u*)(SF + rr * KP + cc + 8) = sfq[1];
          *(LAS v4u*)(SB + rr * KP + cc) = sbq[0]; *(LAS v4u*)(SB + rr * KP + cc + 8) = sbq[1]; }
        {
            const int qt = F.tid >> 2, c0 = (F.tid & 3) * 32;
            f32x2 st; { const f32x4* sp = (const f32x4*)(F.STATS + (size_t)(row0 + qt) * 16); float s1 = 0.f, s2 = 0.f;
#pragma unroll
                for (int k = 0; k < 8; ++k) { const f32x4 pv = sp[k]; s1 += pv[0] + pv[2]; s2 += pv[1] + pv[3]; }
                const float mean = s1 * (1.0f / 512.0f); st = (f32x2){mean, frsq(s2 * (1.0f / 512.0f) - mean * mean + EPS)}; }
            const v4u* p = (const v4u*)(F.BIG + (size_t)(row0 + qt) * EVEN_IN + 2048 + h * 128 + c0);
            const LAS float* lg = cvec + 128 + c0; const LAS float* lb = cvec + 256 + c0;
#pragma unroll
            for (int t = 0; t < 4; ++t) { const v4u sv = p[t]; const unsigned w[4] = {sv.x, sv.y, sv.z, sv.w}; const f32x4 g0 = *(const LAS f32x4*)(lg + 8 * t), g1 = *(const LAS f32x4*)(lg + 8 * t + 4), b0 = *(const LAS f32x4*)(lb + 8 * t), b1 = *(const LAS f32x4*)(lb + 8 * t + 4);
                const float gg[8] = {g0[0], g0[1], g0[2], g0[3], g1[0], g1[1], g1[2], g1[3]}, bbv[8] = {b0[0], b0[1], b0[2], b0[3], b1[0], b1[1], b1[2], b1[3]};
#pragma unroll
                for (int k = 0; k < 4; ++k) { const float lo = (bf_lo(w[k]) - st.x) * st.y * gg[2 * k] + bbv[2 * k], hi = (bf_hi(w[k]) - st.x) * st.y * gg[2 * k + 1] + bbv[2 * k + 1];
                    SN[(c0 + 8 * t + 2 * k) * TP + qt] = f2bf(lo); SN[(c0 + 8 * t + 2 * k + 1) * TP + qt] = f2bf(hi); } }
        }
        __syncthreads();
        {
            f32x4 acc[8];
#pragma unroll
            for (int n = 0; n < 8; ++n) acc[n] = (f32x4){0.f, 0.f, 0.f, 0.f};
#pragma unroll
            for (int n = 0; n < 8; ++n)
#pragma unroll
                for (int ks = 0; ks < 2; ++ks) { const bf16x8 kfr = *(const LAS bf16x8*)(KS + (16 * n + fr) * KP + 32 * ks + 8 * fq); MMA16(acc[n], qf[ks], kfr); }
#pragma unroll
            for (int n = 0; n < 8; ++n) { float pv[4];
#pragma unroll
                for (int r = 0; r < 4; ++r) { const int dl = irow - (16 * n + 4 * fq + r); const float ex = fexp2((float)(dl > 0 ? dl : -dl) * (dl > 0 ? l2f : l2b)); const float dec = dl == 0 ? 2.0f : ex; pv[r] = acc[n][r] * dec; }
                u32x2 w; w.x = cvt_pk_bf16(pv[0], pv[1]); w.y = cvt_pk_bf16(pv[2], pv[3]); *(LAS u32x2*)(PB + irow * TP + 16 * n + 4 * fq) = w; }
        }
        LDS_WAIT();
        f32x4 ao[8];
#pragma unroll
        for (int n = 0; n < 8; ++n) ao[n] = (f32x4){0.f, 0.f, 0.f, 0.f};
#pragma unroll
        for (int ks = 0; ks < 4; ++ks) { const bf16x8 a = *(const LAS bf16x8*)(PB + irow * TP + 32 * ks + 8 * fq);
#pragma unroll
            for (int n = 0; n < 8; ++n) { const bf16x8 bv = *(const LAS bf16x8*)(VT + (16 * n + fr) * TP + 32 * ks + 8 * fq); MMA16(ao[n], a, bv); } }
#pragma unroll
        for (int dir = 0; dir < 2; ++dir) {
            const float xi = dir ? fexp2((float)(128 - irow) * l2b) : fexp2((float)(irow + 1) * l2f);
            const LAS bf16* Sx = dir ? SB : SF;
            f32x4 ax[8];
#pragma unroll
            for (int n = 0; n < 8; ++n) ax[n] = (f32x4){0.f, 0.f, 0.f, 0.f};
#pragma unroll
            for (int n = 0; n < 8; ++n)
#pragma unroll
                for (int ks = 0; ks < 2; ++ks) { const bf16x8 sfr = *(const LAS bf16x8*)(Sx + (16 * n + fr) * KP + 32 * ks + 8 * fq); MMA16(ax[n], qf[ks], sfr); }
#pragma unroll
            for (int n = 0; n < 8; ++n) ao[n] = ao[n] + ax[n] * xi;
        }
        float s = 0.f;
#pragma unroll
        for (int n = 0; n < 8; ++n) s += (ao[n][0] + ao[n][1]) + (ao[n][2] + ao[n][3]);
        s = col_sum4(s);
        const float mean = s * (1.0f / 128.0f); float q = 0.f;
#pragma unroll
        for (int n = 0; n < 8; ++n) { const f32x4 d = ao[n] - mean; q += (d[0] * d[0] + d[1] * d[1]) + (d[2] * d[2] + d[3] * d[3]); }
        q = col_sum4(q);
        const float rstd = frsq(q * (1.0f / 128.0f) + EPS);
#pragma unroll
        for (int n = 0; n < 8; ++n) { const int e0 = 16 * n + 4 * fq; const u32x2 gt = gtv[n]; const f32x4 gn = *(const LAS f32x4*)(cvec + e0);
            const float y0 = (ao[n][0] - mean) * rstd * gn[0] * silu_f(bf_lo(gt.x)), y1 = (ao[n][1] - mean) * rstd * gn[1] * silu_f(bf_hi(gt.x));
            const float y2 = (ao[n][2] - mean) * rstd * gn[2] * silu_f(bf_lo(gt.y)), y3 = (ao[n][3] - mean) * rstd * gn[3] * silu_f(bf_hi(gt.y));
            u32x2 w; w.x = cvt_pk_bf16(y0, y1); w.y = cvt_pk_bf16(y2, y3); *(u32x2*)(F.MIX + grow * D + h * 128 + e0) = w; }
        {
            f32x4 acc[8];
#pragma unroll
            for (int n = 0; n < 8; ++n) acc[n] = (f32x4){0.f, 0.f, 0.f, 0.f};
#pragma unroll
            for (int ks = 0; ks < 4; ++ks) { const bf16x8 a = sga[ks];
#pragma unroll
                for (int n = 0; n < 8; ++n) { const bf16x8 bv = *(const LAS bf16x8*)(SN + (16 * n + fr) * TP + 32 * ks + 8 * fq); MMA16(acc[n], a, bv); } }
            const float bsv = cvec[384 + irow];
#pragma unroll
            for (int n = 0; n < 8; ++n) { const int c0 = 16 * n + 4 * fq; const u32x2 uu = uuv[n];
                u32x2 w; w.x = cvt_pk_bf16(bf_lo(uu.x) * (acc[n][0] + bsv), bf_hi(uu.x) * (acc[n][1] + bsv)); w.y = cvt_pk_bf16(bf_lo(uu.y) * (acc[n][2] + bsv), bf_hi(uu.y) * (acc[n][3] + bsv));
                *(u32x2*)(F.MIX + grow * D + 512 + h * 128 + c0) = w; }
        }
        __syncthreads();
    }
}

namespace att {
constexpr int QBLK = 32, KVBLK = 64, DH = 128;
constexpr float SCALE = 0.088388347648318440f;
constexpr float THR = 8.f;
constexpr int LDQ = 1024, LDK = 256, LDO = 1024;
constexpr size_t SHM_V = KVBLK * DH * 2, SHM_K = KVBLK * DH * 2, SHM_ATTN = 2 * SHM_V + 2 * SHM_K + NWAVES * 64 * 4;
#define KSWZ(row, colB) ((row) * 256 + ((colB) ^ (((row) & 7) << 4)))
#define SBAR() __builtin_amdgcn_sched_barrier(0)
__device__ __forceinline__ int crow(int r, int hi) { return (r & 3) + 8 * (r >> 2) + 4 * hi; }
__device__ __forceinline__ void partialSM(f32x16& p0, f32x16& p1, float& m_reg, float& mn, float& alpha) {
  constexpr float C = SCALE * 1.4426950408889634f;
  float pmax = p0[0]; for (int r = 1; r < 16; ++r) pmax = fmaxf(pmax, p0[r]); for (int r = 0; r < 16; ++r) pmax = fmaxf(pmax, p1[r]);
  { auto rr = __builtin_amdgcn_permlane32_swap(__float_as_uint(pmax), __float_as_uint(pmax), false, false);
    pmax = fmaxf(__uint_as_float(rr[0]), __uint_as_float(rr[1])); }
  if (__builtin_expect(__all(pmax - m_reg <= THR / SCALE), 1)) { mn = m_reg; alpha = 1.f; }
  else { mn = fmaxf(m_reg, pmax); alpha = __builtin_amdgcn_exp2f((m_reg - mn) * C); m_reg = mn; }
  float mnC = -mn * C;
  for (int r = 0; r < 16; ++r) p0[r] = fmaf(p0[r], C, mnC); for (int r = 0; r < 16; ++r) p1[r] = fmaf(p1[r], C, mnC);
  for (int r = 0; r < 16; ++r) p0[r] = __builtin_amdgcn_exp2f(p0[r]);
}
__device__ __forceinline__ void finishSM(f32x16& p0, f32x16& p1, float alpha, float& l_reg, bf16x8& pa0, bf16x8& pa1, bf16x8& pa2, bf16x8& pa3) {
  for (int r = 0; r < 16; ++r) p1[r] = __builtin_amdgcn_exp2f(p1[r]);
  float ps = 0; for (int r = 0; r < 16; ++r) ps += p0[r]; for (int r = 0; r < 16; ++r) ps += p1[r];
  { auto rr = __builtin_amdgcn_permlane32_swap(__float_as_uint(ps), __float_as_uint(ps), false, false);
    ps = __uint_as_float(rr[0]) + __uint_as_float(rr[1]); }
  l_reg = l_reg * alpha + ps;
#define PK4(P, BASE, OUT) do { unsigned a0 = cvt_pk_bf16(P[BASE + 0], P[BASE + 1]), a1 = cvt_pk_bf16(P[BASE + 2], P[BASE + 3]);   \
    unsigned b0 = cvt_pk_bf16(P[BASE + 4], P[BASE + 5]), b1 = cvt_pk_bf16(P[BASE + 6], P[BASE + 7]);                              \
    auto r0 = __builtin_amdgcn_permlane32_swap(a0, b0, false, false); auto r1 = __builtin_amdgcn_permlane32_swap(a1, b1, false, false); \
    v4u w = {r0[0], r1[0], r0[1], r1[1]}; OUT = *reinterpret_cast<bf16x8*>(&w); } while (0)
  PK4(p0, 0, pa0); PK4(p0, 8, pa1); PK4(p1, 0, pa2); PK4(p1, 8, pa3);
#undef PK4
}
__device__ __forceinline__ void qkt(f32x16& p0, f32x16& p1, const int (&kb4)[4], int boff, const bf16x8* qr) {
  p0 = f32x16{}; p1 = f32x16{};
#pragma unroll
  for (int d0 = 0; d0 < 8; ++d0) { const LAS char* kp = (const LAS char*)(uintptr_t)(unsigned)(kb4[d0 & 3] + boff);
    bf16x8 b0 = *reinterpret_cast<const LAS bf16x8*>(kp + (d0 >> 2) * 128);
    bf16x8 b1 = *reinterpret_cast<const LAS bf16x8*>(kp + (d0 >> 2) * 128 + 8192);
    p0 = __builtin_amdgcn_mfma_f32_32x32x16_bf16(b0, qr[d0], p0, 0, 0, 0);
    p1 = __builtin_amdgcn_mfma_f32_32x32x16_bf16(b1, qr[d0], p1, 0, 0, 0); }
}
__device__ __forceinline__ void mask_tile(f32x16& p0, f32x16& p1, int mk, int jb, int i, int hi) {
  if (mk == 1) { for (int r = 0; r < 16; ++r) { const int j = jb + crow(r, hi); p0[r] = (j >= i) ? p0[r] : -1e30f; p1[r] = (j + 32 >= i) ? p1[r] : -1e30f; } }
  else if (mk == 2) { for (int r = 0; r < 16; ++r) { const int j = jb + crow(r, hi); p0[r] = (j <= i) ? p0[r] : -1e30f; p1[r] = (j + 32 <= i) ? p1[r] : -1e30f; } }
}
__device__ __forceinline__ int v_st(int k, int c) { const int kk = (k & ~0xC) | ((k & 4) << 1) | ((k & 8) >> 1); return ((kk >> 3) * 4 + (c >> 5)) * 512 + ((kk & 7) * 32 + (c & 31)) * 2; }
__device__ __forceinline__ int v_rd_base(int lane) { return ((lane & 3) << 3) | (((lane >> 2) & 3) << 6) | (((lane >> 4) & 1) << 5) | (((lane >> 5) & 1) << 8); }
constexpr int v_rd_off(int d0, int ks, int half) { return d0 * 512 + ks * 4096 + half * 2048; }
template <int OFF> __device__ __forceinline__ s16x4 tr_read(int vb) {
  s16x4 r; asm volatile("ds_read_b64_tr_b16 %0, %1 offset:%2" : "=&v"(r) : "v"(vb), "i"(OFF) : "memory"); return r;
}
template <int D0> __device__ __forceinline__ void pv_one(f32x16& od, int vb, bf16x8 pa0, bf16x8 pa1, bf16x8 pa2, bf16x8 pa3) {
  const s16x4 l0 = tr_read<v_rd_off(D0, 0, 0)>(vb), h0 = tr_read<v_rd_off(D0, 0, 1)>(vb), l1 = tr_read<v_rd_off(D0, 1, 0)>(vb), h1 = tr_read<v_rd_off(D0, 1, 1)>(vb);
  const s16x4 l2 = tr_read<v_rd_off(D0, 2, 0)>(vb), h2 = tr_read<v_rd_off(D0, 2, 1)>(vb), l3 = tr_read<v_rd_off(D0, 3, 0)>(vb), h3 = tr_read<v_rd_off(D0, 3, 1)>(vb);
  asm volatile("s_waitcnt lgkmcnt(0)" ::: "memory"); SBAR();
#define PK(L, H) (bf16x8){L[0], L[1], L[2], L[3], H[0], H[1], H[2], H[3]}
  od = __builtin_amdgcn_mfma_f32_32x32x16_bf16(pa0, PK(l0, h0), od, 0, 0, 0);
  od = __builtin_amdgcn_mfma_f32_32x32x16_bf16(pa1, PK(l1, h1), od, 0, 0, 0);
  od = __builtin_amdgcn_mfma_f32_32x32x16_bf16(pa2, PK(l2, h2), od, 0, 0, 0);
  od = __builtin_amdgcn_mfma_f32_32x32x16_bf16(pa3, PK(l3, h3), od, 0, 0, 0);
#undef PK
}
__device__ __forceinline__ void pv_d0(f32x16* o, int vb, bf16x8 pa0, bf16x8 pa1, bf16x8 pa2, bf16x8 pa3) {
  pv_one<0>(o[0], vb, pa0, pa1, pa2, pa3); pv_one<1>(o[1], vb, pa0, pa1, pa2, pa3); pv_one<2>(o[2], vb, pa0, pa1, pa2, pa3); pv_one<3>(o[3], vb, pa0, pa1, pa2, pa3);
}

__device__ __forceinline__ void attn_unit(const bf16* __restrict__ Q, const bf16* __restrict__ Kb, const bf16* __restrict__ Vb, bf16* __restrict__ O, const float* __restrict__ sinkp,
                                          int qrow0, int h0, int kvh, int klat, int kctx, int add0, int skipnext, int NT, char* lds, const int tid) {
  const int wid = tid >> 6, lane = tid & 63, r32 = lane & 31, hi = lane >> 5;
  bf16* V_lds = (bf16*)lds; bf16* K_lds = (bf16*)(lds + 2 * SHM_V);
  float* ws = (float*)(lds + 2 * SHM_V + 2 * SHM_K) + wid * 64; float* li_l = ws; float* al_l = ws + 32;
  const int head = h0 + (wid >> 2), iq = (wid & 3) * QBLK + r32;
  float m_reg = sinkp[head] * (1.0f / SCALE), l_reg = 1.0f; f32x16 o[4] = {}; bf16x8 qr[8];
  const bf16* Qw = Q + (size_t)(qrow0 + iq) * LDQ + head * DH + hi * 8;
#pragma unroll
  for (int d0 = 0; d0 < 8; ++d0) qr[d0] = *reinterpret_cast<const bf16x8*>(Qw + d0 * 16);
  const int sr = tid >> 4, sc = (tid & 15) * 8, vst0 = v_st(sr, sc), vst1 = v_st(32 + sr, sc);
  const int vb0 = (int)(uintptr_t)V_lds + v_rd_base(lane);
  int kb4[4];
#pragma unroll
  for (int q = 0; q < 4; ++q) kb4[q] = (int)(uintptr_t)K_lds + r32 * 256 + ((q << 5) ^ ((hi << 4) ^ ((r32 & 7) << 4)));
  const unsigned kvoff = (unsigned)((sr * LDK + kvh * DH + sc) * 2);
  struct { bf16x8 vs0, vs1, ks0, ks1; } sr_[2];
#define TILE_T(s) ({ int _t = (s) + add0; if (skipnext && _t >= 4) _t += 2; _t; })
#define TILE_ROW(t) ((t) < 6 ? klat + 64 * (t) : kctx + 64 * ((t) - 6))
#define TILE_MK(t) ((t) < 2 ? 1 : (((t) >= 4 && (t) < 6) ? 2 : 0))
#define SLOAD(i, s) do { const int _t = TILE_T(s); const size_t _k0 = (size_t)TILE_ROW(_t) * (LDK * 2); const char* _kp = (const char*)Kb + _k0; const char* _vp = (const char*)Vb + _k0; \
    sr_[i].vs0 = *reinterpret_cast<const bf16x8*>(_vp + kvoff); sr_[i].vs1 = *reinterpret_cast<const bf16x8*>(_vp + 32 * LDK * 2 + kvoff); \
    sr_[i].ks0 = *reinterpret_cast<const bf16x8*>(_kp + kvoff); sr_[i].ks1 = *reinterpret_cast<const bf16x8*>(_kp + 32 * LDK * 2 + kvoff); } while (0)
#define SWRITE(b, i) do { *(bf16x8*)((char*)V_lds + (b) * SHM_V + vst0) = sr_[i].vs0;          \
    *(bf16x8*)((char*)V_lds + (b) * SHM_V + vst1) = sr_[i].vs1; int kc = sc * 2;               \
    *(bf16x8*)((char*)K_lds + (b) * SHM_K + KSWZ(sr, kc)) = sr_[i].ks0;                       \
    *(bf16x8*)((char*)K_lds + (b) * SHM_K + KSWZ(32 + sr, kc)) = sr_[i].ks1; } while (0)
#define SWAIT() asm volatile("s_waitcnt vmcnt(4)" ::: "memory")
#define RESC(a) do { if (__any((a) < 1.f)) { if (hi == 0) al_l[r32] = (a); asm volatile("s_waitcnt lgkmcnt(0)" ::: "memory"); \
    for (int d = 0; d < 4; ++d) for (int r = 0; r < 16; ++r) o[d][r] *= al_l[crow(r, hi)]; } } while (0)
#define MASK(P0, P1, s) do { const int _t = TILE_T(s); mask_tile(P0, P1, TILE_MK(_t), 64 * (_t & 1), iq, hi); } while (0)
  f32x16 pA0, pA1, pB0, pB1; float mnA, mnB, alA, alB; bf16x8 pa0, pa1, pa2, pa3;
  constexpr int SE = 0, SO = 1;
  SLOAD(SE, 0); asm volatile("s_waitcnt vmcnt(0)" ::: "memory"); SWRITE(0, SE); __syncthreads();
  qkt(pA0, pA1, kb4, 0, qr); MASK(pA0, pA1, 0); partialSM(pA0, pA1, m_reg, mnA, alA);
  SLOAD(SO, 1); if (2 < NT) SLOAD(SE, 2);
  SWAIT(); SWRITE(1, SO); __syncthreads();
  for (int j = 1; j + 1 < NT; j += 2) {
    SBAR(); qkt(pB0, pB1, kb4, (int)SHM_K, qr); MASK(pB0, pB1, j);
    finishSM(pA0, pA1, alA, l_reg, pa0, pa1, pa2, pa3); SBAR();
    SLOAD(SO, j + 2); SBAR();
    pv_d0(o, vb0, pa0, pa1, pa2, pa3); partialSM(pB0, pB1, m_reg, mnB, alB);
    __syncthreads(); SWAIT(); SWRITE(0, SE);
    RESC(alB); __syncthreads();
    SBAR(); qkt(pA0, pA1, kb4, 0, qr); MASK(pA0, pA1, j + 1);
    finishSM(pB0, pB1, alB, l_reg, pa0, pa1, pa2, pa3); SBAR();
    if (j + 3 < NT) SLOAD(SE, j + 3); SBAR();
    pv_d0(o, vb0 + (int)SHM_V, pa0, pa1, pa2, pa3); partialSM(pA0, pA1, m_reg, mnA, alA);
    __syncthreads(); SWAIT(); SWRITE(1, SO);
    RESC(alA); __syncthreads();
  }
  SBAR(); qkt(pB0, pB1, kb4, (int)SHM_K, qr); MASK(pB0, pB1, NT - 1);
  finishSM(pA0, pA1, alA, l_reg, pa0, pa1, pa2, pa3); SBAR();
  pv_d0(o, vb0, pa0, pa1, pa2, pa3); partialSM(pB0, pB1, m_reg, mnB, alB);
  __syncthreads(); RESC(alB);
  finishSM(pB0, pB1, alB, l_reg, pa0, pa1, pa2, pa3); SBAR();
  pv_d0(o, vb0 + (int)SHM_V, pa0, pa1, pa2, pa3);
  if (hi == 0) li_l[r32] = l_reg; asm volatile("s_waitcnt lgkmcnt(0)" ::: "memory");
  float rli[16];
#pragma unroll
  for (int r = 0; r < 16; ++r) rli[r] = __builtin_amdgcn_rcpf(li_l[crow(r, hi)]);
  bf16* Ow = O + (size_t)(qrow0 + (wid & 3) * QBLK) * LDO + head * DH;
#pragma unroll
  for (int r = 0; r < 16; ++r) { int orow = crow(r, hi);
    for (int d0 = 0; d0 < 4; ++d0) Ow[(size_t)orow * LDO + d0 * 32 + r32] = f2bf(o[d0][r] * rli[r]); }
  __syncthreads();
#undef TILE_T
#undef TILE_ROW
#undef TILE_MK
#undef SLOAD
#undef SWRITE
#undef SWAIT
#undef RESC
#undef MASK
}
}

__device__ __forceinline__ void attn_phase(Frame& F, int li, bool need_ctx) {
    const bf16* Q = F.BIG; const bf16* Kb = (const bf16*)((const char*)F.BIG + BIG_K); const bf16* Vb = (const bf16*)((const char*)F.BIG + BIG_V);
    const float* sinkp = F.sink + li * 8;
    const int NU = 1024 + (need_ctx ? 64 : 0);
    for (int u = F.vcu; u < NU; u += F.G) {
        if (u < 1024) { const int pair = u & 1, kvh = (u >> 1) & 1, n = (u >> 2) & 31, b = u >> 7;
            const int add0 = (n == 0) ? 2 : 0, skipnext = (n == 31) ? 1 : 0, NT = 10 - ((n == 0 || n == 31) ? 2 : 0);
            att::attn_unit(Q, Kb, Vb, F.MIX, sinkp, b * SEQ + n * 128, kvh * 4 + pair * 2, kvh, b * SEQ + (n - 1) * 128, RL + b * LC, add0, skipnext, NT, F.ldsg, F.tid);
        } else { const int v = u - 1024, pair = v & 1, kvh = (v >> 1) & 1, cb = (v >> 2) & 1, b = v >> 3;
            att::attn_unit(Q, Kb, Vb, F.MIX, sinkp, RL + b * LC + cb * 128, kvh * 4 + pair * 2, kvh, 0, RL + b * LC, 6, 0, 4, F.ldsg, F.tid);
        }
    }
}

#ifndef MK_SINGLE
#define MK_SINGLE 1
#endif
#ifndef REP_SET
#define REP_SET 0
#endif
#define RP(n) ((REP_SET == 200 + (n)) ? 2 : 1)
constexpr int REPS[14] = {RP(0), RP(1), RP(2), RP(3), RP(4), RP(5), RP(6), RP(7), RP(8), RP(9), RP(10), RP(11), RP(12), RP(13)};
#ifdef ONLY
#define ONLYX(n, stmt) do { if constexpr (ONLY == (n)) { stmt; } } while (0)
#else
#define ONLYX(n, stmt) do { for (int rep_ = 0; rep_ < REPS[n]; ++rep_) { stmt; if (rep_ + 1 < REPS[n]) xcd_barrier(bar); } } while (0)
#endif
constexpr int PPL = 9;
constexpr int NPHASE = 1 + DEPTH * PPL + 1;

#define CAS __attribute__((address_space(4)))
__device__ __forceinline__ void fill_ptrs(Frame& F, LAS unsigned char* ldsbase, int wv) {
    const CAS char* ka = (const CAS char*)__builtin_amdgcn_kernarg_segment_ptr(); asm volatile("" : "+s"(ka));
    { F.lds = ldsbase; F.ldsg = (char*)ldsbase; F.MISC = (volatile LAS unsigned*)(ldsbase + MISC_OFF); }
    { asm volatile("" : "+s"(wv)); unsigned am = ~0u; asm volatile("" : "+s"(am)); int ln = (int)__builtin_amdgcn_mbcnt_hi(am, __builtin_amdgcn_mbcnt_lo(am, 0u)); asm volatile("" : "+v"(ln)); F.lane = ln; F.wave = wv; F.tid = wv * 64 + ln; }
    { int g = gridDim.x, bx = blockIdx.x; asm volatile("" : "+s"(g), "+s"(bx)); F.G = g; F.vcu = (g % 8 == 0) ? (bx % 8) * (g / 8) + bx / 8 : bx; F.bx = bx; }
#define KIN(k) (*(const float* const CAS*)(ka + 8 * (k)))
    F.x_in = KIN(0); F.c_in = KIN(1); F.ctx_in = KIN(2); F.cctx_in = KIN(3); F.w_mod = KIN(4); F.b_mod = KIN(5); F.norm_g = KIN(6);
    F.w_in_even = KIN(7); F.w_out_even = KIN(8); F.ret_ld = KIN(9); F.ret_gn = KIN(10); F.sg_ln_g = KIN(11); F.sg_ln_b = KIN(12); F.sg_w = KIN(13); F.sg_b = KIN(14);
    F.w_qkv = KIN(15); F.w_o = KIN(16); F.sink = KIN(17); F.w_router = KIN(18); F.b_router = KIN(19); F.w_eg = KIN(20); F.w_eu = KIN(21); F.w_ed = KIN(22); F.final_g = KIN(23);
    F.out = *(float* const CAS*)(ka + 8 * 24);
    unsigned char* ws = *(unsigned char* const CAS*)(ka + 8 * 25);
#undef KIN
    F.ctl = (unsigned*)(ws + WS_CTL);
    F.WRT = (unsigned*)(ws + WS_WRT); F.MOD = (float*)(ws + WS_MOD); F.ROPE = (float*)(ws + WS_ROPE); F.X = (bf16*)(ws + WS_X); F.KV = (float*)(ws + WS_C);
    F.SGW = (bf16*)(ws + WS_SGW); F.W1T = (bf16*)(ws + WS_W1T); F.W2T = (bf16*)(ws + WS_W2T); F.WIN = (bf16*)(ws + WS_WIN); F.WOUT = (bf16*)(ws + WS_WOUT); F.WQKV = (bf16*)(ws + WS_WQKV); F.WO = (bf16*)(ws + WS_WO);
    F.H = (bf16*)(ws + WS_H); F.BIG = (bf16*)(ws + WS_BIG); F.MIX = (bf16*)(ws + WS_MIX); F.CS = (bf16*)(ws + WS_C); F.ST = (bf16*)(ws + WS_C + C_ST);
    F.STATS = (f32x2*)(ws + WS_C + C_STATS); F.TOK = (v4u*)(ws + WS_TOK); F.LIST = (int*)(ws + WS_LIST);
}
struct Args { const float* in[24]; float* out; unsigned char* ws; int ph_lo, ph_hi; };

__global__ void __launch_bounds__(NWAVES * 64, 2) fwd_kernel(Args args) {
    extern __shared__ __attribute__((aligned(16))) unsigned char lds[];
    Frame F; const int wv0 = __builtin_amdgcn_readfirstlane((int)threadIdx.x >> 6);
    fill_ptrs(F, (LAS unsigned char*)lds, wv0);
    for (int u = F.tid; u < (LDS_BYTES - MISC_OFF) / 4; u += NWAVES * 64) ((LAS unsigned*)(F.lds + MISC_OFF))[u] = 0u;
    __syncthreads();
    XcdBarrier bar; bar.bar = F.ctl + CW_BAR; bar.x = 0; bar.st = nullptr;
    if (MK_SINGLE) bar = xcd_barrier_post(F.ctl + CW_BAR, F.MISC);
    const int lo = args.ph_lo, hi = args.ph_hi;
#define IN(k) (lo <= (k) && (k) < hi)
#define SEAM(k) do { if (IN((k) + 1)) xcd_barrier(bar); } while (0)

    if (IN(0)) { fill_ptrs(F, (LAS unsigned char*)lds, wv0); ONLYX(0, p0_prologue(F)); SEAM(0); }

#pragma unroll 1
    for (int l = 0; l < DEPTH; ++l) {
        const int pb = 1 + l * PPL, li = l >> 1; const bool even = !(l & 1), need_ctx = l < DEPTH - 1;
        const int nrows = need_ctx ? RT : RL;
        if (IN(pb + 0)) { fill_ptrs(F, (LAS unsigned char*)lds, wv0); if (l == 0) { ONLYX(1, (norm_phase<false, false, false, true>(F, l, RT, 0, even ? IN8 : QKV8))); } else { ONLYX(2, (norm_phase<true, false, false, false>(F, l, RT, 0, even ? IN8 : QKV8))); } SEAM(pb + 0); }
        if (IN(pb + 1)) {
            fill_ptrs(F, (LAS unsigned char*)lds, wv0);
            if (even) { pg8::Gemm g{F.H, (const bf16*)((const unsigned char*)F.WIN + (size_t)li * EVEN_IN * 1024 * (IN8 ? 1 : 2)), 0}; pg8::StaticOrder S; S.init(RT, EVEN_IN, F.G, F.bx); EpiIn E{F.BIG, F.STATS};
                ONLYX(3, (pg8::gemm_phase<EpiIn, pg8::StaticOrder, true, false, IN8>(F.lds, g, S, E, F.tid))); }
            else { pg8::Gemm g{F.H, (const bf16*)((const unsigned char*)F.WQKV + (size_t)li * ODD_IN * 1024 * (QKV8 ? 1 : 2)), 0}; pg8::StaticOrder S; S.init(RT, ODD_IN, F.G, F.bx);
                EpiQKV E{F.BIG, (bf16*)((char*)F.BIG + BIG_K), (bf16*)((char*)F.BIG + BIG_V), F.ROPE};
                ONLYX(4, (pg8::gemm_phase<EpiQKV, pg8::StaticOrder, true, false, QKV8>(F.lds, g, S, E, F.tid))); }
            SEAM(pb + 1);
        }
        if (even) {
            if (IN(pb + 2)) { fill_ptrs(F, (LAS unsigned char*)lds, wv0); ONLYX(5, ret_kv_phase(F, li)); SEAM(pb + 2); }
            if (IN(pb + 3)) { fill_ptrs(F, (LAS unsigned char*)lds, wv0); ONLYX(6, ret_scan_phase(F, li)); SEAM(pb + 3); }
            if (IN(pb + 4)) { fill_ptrs(F, (LAS unsigned char*)lds, wv0); ONLYX(7, mixer_phase(F, li)); SEAM(pb + 4); }
        } else {
            if (IN(pb + 4)) { fill_ptrs(F, (LAS unsigned char*)lds, wv0); ONLYX(8, attn_phase(F, li, need_ctx)); SEAM(pb + 4); }
        }
        if (IN(pb + 5)) {
            fill_ptrs(F, (LAS unsigned char*)lds, wv0);
            pg8::Gemm g{F.MIX, (even ? F.WOUT : F.WO) + (size_t)li * 1048576, 0}; pg8::StaticOrder S; S.init(nrows, D, F.G, F.bx);
            EpiRes E{l == 0 ? F.x_in : nullptr, l == 0 ? F.ctx_in : nullptr, F.X, F.MOD + (size_t)l * 9 * 6144};
            ONLYX(9, (pg8::gemm_phase<EpiRes, pg8::StaticOrder, true, false, false>(F.lds, g, S, E, F.tid)));
            SEAM(pb + 5);
        }
        if (IN(pb + 6)) { fill_ptrs(F, (LAS unsigned char*)lds, wv0); ONLYX(10, norm_route_phase(F, l, nrows)); SEAM(pb + 6); }
        if (IN(pb + 7)) {
            fill_ptrs(F, (LAS unsigned char*)lds, wv0);
            const LAS int* tab = moe_table(F, l);
            pg8::Gemm g{F.H, (const bf16*)((const unsigned char*)F.W1T + (size_t)l * 16 * 2048 * 1024), (size_t)2048 * 1024}; pg8::MoeOrder S; S.init(tab, F.LIST, 8, F.G, F.bx); EpiMoe1 E{(unsigned char*)F.BIG};
            ONLYX(11, (pg8::gemm_phase<EpiMoe1, pg8::MoeOrder, true, true, true>(F.lds, g, S, E, F.tid)));
            SEAM(pb + 7);
        }
        if (IN(pb + 8)) {
            fill_ptrs(F, (LAS unsigned char*)lds, wv0);
            const LAS int* tab = moe_table(F, l);
            pg8::Gemm g{F.BIG, (const bf16*)((const unsigned char*)F.W2T + (size_t)l * 16 * 1048576), (size_t)1048576}; pg8::MoeOrder S; S.init(tab, F.LIST, 4, F.G, F.bx); EpiBf8 E{F.CS};
            ONLYX(12, (pg8::gemm_phase<EpiBf8, pg8::MoeOrder, true, false, true, true>(F.lds, g, S, E, F.tid)));
            SEAM(pb + 8);
        }
    }
    if (IN(NPHASE - 1)) { fill_ptrs(F, (LAS unsigned char*)lds, wv0); ONLYX(13, (norm_phase<true, false, true, false>(F, DEPTH, RL, 0, true))); }
#undef IN
#undef SEAM
}

extern "C" void kernel_launch(void* const* d_in, const int* in_sizes, int n_in, void* d_out, int out_size, void* d_ws, size_t ws_size, hipStream_t stream) {
    static int grid = 0;
    if (grid == 0) {
        if (n_in != 24 || in_sizes[0] != RL * D || out_size != RL * D || ws_size < WS_END) { fprintf(stderr, "kernel_launch: shape mismatch: n_in %d in0 %d out %d ws %zu (need %zu)\n", n_in, n_in > 0 ? in_sizes[0] : -1, out_size, ws_size, (size_t)WS_END); grid = -1; return; }
        int dev = 0, cus = 0, per_cu = 0;
        if (hipGetDevice(&dev) != hipSuccess || hipDeviceGetAttribute(&cus, hipDeviceAttributeMultiprocessorCount, dev) != hipSuccess) { fprintf(stderr, "kernel_launch: device query failed\n"); grid = -1; return; }
        if (hipFuncSetAttribute((const void*)fwd_kernel, hipFuncAttributeMaxDynamicSharedMemorySize, LDS_BYTES) != hipSuccess) { fprintf(stderr, "kernel_launch: hipFuncSetAttribute failed\n"); grid = -1; return; }
        if (hipOccupancyMaxActiveBlocksPerMultiprocessor(&per_cu, (const void*)fwd_kernel, NWAVES * 64, LDS_BYTES) != hipSuccess || per_cu < 1) { fprintf(stderr, "kernel_launch: occupancy query reports %d workgroups per CU\n", per_cu); }
        (void)hipGetLastError();
        grid = cus;
    }
    if (grid < 0) return;
    if (hipMemsetAsync((char*)d_ws + WS_CTL, 0, CTL_ZERO_BYTES, stream) != hipSuccess) { fprintf(stderr, "kernel_launch: memset failed\n"); return; }
    Args a{};
    for (int i = 0; i < 24; ++i) a.in[i] = (const float*)d_in[i];
    a.out = (float*)d_out; a.ws = (unsigned char*)d_ws;
#if MK_SINGLE
    a.ph_lo = 0; a.ph_hi = NPHASE;
    hipLaunchKernelGGL(fwd_kernel, dim3(grid), dim3(NWAVES * 64), LDS_BYTES, stream, a);
#else
    for (int p = 0; p < NPHASE; ++p) {
        if (p >= 1 && p < NPHASE - 1) { const int l = (p - 1) / PPL, k = (p - 1) % PPL; if ((l & 1) && (k == 2 || k == 3)) continue; }
        a.ph_lo = p; a.ph_hi = p + 1;
        hipLaunchKernelGGL(fwd_kernel, dim3(grid), dim3(NWAVES * 64), LDS_BYTES, stream, a);
    }
#endif
    const hipError_t le = hipPeekAtLastError();
    if (le != hipSuccess) fprintf(stderr, "kernel_launch: launch failed: %s\n", hipGetErrorName(le));
}
```
